# Optimizing an MI355X kernel written in HIP

```python
import jax, jax.numpy as jnp
from jax import lax
import numpy as np

D_MODEL = 2048
BATCH = 4
SEQ = 2048
DEPTH = 4

CHUNK = 64
Q_BLOCK = 128
EPS = 1e-6

D_SSM = D_MODEL // 2
SSM_HEAD_DIM = 64
SSM_HEADS = D_SSM // SSM_HEAD_DIM
SSM_GROUPS = 2
HEADS_PER_GROUP = SSM_HEADS // SSM_GROUPS
SSM_STATE = 128
CONV_WIDTH = 4
CONV_DIM = D_SSM + 2 * SSM_GROUPS * SSM_STATE
D_ATTN = D_MODEL // 2
ATTN_HEAD_DIM = 128
ATTN_HEADS = D_ATTN // ATTN_HEAD_DIM
D_MIX = D_SSM + D_ATTN

D_FF = 5632
N_MOD = 9

IN_SIZES = (D_SSM, CONV_DIM, SSM_HEADS, D_ATTN, D_ATTN, D_ATTN, ATTN_HEADS)
D_IN_PROJ = sum(IN_SIZES)
IN_SPLITS = tuple(int(s) for s in np.cumsum(IN_SIZES)[:-1])

kernel_name = 'hymba_ssd_fox_macaron_adaln'


def rmsnorm(x, g):
    xf = x.astype(jnp.float32)
    y = xf * lax.rsqrt(jnp.mean(xf * xf, axis=-1, keepdims=True) + EPS)
    return (y * g.astype(jnp.float32)).astype(x.dtype)


def group_rmsnorm(x, g, groups):
    shp = x.shape
    xf = x.astype(jnp.float32).reshape(shp[:-1] + (groups, shp[-1] // groups))
    y = xf * lax.rsqrt(jnp.mean(xf * xf, axis=-1, keepdims=True) + EPS)
    return (y.reshape(shp) * g.astype(jnp.float32)).astype(x.dtype)


def modulate(h, shift, scale):
    return h * (1 + scale[:, None, :]) + shift[:, None, :]


def swiglu(h, w_gate, w_up, w_down):
    return (jax.nn.silu(h @ w_gate) * (h @ w_up)) @ w_down


def causal_depthwise_conv(u, w, b):
    k = w.shape[0]
    out = lax.conv_general_dilated(
        u, w[:, None, :].astype(u.dtype), window_strides=(1,), padding=[(k - 1, 0)],
        dimension_numbers=('NWC', 'WIO', 'NWC'), feature_group_count=u.shape[-1])
    return out + b


def ssd_chunked(x, dt, a, b_mat, c_mat):
    bsz, seqlen, nh, hp = x.shape
    nc = seqlen // CHUNK
    xc = (x * dt[..., None]).reshape(bsz, nc, CHUNK, nh, hp)
    ac = (dt * a).reshape(bsz, nc, CHUNK, nh)
    bc = jnp.repeat(b_mat, HEADS_PER_GROUP, axis=2).reshape(bsz, nc, CHUNK, nh, -1)
    cc = jnp.repeat(c_mat, HEADS_PER_GROUP, axis=2).reshape(bsz, nc, CHUNK, nh, -1)
    a_cs = jnp.cumsum(ac, axis=2)
    a_t = jnp.swapaxes(a_cs, 2, 3)
    seg = a_t[..., :, None] - a_t[..., None, :]
    tri = jnp.tril(jnp.ones((CHUNK, CHUNK), dtype=bool))
    decay = jnp.exp(jnp.where(tri, seg, -jnp.inf))
    cb = jnp.einsum('bclhn,bcshn->bchls', cc, bc)
    y_diag = jnp.einsum('bchls,bcshp->bclhp', cb * decay, xc)
    decay_states = jnp.exp(a_cs[:, :, -1:, :] - a_cs)
    states = jnp.einsum('bclhn,bclhp->bchpn', bc, xc * decay_states[..., None])
    chunk_decay = jnp.exp(a_cs[:, :, -1, :])

    def step(h, inp):
        st, dec = inp
        return dec[:, :, None, None] * h + st, h

    init = jnp.zeros((bsz, nh, hp, states.shape[-1]), dtype=states.dtype)
    _, prev = lax.scan(step, init, (jnp.swapaxes(states, 0, 1), jnp.swapaxes(chunk_decay, 0, 1)))
    prev = jnp.swapaxes(prev, 0, 1)
    y_off = jnp.einsum('bclhn,bchpn->bclhp', cc, prev) * jnp.exp(a_cs)[..., None]
    return (y_diag + y_off).reshape(bsz, seqlen, nh, hp)


def forgetting_attention(q, k, v, log_f):
    bsz, seqlen, nh, hd = q.shape
    nb = seqlen // Q_BLOCK
    cum = jnp.cumsum(log_f, axis=1)
    cum_k = jnp.swapaxes(cum, 1, 2)
    q_blocks = jnp.swapaxes(q.reshape(bsz, nb, Q_BLOCK, nh, hd), 0, 1)
    cq_blocks = jnp.swapaxes(cum.reshape(bsz, nb, Q_BLOCK, nh), 0, 1)
    q_pos = jnp.arange(seqlen).reshape(nb, Q_BLOCK)
    k_pos = jnp.arange(seqlen)
    scale = ATTN_HEAD_DIM ** -0.5

    def block(args):
        qi, ci, pi = args
        s = jnp.einsum('bqhd,bkhd->bhqk', qi, k).astype(jnp.float32) * scale
        s = s + (jnp.swapaxes(ci, 1, 2)[..., :, None] - cum_k[..., None, :])
        s = jnp.where(k_pos[None, :] <= pi[:, None], s, -jnp.inf)
        p = jax.nn.softmax(s, axis=-1)
        return jnp.einsum('bhqk,bkhd->bqhd', p.astype(v.dtype), v)

    out = lax.map(block, (q_blocks, cq_blocks, q_pos))
    return jnp.swapaxes(out, 0, 1).reshape(bsz, seqlen, nh, hd)


def hybrid_mixer(h, w_in, conv_w, conv_b, dt_bias, a_log, d_skip, ssm_norm, f_bias, attn_norm, w_out):
    bsz, seqlen, _ = h.shape
    proj = h @ w_in
    z, xbc, dt_raw, q, k, v, f_raw = jnp.split(proj, IN_SPLITS, axis=-1)
    xbc = jax.nn.silu(causal_depthwise_conv(xbc, conv_w, conv_b))
    xs, b_mat, c_mat = jnp.split(xbc, (D_SSM, D_SSM + SSM_GROUPS * SSM_STATE), axis=-1)
    dt = jax.nn.softplus(dt_raw.astype(jnp.float32) + dt_bias.astype(jnp.float32))
    a = -jnp.exp(a_log.astype(jnp.float32))
    xs_h = xs.reshape(bsz, seqlen, SSM_HEADS, SSM_HEAD_DIM)
    y = ssd_chunked(xs_h, dt, a,
                    b_mat.reshape(bsz, seqlen, SSM_GROUPS, SSM_STATE),
                    c_mat.reshape(bsz, seqlen, SSM_GROUPS, SSM_STATE))
    y = (y + d_skip[:, None] * xs_h).reshape(bsz, seqlen, D_SSM)
    y_ssm = group_rmsnorm(y * jax.nn.silu(z), ssm_norm, SSM_GROUPS).astype(h.dtype)
    log_f = jax.nn.log_sigmoid(f_raw.astype(jnp.float32) + f_bias.astype(jnp.float32))
    o = forgetting_attention(q.reshape(bsz, seqlen, ATTN_HEADS, ATTN_HEAD_DIM),
                             k.reshape(bsz, seqlen, ATTN_HEADS, ATTN_HEAD_DIM),
                             v.reshape(bsz, seqlen, ATTN_HEADS, ATTN_HEAD_DIM), log_f)
    y_attn = group_rmsnorm(o.reshape(bsz, seqlen, D_ATTN), attn_norm, ATTN_HEADS).astype(h.dtype)
    return jnp.concatenate([y_ssm, y_attn], axis=-1) @ w_out


def setup_inputs(seed: int = 0) -> dict:
    key = jax.random.key(seed)
    ks = jax.random.split(key, 20)
    f32 = jnp.float32
    nrm = lambda k, shp, s: (jax.random.normal(k, shp, f32) * s)
    x = jax.random.normal(ks[0], (BATCH, SEQ, D_MODEL), f32)
    c = jax.random.normal(ks[1], (BATCH, D_MODEL), f32)
    norm_pre = 1.0 + nrm(ks[2], (DEPTH, 3, D_MODEL), 0.02)
    norm_post = 1.0 + nrm(ks[3], (DEPTH, 3, D_MODEL), 0.02)
    w_mod = nrm(ks[4], (DEPTH, D_MODEL, N_MOD * D_MODEL), 0.5 * D_MODEL ** -0.5)
    gate_slots = jnp.repeat(jnp.array([0.0, 0.0, 1.0] * 3, f32), D_MODEL)
    b_mod = gate_slots[None, :] + nrm(ks[5], (DEPTH, N_MOD * D_MODEL), 0.02)
    w_ffn_gate = nrm(ks[6], (DEPTH, 2, D_MODEL, D_FF), D_MODEL ** -0.5)
    w_ffn_up = nrm(ks[7], (DEPTH, 2, D_MODEL, D_FF), D_MODEL ** -0.5)
    w_ffn_down = nrm(ks[8], (DEPTH, 2, D_FF, D_MODEL), D_FF ** -0.5)
    w_in = nrm(ks[9], (DEPTH, D_MODEL, D_IN_PROJ), D_MODEL ** -0.5)
    conv_w = nrm(ks[10], (DEPTH, CONV_WIDTH, CONV_DIM), CONV_WIDTH ** -0.5)
    conv_b = nrm(ks[11], (DEPTH, CONV_DIM), 0.02)
    dt0 = jnp.exp(jax.random.uniform(ks[12], (DEPTH, SSM_HEADS), f32, np.log(1e-3), np.log(1e-1)))
    dt_bias = dt0 + jnp.log(-jnp.expm1(-dt0))
    a_log = jnp.log(jax.random.uniform(ks[13], (DEPTH, SSM_HEADS), f32, 1.0, 16.0))
    d_skip = 1.0 + nrm(ks[14], (DEPTH, SSM_HEADS), 0.1)
    ssm_norm = 1.0 + nrm(ks[15], (DEPTH, D_SSM), 0.02)
    f_bias = 2.0 + nrm(ks[16], (DEPTH, ATTN_HEADS), 0.5)
    attn_norm = 1.0 + nrm(ks[17], (DEPTH, D_ATTN), 0.02)
    w_out = nrm(ks[18], (DEPTH, D_MIX, D_MODEL), D_MIX ** -0.5)
    return {'x': x, 'c': c, 'norm_pre': norm_pre, 'norm_post': norm_post, 'w_mod': w_mod, 'b_mod': b_mod,
            'w_ffn_gate': w_ffn_gate, 'w_ffn_up': w_ffn_up, 'w_ffn_down': w_ffn_down,
            'w_in': w_in, 'conv_w': conv_w, 'conv_b': conv_b, 'dt_bias': dt_bias, 'a_log': a_log,
            'd_skip': d_skip, 'ssm_norm': ssm_norm, 'f_bias': f_bias, 'attn_norm': attn_norm, 'w_out': w_out}


def reference(x, c, norm_pre, norm_post, w_mod, b_mod, w_ffn_gate, w_ffn_up, w_ffn_down,
              w_in, conv_w, conv_b, dt_bias, a_log, d_skip, ssm_norm, f_bias, attn_norm, w_out):
    c_act = jax.nn.silu(c)
    for l in range(DEPTH):
        mod = c_act @ w_mod[l] + b_mod[l]
        sh1, sc1, g1, sh2, sc2, g2, sh3, sc3, g3 = jnp.split(mod, N_MOD, axis=-1)
        h = modulate(rmsnorm(x, norm_pre[l, 0]), sh1, sc1)
        h = rmsnorm(swiglu(h, w_ffn_gate[l, 0], w_ffn_up[l, 0], w_ffn_down[l, 0]), norm_post[l, 0])
        x = x + (0.5 * g1[:, None, :] * h).astype(x.dtype)
        h = modulate(rmsnorm(x, norm_pre[l, 1]), sh2, sc2)
        h = hybrid_mixer(h, w_in[l], conv_w[l], conv_b[l], dt_bias[l], a_log[l], d_skip[l],
                         ssm_norm[l], f_bias[l], attn_norm[l], w_out[l])
        h = rmsnorm(h, norm_post[l, 1])
        x = x + (g2[:, None, :] * h).astype(x.dtype)
        h = modulate(rmsnorm(x, norm_pre[l, 2]), sh3, sc3)
        h = rmsnorm(swiglu(h, w_ffn_gate[l, 1], w_ffn_up[l, 1], w_ffn_down[l, 1]), norm_post[l, 2])
        x = x + (0.5 * g3[:, None, :] * h).astype(x.dtype)
    return x
```

```cpp
#include <hip/hip_runtime.h>
#include <cstdio>
#include <cstdint>
namespace pg8 {
#define PG8_LAS __attribute__((address_space(3)))
typedef unsigned short bf16_t;
typedef short bf16x8 __attribute__((ext_vector_type(8)));
typedef float f32x4 __attribute__((ext_vector_type(4)));
typedef unsigned u32x4 __attribute__((ext_vector_type(4)));
constexpr int BM = 256, BK = 64, HALF = 128, HTB = HALF * BK * 2  , STAGE_BYTES = 8 * HTB, NXCD = 8, WGM = 8;

__host__ __device__ __forceinline__ int lds_byte(int r, int c) { const int st = (r >> 4) * 2 + (c >> 5), rr = r & 15, cc = c & 31, ob = rr * 64 + cc * 2; return st * 1024 + (ob ^ (((ob >> 9) & 1) << 5)); }
__host__ __device__ __forceinline__ void stage_rc(int b, int& R, int& C) { const int st = b / 1024, sb = b % 1024, swz = sb ^ (((sb >> 9) & 1) << 5); R = (st >> 1) * 16 + swz / 64; C = (st & 1) * 32 + (swz % 64) / 2; }
__host__ __device__ __forceinline__ int perm32(int rho) { const int n = rho >> 4, i = rho & 15; return 8 * (i >> 2) + 4 * n + (i & 3); }

struct Unit { int pm, pn; };
struct Gemm { const bf16_t* A; const bf16_t* Bt; int M, N, K; };

struct StaticOrder {
    int nM, nN, nwg, G, c;
    __host__ __device__ void init(int M, int N, int G_, int c_) { nM = M / BM; nN = N / BM; nwg = nM * nN; G = G_; c = c_; }
    __host__ __device__ bool next(int i, Unit& u) const {
        const long L = (long)i * G + c; if (L >= nwg) return false;
        int wgid = (int)L; { const int q = nwg / NXCD, r = nwg % NXCD, xcd = wgid % NXCD, off = wgid / NXCD; wgid = (xcd < r ? xcd * (q + 1) : r * (q + 1) + (xcd - r) * q) + off; }
        const int nig = WGM * nN, gid = wgid / nig, fm = gid * WGM, gsz = (nM - fm) < WGM ? (nM - fm) : WGM;
        u.pm = fm + ((wgid % nig) % gsz); u.pn = (wgid % nig) / gsz; return true;
    }
    __device__ __forceinline__ void a_ready(const Unit&) const {}
    __device__ __forceinline__ void done(const Unit&) const {}
};

__device__ __forceinline__ unsigned cvt_pk_bf16(float lo, float hi) { unsigned r; asm volatile("v_cvt_pk_bf16_f32 %0, %1, %2" : "=v"(r) : "v"(lo), "v"(hi)); return r; }
typedef float f32x2 __attribute__((ext_vector_type(2)));
typedef __bf16 bf16x2_t __attribute__((ext_vector_type(2)));
__device__ __forceinline__ unsigned pk_bf16(float lo, float hi) { f32x2 v = {lo, hi}; bf16x2_t b = __builtin_convertvector(v, bf16x2_t); return __builtin_bit_cast(unsigned, b); }
__device__ __forceinline__ float silu_f(float g) { return g * __builtin_amdgcn_rcpf(1.0f + __expf(-g)); }

struct EpiF32 {
    static constexpr bool PERM = false, AFTER_DRAIN = false;
    float* C; int ldc;
    __device__ __forceinline__ void operator()(const f32x4 (&acc)[2][2][4][2], const Unit& u, int wr, int wc, int fr, int fq) const {
        const int row0 = u.pm * BM + wr * 64 + fr, col0 = u.pn * BM + wc * 32 + 4 * fq;
#pragma unroll
        for (int ai = 0; ai < 2; ++ai)
#pragma unroll
            for (int m = 0; m < 4; ++m) { float* rowp = C + (size_t)(row0 + ai * HALF + m * 16) * ldc + col0;
#pragma unroll
                for (int bj = 0; bj < 2; ++bj)
#pragma unroll
                    for (int n = 0; n < 2; ++n) *(f32x4*)(rowp + bj * HALF + n * 16) = acc[ai][bj][m][n]; }
    }
};
struct EpiSwiGLU {
    static constexpr bool PERM = true, AFTER_DRAIN = false;
    bf16_t* O; int ldc;
    __device__ __forceinline__ void operator()(const f32x4 (&acc)[2][2][4][2], const Unit& u, int wr, int wc, int fr, int fq) const {
        const int row0 = u.pm * BM + wr * 64 + fr, col0 = u.pn * HALF + wc * 32 + 8 * fq;
#pragma unroll
        for (int ai = 0; ai < 2; ++ai)
#pragma unroll
            for (int m = 0; m < 4; ++m) { bf16_t* rowp = O + (size_t)(row0 + ai * HALF + m * 16) * ldc + col0;
                const f32x4 g0 = acc[ai][0][m][0], g1 = acc[ai][0][m][1], u0 = acc[ai][1][m][0], u1 = acc[ai][1][m][1];
                u32x4 w;
                w.x = pk_bf16(silu_f(g0[0]) * u0[0], silu_f(g0[1]) * u0[1]); w.y = pk_bf16(silu_f(g0[2]) * u0[2], silu_f(g0[3]) * u0[3]);
                w.z = pk_bf16(silu_f(g1[0]) * u1[0], silu_f(g1[1]) * u1[1]); w.w = pk_bf16(silu_f(g1[2]) * u1[2], silu_f(g1[3]) * u1[3]);
                *(u32x4*)rowp = w; }
    }
};
struct EpiProj {
    static constexpr bool PERM = true, AFTER_DRAIN = false;
    bf16_t* O; int ldc; float* dtf; int nbf;
    __device__ __forceinline__ void operator()(const f32x4 (&acc)[2][2][4][2], const Unit& u, int wr, int wc, int fr, int fq) const {
        const int row0 = u.pm * BM + wr * 64 + fr;
        if (u.pn < nbf) {
            const int col0 = u.pn * BM + wc * 32 + 8 * fq;
#pragma unroll
            for (int ai = 0; ai < 2; ++ai)
#pragma unroll
                for (int m = 0; m < 4; ++m) { bf16_t* rowp = O + (size_t)(row0 + ai * HALF + m * 16) * ldc + col0;
#pragma unroll
                    for (int bj = 0; bj < 2; ++bj) { const f32x4 v0 = acc[ai][bj][m][0], v1 = acc[ai][bj][m][1];
                        u32x4 w; w.x = pk_bf16(v0[0], v0[1]); w.y = pk_bf16(v0[2], v0[3]); w.z = pk_bf16(v1[0], v1[1]); w.w = pk_bf16(v1[2], v1[3]);
                        *(u32x4*)(rowp + bj * HALF) = w; } }
        } else if (wc == 0) {
#pragma unroll
            for (int ai = 0; ai < 2; ++ai)
#pragma unroll
                for (int m = 0; m < 4; ++m) { float* rp = dtf + (size_t)(row0 + ai * HALF + m * 16) * 32 + 8 * fq;
                    *(f32x4*)rp = acc[ai][0][m][0]; *(f32x4*)(rp + 4) = acc[ai][0][m][1]; }
        }
    }
};
template <class Epi, class Sched, bool ALIGN_EPI = false, bool SP2 = false>
__device__ __forceinline__ void gemm_phase(PG8_LAS unsigned char* lds, const Gemm g, const Sched& S, const Epi& E) {
    int tid_ = threadIdx.x; asm volatile("" : "+v"(tid_)); const int tid = tid_, wid = __builtin_amdgcn_readfirstlane(tid >> 6), lane = tid & 63, wr = wid >> 2, wc = wid & 3, fr = lane & 15, fq = lane >> 4;
    const int K = g.K, nt = K / BK;
    unsigned voffA[2], voffB[2];
#pragma unroll
    for (int i = 0; i < 2; ++i) { int R, C; stage_rc(tid * 16 + i * 8192, R, C); const int Rb = Epi::PERM ? ((R & ~31) + perm32(R & 31)) : R;
        voffA[i] = (unsigned)(R * K + C) * 2u; voffB[i] = (unsigned)(Rb * K + C) * 2u; }
    const size_t kstep = (size_t)(BK * 2);
    const size_t hstep = (size_t)HALF * K * 2;
    const size_t tstep = 2 * hstep;
    const unsigned ldsw = (unsigned)wid * 1024u;
    const int aoff = lds_byte(wr * 64 + fr, fq * 8), boff = lds_byte(wc * 32 + fr, fq * 8);
#define PG8_SA(b, h) (((b) * 2 + (h)) * HTB)
#define PG8_SB(b, h) ((4 + (b) * 2 + (h)) * HTB)
#define PG8_STAGE(bufoff, gbase, voff) do { _Pragma("unroll") for (int _i = 0; _i < 2; ++_i) \
        __builtin_amdgcn_global_load_lds((const unsigned*)((const char*)(gbase) + (voff)[_i]), (PG8_LAS unsigned*)(lds + (bufoff) + ldsw + _i * 8192), 16, 0, 0); } while (0)
#define PG8_LDA(dst, b, h) do { _Pragma("unroll") for (int m = 0; m < 4; ++m) _Pragma("unroll") for (int k = 0; k < 2; ++k) dst[m][k] = *(const PG8_LAS bf16x8*)(lds + PG8_SA(b, h) + aoff + m * 2048 + k * 1024); } while (0)
#define PG8_LDB(dst, b, h) do { _Pragma("unroll") for (int n = 0; n < 2; ++n) _Pragma("unroll") for (int k = 0; k < 2; ++k) dst[n][k] = *(const PG8_LAS bf16x8*)(lds + PG8_SB(b, h) + boff + n * 2048 + k * 1024); } while (0)
#define PG8_MMA(ai, bj, At, Bt) do { __builtin_amdgcn_s_setprio(1); _Pragma("unroll") for (int m = 0; m < 4; ++m) _Pragma("unroll") for (int n = 0; n < 2; ++n) _Pragma("unroll") for (int k = 0; k < 2; ++k) \
        acc[ai][bj][m][n] = __builtin_amdgcn_mfma_f32_16x16x32_bf16(Bt[n][k], At[m][k], acc[ai][bj][m][n], 0, 0, 0); __builtin_amdgcn_s_setprio(0); } while (0)
#define PG8_WAIT_V(n) asm volatile("s_waitcnt vmcnt(" #n ")" ::: "memory")
#define PG8_WAIT_L(n) asm volatile("s_waitcnt lgkmcnt(" #n ")" ::: "memory")
#define PG8_BAR __builtin_amdgcn_s_barrier()
#define PG8_SCHED __builtin_amdgcn_sched_barrier(0)
    Unit cur, nxt; int ui = 0;
    if (!S.next(0, cur)) return;
    f32x4 acc[2][2][4][2];
#pragma unroll
    for (int a = 0; a < 2; ++a)
#pragma unroll
        for (int b = 0; b < 2; ++b)
#pragma unroll
            for (int m = 0; m < 4; ++m)
#pragma unroll
                for (int n = 0; n < 2; ++n) acc[a][b][m][n] = (f32x4){0.f, 0.f, 0.f, 0.f};
    bf16x8 At[4][2], B0[2][2], B1[2][2];
    const char* cA = (const char*)g.A + (size_t)cur.pm * tstep; const char* cB = (const char*)g.Bt + (size_t)cur.pn * tstep;
    S.a_ready(cur);
    if constexpr (SP2) {
        PG8_STAGE(PG8_SB(0, 0), cB, voffB); PG8_STAGE(PG8_SB(0, 1), cB + hstep, voffB); PG8_STAGE(PG8_SA(0, 0), cA, voffA); PG8_STAGE(PG8_SA(0, 1), cA + hstep, voffA);
        if (wr == 1) PG8_BAR;
        PG8_WAIT_V(2); PG8_BAR;
        PG8_STAGE(PG8_SB(1, 0), cB + kstep, voffB); PG8_STAGE(PG8_SA(1, 0), cA + kstep, voffA); PG8_STAGE(PG8_SB(1, 1), cB + hstep + kstep, voffB);
        PG8_WAIT_V(6); PG8_BAR;
    } else {
        PG8_STAGE(PG8_SB(0, 0), cB, voffB); PG8_STAGE(PG8_SA(0, 0), cA, voffA); PG8_STAGE(PG8_SB(0, 1), cB + hstep, voffB); PG8_STAGE(PG8_SA(0, 1), cA + hstep, voffA);
        if (wr == 1) PG8_BAR;
        PG8_WAIT_V(4); PG8_BAR;
        PG8_STAGE(PG8_SB(1, 0), cB + kstep, voffB); PG8_STAGE(PG8_SA(1, 0), cA + kstep, voffA); PG8_STAGE(PG8_SB(1, 1), cB + hstep + kstep, voffB);
        PG8_WAIT_V(6); PG8_BAR;
    }
    for (;;) {
        const bool has_next = S.next(ui + 1, nxt);
        const char* nA = has_next ? (const char*)g.A + (size_t)nxt.pm * tstep : cA; const char* nB = has_next ? (const char*)g.Bt + (size_t)nxt.pn * tstep : cB;
        for (int t = 0; t < nt; t += 2) {
            const bool last = (t == nt - 2);
            const char* a1 = cA + (size_t)(t + 1) * kstep;
            const char* a2 = last ? nA : cA + (size_t)(t + 2) * kstep; const char* b2 = last ? nB : cB + (size_t)(t + 2) * kstep;
            const char* a3 = a2 + kstep; const char* b3 = b2 + kstep;
            if (last && has_next) S.a_ready(nxt);
            if constexpr (SP2) {
            PG8_LDB(B0, 0, 0); PG8_LDB(B1, 0, 1); PG8_SCHED; PG8_LDA(At, 0, 0); PG8_STAGE(PG8_SA(1, 1), a1 + hstep, voffA);
            PG8_WAIT_V(8); PG8_WAIT_L(0); PG8_BAR; PG8_MMA(0, 0, At, B0); PG8_MMA(0, 1, At, B1); PG8_BAR; PG8_SCHED;
            PG8_LDA(At, 0, 1); PG8_STAGE(PG8_SB(0, 0), b2, voffB); PG8_STAGE(PG8_SB(0, 1), b2 + hstep, voffB); PG8_STAGE(PG8_SA(0, 0), a2, voffA);
            PG8_WAIT_V(8); PG8_WAIT_L(0); PG8_BAR; PG8_MMA(1, 0, At, B0); PG8_MMA(1, 1, At, B1); PG8_BAR; PG8_SCHED;
            PG8_LDB(B0, 1, 0); PG8_LDB(B1, 1, 1); PG8_SCHED; PG8_LDA(At, 1, 0); PG8_STAGE(PG8_SA(0, 1), a2 + hstep, voffA);
            PG8_WAIT_V(8); PG8_WAIT_L(0); PG8_BAR; PG8_MMA(0, 0, At, B0); PG8_MMA(0, 1, At, B1); PG8_BAR; PG8_SCHED;
            PG8_LDA(At, 1, 1); PG8_STAGE(PG8_SB(1, 0), b3, voffB); PG8_STAGE(PG8_SB(1, 1), b3 + hstep, voffB); PG8_STAGE(PG8_SA(1, 0), a3, voffA);
            PG8_WAIT_V(8); PG8_WAIT_L(0); PG8_BAR; PG8_MMA(1, 0, At, B0); PG8_MMA(1, 1, At, B1); PG8_BAR; PG8_SCHED;
            } else {
            PG8_LDB(B0, 0, 0); PG8_SCHED; PG8_LDA(At, 0, 0); PG8_STAGE(PG8_SA(1, 1), a1 + hstep, voffA);
            PG8_WAIT_L(8); PG8_BAR; PG8_WAIT_L(0); PG8_MMA(0, 0, At, B0); PG8_BAR; PG8_SCHED;
            PG8_LDB(B1, 0, 1); PG8_STAGE(PG8_SB(0, 0), b2, voffB);
            PG8_BAR; PG8_WAIT_L(0); PG8_MMA(0, 1, At, B1); PG8_BAR;
            PG8_LDA(At, 0, 1); PG8_STAGE(PG8_SA(0, 0), a2, voffA);
            PG8_BAR; PG8_WAIT_L(0); PG8_MMA(1, 0, At, B0); PG8_BAR; PG8_SCHED;
            PG8_STAGE(PG8_SB(0, 1), b2 + hstep, voffB);
            PG8_WAIT_V(6); PG8_BAR; PG8_MMA(1, 1, At, B1); PG8_BAR;
            PG8_LDB(B0, 1, 0); PG8_SCHED; PG8_LDA(At, 1, 0); PG8_STAGE(PG8_SA(0, 1), a2 + hstep, voffA);
            PG8_WAIT_L(8); PG8_BAR; PG8_WAIT_L(0); PG8_MMA(0, 0, At, B0); PG8_BAR; PG8_SCHED;
            PG8_LDB(B1, 1, 1); PG8_STAGE(PG8_SB(1, 0), b3, voffB);
            PG8_BAR; PG8_WAIT_L(0); PG8_MMA(0, 1, At, B1); PG8_BAR;
            PG8_LDA(At, 1, 1); PG8_STAGE(PG8_SA(1, 0), a3, voffA);
            PG8_BAR; PG8_WAIT_L(0); PG8_MMA(1, 0, At, B0); PG8_BAR; PG8_SCHED;
            PG8_STAGE(PG8_SB(1, 1), b3 + hstep, voffB);
            PG8_WAIT_V(6); PG8_BAR; PG8_MMA(1, 1, At, B1); PG8_BAR;
            }
        }
        if constexpr (ALIGN_EPI) { if (wr == 0) PG8_BAR; }
        if constexpr (!Epi::AFTER_DRAIN) { E(acc, cur, wr, wc, fr, fq); S.done(cur); }
        if (!has_next) break;
#pragma unroll
        for (int a = 0; a < 2; ++a)
#pragma unroll
            for (int b = 0; b < 2; ++b)
#pragma unroll
                for (int m = 0; m < 4; ++m)
#pragma unroll
                    for (int n = 0; n < 2; ++n) acc[a][b][m][n] = (f32x4){0.f, 0.f, 0.f, 0.f};
        cur = nxt; cA = nA; cB = nB; ++ui;
        if constexpr (ALIGN_EPI) { if (wr == 1) PG8_BAR; }
    }
    PG8_WAIT_V(0);
    if constexpr (!ALIGN_EPI) { if (wr == 0) PG8_BAR; }
    PG8_BAR;
    if constexpr (Epi::AFTER_DRAIN) { E.fused(acc, cur, wr, wc, fr, fq, lds, wid, lane); S.done(cur); }
#undef PG8_SA
#undef PG8_SB
#undef PG8_STAGE
#undef PG8_LDA
#undef PG8_LDB
#undef PG8_MMA
#undef PG8_WAIT_V
#undef PG8_WAIT_L
#undef PG8_BAR
#undef PG8_SCHED
}
}

constexpr int NWAVES = 8, NTHR = NWAVES * 64;
constexpr int NB = 4, SEQ = 2048, DM = 2048, DEPTH = 4, M = NB * SEQ;
constexpr int CHUNK = 64, NCH = SEQ / CHUNK;
constexpr int DSSM = 1024, SP = 64, SH = 16, SG = 2, HPG = 8, SN = 128, CONVD = 1536;
constexpr int DATT = 1024, AHD = 128, AH = 8;
constexpr int DFF = 5632, NMOD = 9, MODW = NMOD * DM, NGU = 2 * DFF;
constexpr int DIN = 5656, DINB = 5632, DINP = 5888;
constexpr int PC_Z = 0, PC_X = 1024, PC_B = 2048, PC_C = 2304, PC_Q = 2560, PC_K = 3584, PC_V = 4608;
constexpr float EPS = 1e-6f;

constexpr size_t MiB = 1u << 20;
constexpr size_t WS_CTL = 0, CTL_ZERO_BYTES = 4 * MiB;
constexpr size_t WS_MOD = 1 * MiB;
constexpr size_t WS_WGU = 4 * MiB;
constexpr size_t WS_WDN = WS_WGU + (size_t)DEPTH * 2 * NGU * DM * 2;
constexpr size_t WS_WIN = WS_WDN + (size_t)DEPTH * 2 * DM * DFF * 2;
constexpr size_t WS_WOUT = WS_WIN + (size_t)DEPTH * DINP * DM * 2;
constexpr size_t WS_HB = WS_WOUT + (size_t)DEPTH * DM * DM * 2;
constexpr size_t WS_ACT = WS_HB + (size_t)M * DM * 2;
constexpr size_t WS_Y = WS_ACT + (size_t)M * DFF * 2;
constexpr size_t WS_DTF = WS_Y + (size_t)M * DM * 4;
constexpr size_t WS_XBC = WS_DTF + (size_t)M * 32 * 4;
constexpr size_t WS_DT = WS_XBC + (size_t)M * CONVD * 2;
constexpr size_t WS_ACS = WS_DT + (size_t)M * 16 * 4;
constexpr size_t WS_CUMF = WS_ACS + (size_t)M * 16 * 4;
constexpr size_t WS_ST = WS_CUMF + (size_t)NB * AH * SEQ * 4;
constexpr size_t WS_YCAT = WS_ST + (size_t)NB * NCH * SH * SP * SN * 4;
constexpr size_t WS_PART = WS_YCAT + (size_t)M * DM * 2;
constexpr size_t WS_END = WS_PART + (size_t)8 * DEPTH * NB * MODW * 4;
constexpr int CW_BAR = 4096;

constexpr int RING_BYTES = 131072;
constexpr int LDSCTL_OFF = RING_BYTES, MISC_OFF = LDSCTL_OFF + 320;
constexpr int LDS_BYTES = 147456;

#define GAS __attribute__((address_space(1)))
#define LAS __attribute__((address_space(3)))
typedef unsigned short bf16;
typedef unsigned v4u __attribute__((ext_vector_type(4)));
typedef float f32x4 __attribute__((ext_vector_type(4)));
typedef short bf16x8 __attribute__((ext_vector_type(8)));
typedef GAS unsigned gu32;
typedef GAS unsigned long long gu64;
#define RLX_AGENT __ATOMIC_RELAXED, __HIP_MEMORY_SCOPE_AGENT
#define LDS_WAIT() asm volatile("s_waitcnt lgkmcnt(0)" ::: "memory")
#define VM_WAIT() asm volatile("s_waitcnt vmcnt(0)" ::: "memory")
__device__ __forceinline__ unsigned long long rt() { return __builtin_amdgcn_s_memrealtime(); }
__device__ __forceinline__ unsigned f2bf(float f) { unsigned u = __builtin_bit_cast(unsigned, f); return (u + 0x7fffu + ((u >> 16) & 1u)) >> 16; }
__device__ __forceinline__ unsigned pk2(float lo, float hi) { return f2bf(lo) | (f2bf(hi) << 16); }

#define XB_TMO      128
#define XB_XCNT(j)  (256  + 64 * (j))
#define XB_XSUB(j)  (1280 + 64 * (j))
#define XB_XGEN(j)  (2304 + 64 * (j))
#define XB_TOP      3328
#define XB_TOPGEN   3392
#define XCD_BAR_WORDS 3456
#define XB_SPIN_CAP (1u << 18)

__device__ __forceinline__ unsigned xb_ld(unsigned* p)              { return __hip_atomic_load(p, __ATOMIC_RELAXED, __HIP_MEMORY_SCOPE_AGENT); }
__device__ __forceinline__ unsigned xb_add(unsigned* p, unsigned v) { return __hip_atomic_fetch_add(p, v, __ATOMIC_RELAXED, __HIP_MEMORY_SCOPE_AGENT); }
__device__ __forceinline__ unsigned xb_xcc_id() { return (unsigned)__builtin_amdgcn_s_getreg((3 << 11) | 20) & 0xFu; }
#define XB_SPIN(cond, bar) do { unsigned _sp = 0; while (cond) { __builtin_amdgcn_s_sleep(1); \
    if ((++_sp & 255u) == 0u) { if (xb_ld(&(bar)[XB_TMO])) break; if (_sp > XB_SPIN_CAP) { atomicAdd(&(bar)[XB_TMO], 1u); break; } } } } while (0)

struct XcdBarrier {
    unsigned* bar; unsigned x;
    volatile LAS unsigned* st;
};

__device__ __forceinline__ XcdBarrier xcd_barrier_post(unsigned* bar, volatile LAS unsigned* st) {
    XcdBarrier b; b.bar = bar; b.x = xb_xcc_id(); b.st = st;
    if (threadIdx.x == 0) (void)xb_add(&bar[XB_XCNT(b.x)], 1u);
    return b;
}
__device__ __forceinline__ void xcd_barrier_complete(unsigned* bar, unsigned x, unsigned& nloc, unsigned& nx) {
    const unsigned G = gridDim.x * gridDim.y * gridDim.z;
    unsigned sum, cnt, mine, sp = 0u;
    for (;;) {
        sum = 0u; cnt = 0u; mine = 0u;
#pragma unroll
        for (unsigned j = 0; j < 16; ++j) { const unsigned c = xb_ld(&bar[XB_XCNT(j)]); sum += c; cnt += (c > 0u) ? 1u : 0u; mine = (j == x) ? c : mine; }
        if (sum == G) break;
        __builtin_amdgcn_s_sleep(1);
        if ((++sp & 255u) == 0u) { if (xb_ld(&bar[XB_TMO])) break; if (sp > XB_SPIN_CAP) { atomicAdd(&bar[XB_TMO], 1u); break; } }
    }
    nloc = mine > 0u ? mine : 1u; nx = cnt > 0u ? cnt : 1u;
}

__device__ __forceinline__ void xcd_barrier(const XcdBarrier& b) {
    asm volatile("s_waitcnt vmcnt(0)" ::: "memory");
    __syncthreads();
    if (threadIdx.x == 0) {
        unsigned* bar = b.bar;
        __builtin_amdgcn_s_waitcnt(0);
        unsigned nloc = b.st[0], nx = b.st[1];
        if (nloc == 0u) { xcd_barrier_complete(bar, b.x, nloc, nx); b.st[0] = nloc; b.st[1] = nx; }
        const unsigned old = xb_add(&bar[XB_XSUB(b.x)], 1u);
        const unsigned gen = old / nloc;
        if (old + 1u == (gen + 1u) * nloc) {
            __builtin_amdgcn_fence(__ATOMIC_RELEASE, "agent");
            asm volatile("s_waitcnt vmcnt(0)" ::: "memory");
            const unsigned og = xb_add(&bar[XB_TOP], 1u);
            const unsigned tg = og / nx;
            if (og + 1u == (tg + 1u) * nx) xb_add(&bar[XB_TOPGEN], 1u);
            else XB_SPIN(xb_ld(&bar[XB_TOPGEN]) == tg, bar);
            __builtin_amdgcn_fence(__ATOMIC_ACQUIRE, "agent");
            xb_add(&bar[XB_XGEN(b.x)], 1u);
            asm volatile("s_waitcnt vmcnt(0)" ::: "memory");
        } else {
            XB_SPIN(xb_ld(&bar[XB_XGEN(b.x)]) == gen, bar);
            __builtin_amdgcn_fence(__ATOMIC_ACQUIRE, "agent");
            asm volatile("s_waitcnt vmcnt(0)" ::: "memory");
        }
    }
    __syncthreads();
}

typedef unsigned u32x2 __attribute__((ext_vector_type(2)));
struct Frame {
    LAS unsigned char* lds;
    volatile LAS unsigned* MISC;
    gu32* ctl;
    int vcu, G;
    const float *x, *c, *norm_pre, *norm_post, *w_mod, *b_mod, *w_gate, *w_up, *w_down, *w_in, *conv_w, *conv_b, *dt_bias, *a_log, *d_skip, *ssm_norm, *f_bias, *attn_norm, *w_out;
    float* X;
    float* MOD;
    bf16 *WGU, *WDN, *WIN, *WOUT;
    bf16 *HB, *ACT, *PROJ, *XBC, *YCAT;
    float *Y, *DTF, *DT, *ACS, *CUMF, *ST, *PART;
};
__device__ __forceinline__ float bf2f(unsigned short u) { return __uint_as_float((unsigned)u << 16); }
__device__ __forceinline__ float bflo(unsigned w) { return __uint_as_float(w << 16); }
__device__ __forceinline__ float bfhi(unsigned w) { return __uint_as_float(w & 0xffff0000u); }
__device__ __forceinline__ float wave_sum(float v) {
#pragma unroll
    for (int o = 1; o < 64; o <<= 1) v += __shfl_xor(v, o);
    return v;
}
__device__ __forceinline__ float wave_max(float v) {
#pragma unroll
    for (int o = 1; o < 64; o <<= 1) v = fmaxf(v, __shfl_xor(v, o));
    return v;
}
__device__ __forceinline__ float softplus_f(float x) { return fmaxf(x, 0.f) + log1pf(__expf(-fabsf(x))); }
__device__ __forceinline__ float silu_f(float g) { return g * __builtin_amdgcn_rcpf(1.0f + __expf(-g)); }
__device__ __forceinline__ unsigned pkb(float lo, float hi) { return pg8::pk_bf16(lo, hi); }
__device__ __forceinline__ float rl(float v, int l) { return __int_as_float(__builtin_amdgcn_readlane(__float_as_int(v), l)); }
__device__ __forceinline__ int fresh_tid() { int t = threadIdx.x; asm volatile("" : "+v"(t)); return t; }
#define PHASE_IDS const int tid = fresh_tid(), lane = tid & 63, wave = __builtin_amdgcn_readfirstlane(tid >> 6); (void)tid; (void)lane; (void)wave
#define MFMA16(a, b, c) __builtin_amdgcn_mfma_f32_16x16x32_bf16((a), (b), (c), 0, 0, 0)

__device__ __forceinline__ void tr_item(const float* __restrict__ W, int N, int srccol0, bf16* __restrict__ WT, int K, int drow0, int k0, LAS unsigned* T, int lane) {
    const int r = lane >> 4, q = lane & 15;
    f32x4 a[8], b[8];
#pragma unroll
    for (int i = 0; i < 8; ++i) { const int kp = 4 * i + r; const float* p = W + (size_t)(k0 + 2 * kp) * N + srccol0 + 4 * q; a[i] = *(const f32x4*)p; b[i] = *(const f32x4*)(p + N); }
#pragma unroll
    for (int i = 0; i < 8; ++i) { const int kp = 4 * i + r; LAS unsigned* t = T + kp * 65 + 4 * q;
        t[0] = pkb(a[i][0], b[i][0]); t[1] = pkb(a[i][1], b[i][1]); t[2] = pkb(a[i][2], b[i][2]); t[3] = pkb(a[i][3], b[i][3]); }
    LDS_WAIT(); asm volatile("" ::: "memory");
    const int c = lane & 7;
#pragma unroll
    for (int i = 0; i < 8; ++i) { const int n = 8 * i + (lane >> 3); const LAS unsigned* t = T + (4 * c) * 65 + n;
        v4u o; o.x = t[0]; o.y = t[65]; o.z = t[130]; o.w = t[195];
        *(v4u*)(WT + (size_t)(drow0 + n) * K + k0 + 8 * c) = o; }
    LDS_WAIT(); asm volatile("" ::: "memory");
}
__device__ __forceinline__ void p0_prologue(Frame& F) {
    PHASE_IDS;
    const int gw = F.vcu * NWAVES + wave, NGW = F.G * NWAVES;
    {
        LAS unsigned* T = (LAS unsigned*)(F.lds) + wave * (32 * 65);
        constexpr int I_FF = (DM / 64) * (DFF / 64);
        constexpr int I_OUT = (DM / 64) * (DM / 64);
        constexpr int E_G = 8 * I_FF, E_U = 16 * I_FF, E_D = 24 * I_FF, E_I = 28 * I_FF, E_O = E_I + 4 * I_OUT;
        for (int it = gw; it < E_O; it += NGW) {
            if (it < E_U) {
                const int up = it >= E_G ? 1 : 0, r0 = it - up * E_G, lf = r0 / I_FF, r = r0 % I_FF, kb = r / 88, nb = r % 88;
                const float* W = (up ? F.w_up : F.w_gate) + (size_t)lf * DM * DFF;
                tr_item(W, DFF, 64 * nb, F.WGU + (size_t)lf * NGU * DM, DM, (nb >> 1) * 256 + (nb & 1) * 64 + up * 128, 64 * kb, T, lane);
            } else if (it < E_D) {
                const int r0 = it - E_U, lf = r0 / I_FF, r = r0 % I_FF, kb = r / 32, nb = r % 32;
                tr_item(F.w_down + (size_t)lf * DFF * DM, DM, 64 * nb, F.WDN + (size_t)lf * DM * DFF, DFF, 64 * nb, 64 * kb, T, lane);
            } else if (it < E_I) {
                const int r0 = it - E_D, l = r0 / I_FF, r = r0 % I_FF, kb = r / 88, nb = r % 88;
                const int src = 64 * nb + (64 * nb >= 2560 ? 16 : 0);
                tr_item(F.w_in + (size_t)l * DM * DIN, DIN, src, F.WIN + (size_t)l * DINP * DM, DM, 64 * nb, 64 * kb, T, lane);
            } else {
                const int r0 = it - E_I, l = r0 / I_OUT, r = r0 % I_OUT, kb = r / 32, nb = r % 32;
                tr_item(F.w_out + (size_t)l * DM * DM, DM, 64 * nb, F.WOUT + (size_t)l * DM * DM, DM, 64 * nb, 64 * kb, T, lane);
            }
        }
        const int gtid = blockIdx.x * NTHR + tid, NT = F.G * NTHR;
        for (int i = gtid; i < DEPTH * 256 * 256; i += NT) {
            const int kc = i & 255, j = (i >> 8) & 255, l = i >> 16;
            const int src = j < 16 ? 2560 + j : (j < 24 ? 5648 + (j - 16) : -1);
            v4u o = {0u, 0u, 0u, 0u};
            if (src >= 0) { const float* p = F.w_in + (size_t)l * DM * DIN + (size_t)(8 * kc) * DIN + src;
                o.x = pkb(p[0], p[DIN]); o.y = pkb(p[2 * DIN], p[3 * DIN]); o.z = pkb(p[4 * DIN], p[5 * DIN]); o.w = pkb(p[6 * DIN], p[7 * DIN]); }
            *(v4u*)(F.WIN + (size_t)l * DINP * DM + (size_t)(DINB + j) * DM + 8 * kc) = o;
        }
    }
    {
        LAS float* cact = (LAS float*)(F.lds + 81920);
        for (int i = tid; i < NB * DM; i += NTHR) cact[i] = silu_f(F.c[i]);
        __syncthreads();
        const int gtid = blockIdx.x * NTHR + tid, NT = F.G * NTHR;
        constexpr int J4 = MODW / 4, KS = 8, KL = DM / KS;
        for (int i = gtid; i < DEPTH * KS * J4; i += NT) {
            const int j4 = i % J4, ks = (i / J4) % KS, l = i / (J4 * KS);
            const float* wp = F.w_mod + ((size_t)l * DM + ks * KL) * MODW + 4 * j4;
            const LAS float* cp = cact + ks * KL;
            f32x4 acc[NB];
#pragma unroll
            for (int b = 0; b < NB; ++b) acc[b] = (f32x4){0.f, 0.f, 0.f, 0.f};
            for (int k = 0; k < KL; k += 8) {
                f32x4 w[8];
#pragma unroll
                for (int u = 0; u < 8; ++u) w[u] = *(const f32x4*)(wp + (size_t)(k + u) * MODW);
#pragma unroll
                for (int u = 0; u < 8; ++u)
#pragma unroll
                    for (int b = 0; b < NB; ++b) acc[b] += cp[b * DM + k + u] * w[u];
            }
#pragma unroll
            for (int b = 0; b < NB; ++b) *(f32x4*)(F.PART + ((size_t)(ks * DEPTH + l) * NB + b) * MODW + 4 * j4) = acc[b];
        }
        __syncthreads();
    }
}

__device__ __forceinline__ void mod_reduce_phase(Frame& F) {
    PHASE_IDS;
    const int gtid = blockIdx.x * NTHR + tid, NT = F.G * NTHR;
    for (int i = gtid; i < DEPTH * NB * (MODW / 4); i += NT) {
        const int j4 = i % (MODW / 4), lb = i / (MODW / 4), l = lb / NB;
        f32x4 a = *(const f32x4*)(F.b_mod + (size_t)l * MODW + 4 * j4);
#pragma unroll
        for (int ks = 0; ks < 8; ++ks) a += *(const f32x4*)(F.PART + ((size_t)ks * DEPTH * NB + lb) * MODW + 4 * j4);
        *(f32x4*)(F.MOD + (size_t)lb * MODW + 4 * j4) = a;
    }
}

__device__ __forceinline__ void thin_phase(Frame& F, const float* xin, bool has_prev, const float* gate, const float* npost, float gscale,
                                           bool has_next, const float* npre, const float* sh, const float* sc) {
    PHASE_IDS;
    const int gw = F.vcu * NWAVES + wave, NGW = F.G * NWAVES;
    for (int row = gw; row < M; row += NGW) {
        const int b = row / SEQ;
        const f32x4* xr = (const f32x4*)(xin + (size_t)row * DM) + lane;
        f32x4 xv[8];
#pragma unroll
        for (int j = 0; j < 8; ++j) xv[j] = xr[64 * j];
        if (has_prev) {
            const f32x4* yr = (const f32x4*)(F.Y + (size_t)row * DM) + lane;
            f32x4 yv[8]; float ss = 0.f;
#pragma unroll
            for (int j = 0; j < 8; ++j) { yv[j] = yr[64 * j]; ss += (yv[j][0] * yv[j][0] + yv[j][1] * yv[j][1]) + (yv[j][2] * yv[j][2] + yv[j][3] * yv[j][3]); }
            const float r = 1.0f / sqrtf(wave_sum(ss) * (1.0f / DM) + EPS);
            const f32x4* gp = (const f32x4*)(gate + (size_t)b * MODW) + lane; const f32x4* np = (const f32x4*)npost + lane;
#pragma unroll
            for (int j = 0; j < 8; ++j) xv[j] += (gp[64 * j] * gscale) * ((yv[j] * r) * np[64 * j]);
        }
        f32x4* xo = (f32x4*)(F.X + (size_t)row * DM) + lane;
#pragma unroll
        for (int j = 0; j < 8; ++j) xo[64 * j] = xv[j];
        if (has_next) {
            float ss = 0.f;
#pragma unroll
            for (int j = 0; j < 8; ++j) ss += (xv[j][0] * xv[j][0] + xv[j][1] * xv[j][1]) + (xv[j][2] * xv[j][2] + xv[j][3] * xv[j][3]);
            const float r = 1.0f / sqrtf(wave_sum(ss) * (1.0f / DM) + EPS);
            const f32x4* np = (const f32x4*)npre + lane; const f32x4* shp = (const f32x4*)(sh + (size_t)b * MODW) + lane; const f32x4* scp = (const f32x4*)(sc + (size_t)b * MODW) + lane;
            u32x2* ho = (u32x2*)(F.HB + (size_t)row * DM) + lane;
#pragma unroll
            for (int j = 0; j < 8; ++j) { const f32x4 hv = ((xv[j] * r) * np[64 * j]) * (scp[64 * j] + 1.0f) + shp[64 * j];
                u32x2 w; w.x = pkb(hv[0], hv[1]); w.y = pkb(hv[2], hv[3]); ho[64 * j] = w; }
        }
    }
}

__device__ __forceinline__ void prep_phase(Frame& F, int l) {
    PHASE_IDS;
    const int gtid = blockIdx.x * NTHR + tid, NT = F.G * NTHR;
    for (int i = gtid; i < NB * NCH * SH; i += NT) {
        const int h = i & 15, c = (i >> 4) & 31, b = i >> 9;
        const float a = -__expf(F.a_log[l * SH + h]), bias = F.dt_bias[l * SH + h];
        const int r0 = b * SEQ + c * CHUNK; float acc = 0.f;
        for (int t = 0; t < CHUNK; ++t) { const float dt = softplus_f(F.DTF[(size_t)(r0 + t) * 32 + h] + bias); F.DT[(r0 + t) * 16 + h] = dt; acc += dt * a; F.ACS[(r0 + t) * 16 + h] = acc; }
    }
    {
        const int gwr = F.G * NWAVES - 1 - (blockIdx.x * NWAVES + wave), NGW = F.G * NWAVES;
        for (int i = gwr; i < NB * AH; i += NGW) {
            const int b = i / AH, h = i % AH; const float fb = F.f_bias[l * AH + h];
            float v[32]; float run = 0.f;
#pragma unroll
            for (int e = 0; e < 32; ++e) { const float xx = F.DTF[(size_t)(b * SEQ + 32 * lane + e) * 32 + 16 + h] + fb; run += -softplus_f(-xx); v[e] = run; }
            float inc = run;
#pragma unroll
            for (int o = 1; o < 64; o <<= 1) { const float t = __shfl_up(inc, o); if (lane >= o) inc += t; }
            const float excl = inc - run;
#pragma unroll
            for (int e = 0; e < 32; ++e) F.CUMF[(size_t)i * SEQ + 32 * lane + e] = excl + v[e];
        }
    }
    for (int i = gtid; i < M * (CONVD / 8); i += NT) {
        const int row = i / (CONVD / 8), g8 = i % (CONVD / 8), t = row % SEQ, c0 = 8 * g8;
        float acc[8];
        { const f32x4 b0 = *(const f32x4*)(F.conv_b + l * CONVD + c0), b1 = *(const f32x4*)(F.conv_b + l * CONVD + c0 + 4);
          acc[0] = b0[0]; acc[1] = b0[1]; acc[2] = b0[2]; acc[3] = b0[3]; acc[4] = b1[0]; acc[5] = b1[1]; acc[6] = b1[2]; acc[7] = b1[3]; }
#pragma unroll
        for (int k = 0; k < 4; ++k) {
            if (t - 3 + k >= 0) {
                const v4u u = *(const v4u*)(F.PROJ + (size_t)(row - 3 + k) * DINB + PC_X + c0);
                const f32x4 w0 = *(const f32x4*)(F.conv_w + (size_t)(l * 4 + k) * CONVD + c0), w1 = *(const f32x4*)(F.conv_w + (size_t)(l * 4 + k) * CONVD + c0 + 4);
                acc[0] += w0[0] * bflo(u.x); acc[1] += w0[1] * bfhi(u.x); acc[2] += w0[2] * bflo(u.y); acc[3] += w0[3] * bfhi(u.y);
                acc[4] += w1[0] * bflo(u.z); acc[5] += w1[1] * bfhi(u.z); acc[6] += w1[2] * bflo(u.w); acc[7] += w1[3] * bfhi(u.w);
            }
        }
        v4u o; o.x = pkb(silu_f(acc[0]), silu_f(acc[1])); o.y = pkb(silu_f(acc[2]), silu_f(acc[3])); o.z = pkb(silu_f(acc[4]), silu_f(acc[5])); o.w = pkb(silu_f(acc[6]), silu_f(acc[7]));
        *(v4u*)(F.XBC + (size_t)row * CONVD + c0) = o;
    }
}

__device__ __forceinline__ void ssd_states_phase(Frame& F, int l) {
    PHASE_IDS;
    LAS bf16* BT = (LAS bf16*)F.lds;
    LAS bf16* XsT = (LAS bf16*)(F.lds + 128 * 72 * 2) + wave * (64 * 72);
    const int fr = lane & 15, fq = lane >> 4;
    for (int unit = blockIdx.x; unit < NB * NCH * SG; unit += F.G) {
        const int g = unit & 1, c = (unit >> 1) & 31, b = unit >> 6, t0 = b * SEQ + c * CHUNK, h = g * HPG + wave;
        {   const int n = tid & 127, lq = tid >> 7; const bf16* src = F.XBC + (size_t)t0 * CONVD + PC_B - PC_X + 128 * g + n;
#pragma unroll
            for (int jj = 0; jj < 2; ++jj) { v4u w; unsigned ww[4];
#pragma unroll
                for (int e2 = 0; e2 < 4; ++e2) { const int l0 = 16 * lq + 8 * jj + 2 * e2; ww[e2] = (unsigned)src[(size_t)l0 * CONVD] | ((unsigned)src[(size_t)(l0 + 1) * CONVD] << 16); }
                w.x = ww[0]; w.y = ww[1]; w.z = ww[2]; w.w = ww[3];
                *(LAS v4u*)(BT + n * 72 + 16 * lq + 8 * jj) = w; } }
        {   const float dtl = F.DT[(t0 + lane) * 16 + h], al = F.ACS[(t0 + lane) * 16 + h], alast = F.ACS[(t0 + 63) * 16 + h];
            const float wl = dtl * __expf(alast - al);
            const bf16* src = F.XBC + (size_t)t0 * CONVD + 64 * h + lane;
#pragma unroll
            for (int jj = 0; jj < 8; ++jj) { unsigned ww[4];
#pragma unroll
                for (int e2 = 0; e2 < 4; ++e2) { const int l0 = 8 * jj + 2 * e2; ww[e2] = pkb(bf2f(src[(size_t)l0 * CONVD]) * rl(wl, l0), bf2f(src[(size_t)(l0 + 1) * CONVD]) * rl(wl, l0 + 1)); }
                v4u w; w.x = ww[0]; w.y = ww[1]; w.z = ww[2]; w.w = ww[3];
                *(LAS v4u*)(XsT + lane * 72 + 8 * jj) = w; } }
        __syncthreads();
        float* stp = F.ST + (size_t)((b * NCH + c) * SH + h) * (SP * SN);
#pragma unroll
        for (int nh = 0; nh < 2; ++nh) {
            f32x4 acc[4][4];
#pragma unroll
            for (int i = 0; i < 4; ++i)
#pragma unroll
                for (int j = 0; j < 4; ++j) acc[i][j] = (f32x4){0.f, 0.f, 0.f, 0.f};
#pragma unroll
            for (int ks = 0; ks < 2; ++ks) {
                bf16x8 xa[4], yb[4];
#pragma unroll
                for (int nt = 0; nt < 4; ++nt) xa[nt] = *(const LAS bf16x8*)(BT + (64 * nh + 16 * nt + fr) * 72 + 32 * ks + 8 * fq);
#pragma unroll
                for (int pt = 0; pt < 4; ++pt) yb[pt] = *(const LAS bf16x8*)(XsT + (16 * pt + fr) * 72 + 32 * ks + 8 * fq);
#pragma unroll
                for (int nt = 0; nt < 4; ++nt)
#pragma unroll
                    for (int pt = 0; pt < 4; ++pt) acc[nt][pt] = MFMA16(xa[nt], yb[pt], acc[nt][pt]);
            }
#pragma unroll
            for (int nt = 0; nt < 4; ++nt)
#pragma unroll
                for (int pt = 0; pt < 4; ++pt) *(f32x4*)(stp + (16 * pt + fr) * SN + 64 * nh + 16 * nt + 4 * fq) = acc[nt][pt];
        }
        __syncthreads();
    }
}

__device__ __forceinline__ void attn_naive_phase(Frame& F, int l) {
    PHASE_IDS;
    LAS float* sc = (LAS float*)F.lds + wave * SEQ;
    const int gw = blockIdx.x * NWAVES + wave, NGW = F.G * NWAVES;
    const float scale = 0.08838834764831845f;
    for (int item = gw; item < NB * AH * SEQ; item += NGW) {
        const int bh = item / SEQ, ii = item % SEQ, i = (bh & 1) ? SEQ - 1 - ii : ii, b = bh / AH, h = bh % AH, row = b * SEQ + i;
        v4u q[16];
#pragma unroll
        for (int cc = 0; cc < 16; ++cc) q[cc] = *(const v4u*)(F.PROJ + (size_t)row * DINB + PC_Q + AHD * h + 8 * cc);
        const float* cum = F.CUMF + (size_t)bh * SEQ; const float cumi = cum[i];
        float mx = -__builtin_inff();
        for (int j = lane; j <= i; j += 64) {
            const bf16* kp = F.PROJ + (size_t)(b * SEQ + j) * DINB + PC_K + AHD * h; float s = 0.f;
#pragma unroll
            for (int cc = 0; cc < 16; ++cc) { const v4u kv = *(const v4u*)(kp + 8 * cc);
                s += bflo(q[cc].x) * bflo(kv.x) + bfhi(q[cc].x) * bfhi(kv.x) + bflo(q[cc].y) * bflo(kv.y) + bfhi(q[cc].y) * bfhi(kv.y)
                   + bflo(q[cc].z) * bflo(kv.z) + bfhi(q[cc].z) * bfhi(kv.z) + bflo(q[cc].w) * bflo(kv.w) + bfhi(q[cc].w) * bfhi(kv.w); }
            s = s * scale + (cumi - cum[j]); sc[j] = s; mx = fmaxf(mx, s);
        }
        mx = wave_max(mx);
        float sum = 0.f;
        for (int j = lane; j <= i; j += 64) { const float p = __expf(sc[j] - mx); sc[j] = p; sum += p; }
        sum = wave_sum(sum);
        LDS_WAIT(); asm volatile("" ::: "memory");
        float o0 = 0.f, o1 = 0.f;
        const bf16* vp = F.PROJ + (size_t)(b * SEQ) * DINB + PC_V + AHD * h + 2 * lane;
#pragma unroll 4
        for (int j = 0; j <= i; ++j) { const float p = sc[j]; const unsigned vv = *(const unsigned*)(vp + (size_t)j * DINB); o0 += p * bflo(vv); o1 += p * bfhi(vv); }
        const float inv = 1.0f / sum; o0 *= inv; o1 *= inv;
        const float r = 1.0f / sqrtf(wave_sum(o0 * o0 + o1 * o1) * (1.0f / AHD) + EPS);
        const float* an = F.attn_norm + l * DATT + AHD * h + 2 * lane;
        *(unsigned*)(F.YCAT + (size_t)row * DM + DSSM + AHD * h + 2 * lane) = pkb(o0 * r * an[0], o1 * r * an[1]);
        LDS_WAIT(); asm volatile("" ::: "memory");
    }
}

__device__ __forceinline__ void ssd_scan_phase(Frame& F) {
    PHASE_IDS;
    const int gtid = blockIdx.x * NTHR + tid, NT = F.G * NTHR;
    for (int i = gtid; i < NB * SH * (SP * SN / 4); i += NT) {
        const int e4 = i & 2047, h = (i >> 11) & 15, b = i >> 15;
        f32x4 hs = (f32x4){0.f, 0.f, 0.f, 0.f};
#pragma unroll 4
        for (int c = 0; c < NCH; ++c) {
            f32x4* p = (f32x4*)(F.ST + (size_t)((b * NCH + c) * SH + h) * (SP * SN)) + e4;
            const f32x4 st = *p; const float dec = __expf(F.ACS[(b * SEQ + c * CHUNK + 63) * 16 + h]);
            *p = hs; hs = hs * dec + st;
        }
    }
}

__device__ __forceinline__ void ssd_out_phase(Frame& F, int l) {
    PHASE_IDS;
    LAS bf16* Cn = (LAS bf16*)F.lds;
    LAS bf16* Bn = Cn + 64 * 136;
    LAS bf16* XTb = Bn + 64 * 136;
    LAS bf16* Swb = XTb + 4 * 64 * 72;
    LAS float* ACSh = (LAS float*)(Swb + 8 * 32 * 72);
    LAS float* DTh = ACSh + 256;
    LAS float* SSP = DTh + 256;
    const int fr = lane & 15, fq = lane >> 4, w = wave, hh = w >> 1, lh = w & 1;
    LAS bf16* XT = XTb + hh * (64 * 72); LAS bf16* Sw = Swb + w * (32 * 72);
    for (int unit = blockIdx.x; unit < NB * NCH * SG; unit += F.G) {
        const int g = unit & 1, c = (unit >> 1) & 31, b = unit >> 6, t0 = b * SEQ + c * CHUNK;
#pragma unroll
        for (int i = 0; i < 2; ++i) { const int idx = tid + NTHR * i, row = idx >> 4, ch = idx & 15; const bf16* src = F.XBC + (size_t)(t0 + row) * CONVD + 128 * g + 8 * ch;
            *(LAS v4u*)(Bn + row * 136 + 8 * ch) = *(const v4u*)(src + (PC_B - PC_X));
            *(LAS v4u*)(Cn + row * 136 + 8 * ch) = *(const v4u*)(src + (PC_C - PC_X)); }
        f32x4 yv[2][2][4];
#pragma unroll
        for (int q = 0; q < 2; ++q) {
            const int h = g * HPG + 4 * q + hh;
            {   const bf16* src = F.XBC + (size_t)(t0 + 32 * lh) * CONVD + 64 * h + lane;
#pragma unroll
                for (int jj = 0; jj < 4; ++jj) { unsigned ww[4];
#pragma unroll
                    for (int e2 = 0; e2 < 4; ++e2) { const int s0 = 8 * jj + 2 * e2; ww[e2] = (unsigned)src[(size_t)s0 * CONVD] | ((unsigned)src[(size_t)(s0 + 1) * CONVD] << 16); }
                    v4u wv; wv.x = ww[0]; wv.y = ww[1]; wv.z = ww[2]; wv.w = ww[3];
                    *(LAS v4u*)(XT + lane * 72 + 32 * lh + 8 * jj) = wv; }
                if (lh == 0) { ACSh[hh * 64 + lane] = F.ACS[(t0 + lane) * 16 + h]; DTh[hh * 64 + lane] = F.DT[(t0 + lane) * 16 + h]; } }
            __syncthreads();
            const LAS float* acsv = ACSh + hh * 64; const LAS float* dtv = DTh + hh * 64;
#pragma unroll
            for (int ltl = 0; ltl < 2; ++ltl) {
                const int lrow = 32 * lh + 16 * ltl + fr; const float al = acsv[lrow];
                bf16x8 yc[4];
#pragma unroll
                for (int ks = 0; ks < 4; ++ks) yc[ks] = *(const LAS bf16x8*)(Cn + lrow * 136 + 32 * ks + 8 * fq);
#pragma unroll
                for (int st = 0; st < 4; ++st) {
                    f32x4 a = (f32x4){0.f, 0.f, 0.f, 0.f};
#pragma unroll
                    for (int ks = 0; ks < 4; ++ks) { const bf16x8 xb = *(const LAS bf16x8*)(Bn + (16 * st + fr) * 136 + 32 * ks + 8 * fq); a = MFMA16(xb, yc[ks], a); }
                    float v[4];
#pragma unroll
                    for (int j = 0; j < 4; ++j) { const int s = 16 * st + 4 * fq + j; v[j] = (s <= lrow) ? a[j] * __expf(al - acsv[s]) * dtv[s] : 0.f; }
                    u32x2 pw; pw.x = pkb(v[0], v[1]); pw.y = pkb(v[2], v[3]);
                    *(LAS u32x2*)(Sw + (16 * ltl + fr) * 72 + 16 * st + 4 * fq) = pw;
                }
            }
            __syncthreads();
            const float dsk = F.d_skip[l * SH + h];
            const float* prev = F.ST + (size_t)((b * NCH + c) * SH + h) * (SP * SN);
#pragma unroll
            for (int ltl = 0; ltl < 2; ++ltl) {
                const int lrow = 32 * lh + 16 * ltl + fr; const float eal = __expf(acsv[lrow]);
                bf16x8 ys[2], yc[4];
#pragma unroll
                for (int ks = 0; ks < 2; ++ks) ys[ks] = *(const LAS bf16x8*)(Sw + (16 * ltl + fr) * 72 + 32 * ks + 8 * fq);
#pragma unroll
                for (int ks = 0; ks < 4; ++ks) yc[ks] = *(const LAS bf16x8*)(Cn + lrow * 136 + 32 * ks + 8 * fq);
                float ssq = 0.f;
#pragma unroll
                for (int pt = 0; pt < 4; ++pt) {
                    f32x4 a = (f32x4){0.f, 0.f, 0.f, 0.f}, o = (f32x4){0.f, 0.f, 0.f, 0.f};
#pragma unroll
                    for (int ks = 0; ks < 2; ++ks) { const bf16x8 xx = *(const LAS bf16x8*)(XT + (16 * pt + fr) * 72 + 32 * ks + 8 * fq); a = MFMA16(xx, ys[ks], a); }
#pragma unroll
                    for (int ks = 0; ks < 4; ++ks) { const float* pp = prev + (16 * pt + fr) * SN + 32 * ks + 8 * fq; const f32x4 p0 = *(const f32x4*)pp, p1 = *(const f32x4*)(pp + 4);
                        v4u pk; pk.x = pkb(p0[0], p0[1]); pk.y = pkb(p0[2], p0[3]); pk.z = pkb(p1[0], p1[1]); pk.w = pkb(p1[2], p1[3]);
                        o = MFMA16(__builtin_bit_cast(bf16x8, pk), yc[ks], o); }
                    const int pc = 16 * pt + 4 * fq;
                    const u32x2 zz = *(const u32x2*)(F.PROJ + (size_t)(t0 + lrow) * DINB + PC_Z + 64 * h + pc);
                    f32x4 y;
                    y[0] = (a[0] + eal * o[0] + dsk * bf2f(XT[(pc + 0) * 72 + lrow])) * silu_f(bflo(zz.x));
                    y[1] = (a[1] + eal * o[1] + dsk * bf2f(XT[(pc + 1) * 72 + lrow])) * silu_f(bfhi(zz.x));
                    y[2] = (a[2] + eal * o[2] + dsk * bf2f(XT[(pc + 2) * 72 + lrow])) * silu_f(bflo(zz.y));
                    y[3] = (a[3] + eal * o[3] + dsk * bf2f(XT[(pc + 3) * 72 + lrow])) * silu_f(bfhi(zz.y));
                    yv[q][ltl][pt] = y; ssq += (y[0] * y[0] + y[1] * y[1]) + (y[2] * y[2] + y[3] * y[3]);
                }
                ssq += __shfl_xor(ssq, 16); ssq += __shfl_xor(ssq, 32);
                if (fq == 0) SSP[lrow * 8 + 4 * q + hh] = ssq;
            }
            __syncthreads();
        }
#pragma unroll
        for (int ltl = 0; ltl < 2; ++ltl) {
            const int lrow = 32 * lh + 16 * ltl + fr;
            const f32x4 s0 = *(const LAS f32x4*)(SSP + lrow * 8), s1 = *(const LAS f32x4*)(SSP + lrow * 8 + 4);
            const float r = 1.0f / sqrtf(((s0[0] + s0[1]) + (s0[2] + s0[3]) + (s1[0] + s1[1]) + (s1[2] + s1[3])) * (1.0f / 512.0f) + EPS);
#pragma unroll
            for (int q = 0; q < 2; ++q) { const int h = g * HPG + 4 * q + hh;
#pragma unroll
                for (int pt = 0; pt < 4; ++pt) { const int pc = 16 * pt + 4 * fq; const f32x4 wn = *(const f32x4*)(F.ssm_norm + l * DSSM + 64 * h + pc); const f32x4 y = yv[q][ltl][pt];
                    u32x2 ow; ow.x = pkb(y[0] * r * wn[0], y[1] * r * wn[1]); ow.y = pkb(y[2] * r * wn[2], y[3] * r * wn[3]);
                    *(u32x2*)(F.YCAT + (size_t)(t0 + lrow) * DM + 64 * h + pc) = ow; } }
        }
        __syncthreads();
    }
}

struct Args { const float* in[19]; float* out; unsigned char* ws; };
__global__ void __launch_bounds__(NWAVES * 64, 2) fwd_kernel(Args args) {
    extern __shared__ __attribute__((aligned(16))) unsigned char lds[];
    Frame F;
    F.lds = (LAS unsigned char*)lds;
    F.MISC = (volatile LAS unsigned*)(F.lds + MISC_OFF);
    F.G = gridDim.x; { const int bx = blockIdx.x; F.vcu = (F.G % 8 == 0) ? (bx % 8) * (F.G / 8) + bx / 8 : bx; }
    unsigned char* ws = args.ws;
    F.ctl = (gu32*)(ws + WS_CTL);
    F.x = args.in[0]; F.c = args.in[1]; F.norm_pre = args.in[2]; F.norm_post = args.in[3]; F.w_mod = args.in[4]; F.b_mod = args.in[5];
    F.w_gate = args.in[6]; F.w_up = args.in[7]; F.w_down = args.in[8]; F.w_in = args.in[9]; F.conv_w = args.in[10]; F.conv_b = args.in[11];
    F.dt_bias = args.in[12]; F.a_log = args.in[13]; F.d_skip = args.in[14]; F.ssm_norm = args.in[15]; F.f_bias = args.in[16]; F.attn_norm = args.in[17]; F.w_out = args.in[18];
    F.X = args.out; F.MOD = (float*)(ws + WS_MOD);
    F.WGU = (bf16*)(ws + WS_WGU); F.WDN = (bf16*)(ws + WS_WDN); F.WIN = (bf16*)(ws + WS_WIN); F.WOUT = (bf16*)(ws + WS_WOUT);
    F.HB = (bf16*)(ws + WS_HB); F.ACT = (bf16*)(ws + WS_ACT); F.PROJ = (bf16*)(ws + WS_ACT); F.XBC = (bf16*)(ws + WS_XBC); F.YCAT = (bf16*)(ws + WS_YCAT);
    F.Y = (float*)(ws + WS_Y); F.DTF = (float*)(ws + WS_DTF); F.DT = (float*)(ws + WS_DT); F.ACS = (float*)(ws + WS_ACS); F.CUMF = (float*)(ws + WS_CUMF); F.ST = (float*)(ws + WS_ST); F.PART = (float*)(ws + WS_PART);
    for (int u = threadIdx.x; u < (LDS_BYTES - LDSCTL_OFF) / 4; u += NWAVES * 64) ((LAS unsigned*)(F.lds + LDSCTL_OFF))[u] = 0u;
    __syncthreads();
    XcdBarrier bar = xcd_barrier_post((unsigned*)(F.ctl + CW_BAR), F.MISC + 8);
#define GRID_BAR() xcd_barrier(bar)

    p0_prologue(F);
    GRID_BAR();
    mod_reduce_phase(F);
    GRID_BAR();
    for (int s = 0; s <= 3 * DEPTH; ++s) {
        const bool has_prev = s > 0, has_next = s < 3 * DEPTH;
        const int l = s / 3, sub = s % 3, lp = has_prev ? (s - 1) / 3 : 0, subp = has_prev ? (s - 1) % 3 : 0;
        const int lc = has_next ? l : DEPTH - 1, subc = has_next ? sub : 0;
        thin_phase(F, s == 0 ? F.x : F.X, has_prev,
                   F.MOD + (size_t)lp * NB * MODW + (3 * subp + 2) * DM, F.norm_post + (lp * 3 + subp) * DM, subp == 1 ? 1.0f : 0.5f,
                   has_next, F.norm_pre + (lc * 3 + subc) * DM, F.MOD + (size_t)lc * NB * MODW + (3 * subc) * DM, F.MOD + (size_t)lc * NB * MODW + (3 * subc + 1) * DM);
        if (!has_next) break;
        GRID_BAR();
        if (sub != 1) {
            const int lf = l * 2 + (sub == 2 ? 1 : 0);
            pg8::Gemm g{F.HB, F.WGU + (size_t)lf * NGU * DM, M, NGU, DM}; pg8::StaticOrder S; S.init(M, NGU, F.G, (int)blockIdx.x);
            pg8::EpiSwiGLU E{F.ACT, DFF};
            pg8::gemm_phase<pg8::EpiSwiGLU, pg8::StaticOrder, true, true>(F.lds, g, S, E);
            GRID_BAR();
        } else {
            {   pg8::Gemm g{F.HB, F.WIN + (size_t)l * DINP * DM, M, DINP, DM}; pg8::StaticOrder S; S.init(M, DINP, F.G, (int)blockIdx.x);
                pg8::EpiProj E{F.PROJ, DINB, F.DTF, DINB / 256};
                pg8::gemm_phase<pg8::EpiProj, pg8::StaticOrder, true, true>(F.lds, g, S, E); }
            GRID_BAR();
            prep_phase(F, l);
            GRID_BAR();
            ssd_states_phase(F, l);
            attn_naive_phase(F, l);
            GRID_BAR();
            ssd_scan_phase(F);
            GRID_BAR();
            ssd_out_phase(F, l);
            GRID_BAR();
        }
        {   const bool mix = (sub == 1); const int lf = l * 2 + (sub == 2 ? 1 : 0);
            pg8::Gemm g{mix ? F.YCAT : F.ACT, mix ? F.WOUT + (size_t)l * DM * DM : F.WDN + (size_t)lf * DM * DFF, M, DM, mix ? DM : DFF}; pg8::StaticOrder S; S.init(M, DM, F.G, (int)blockIdx.x);
            pg8::EpiF32 E{F.Y, DM};
            pg8::gemm_phase<pg8::EpiF32, pg8::StaticOrder, true, true>(F.lds, g, S, E); }
        GRID_BAR();
    }
}

extern "C" void kernel_launch(void* const* d_in, const int* in_sizes, int n_in, void* d_out, int out_size, void* d_ws, size_t ws_size, hipStream_t stream) {
    static int grid = 0;
    if (grid == 0) {
        if (n_in != 19 || in_sizes[0] != M * DM || out_size != M * DM || ws_size < WS_END) { fprintf(stderr, "kernel_launch: unexpected shapes (n_in %d, in0 %d, out %d, ws %zu < %zu)\n", n_in, n_in > 0 ? in_sizes[0] : -1, out_size, ws_size, (size_t)WS_END); grid = -1; return; }
        int dev = 0, cus = 0, per_cu = 0;
        if (hipGetDevice(&dev) != hipSuccess || hipDeviceGetAttribute(&cus, hipDeviceAttributeMultiprocessorCount, dev) != hipSuccess) { grid = -1; return; }
        if (hipFuncSetAttribute((const void*)fwd_kernel, hipFuncAttributeMaxDynamicSharedMemorySize, LDS_BYTES) != hipSuccess) { fprintf(stderr, "kernel_launch: hipFuncSetAttribute failed\n"); grid = -1; return; }
        if (hipOccupancyMaxActiveBlocksPerMultiprocessor(&per_cu, (const void*)fwd_kernel, NWAVES * 64, LDS_BYTES) != hipSuccess || per_cu < 1) { fprintf(stderr, "kernel_launch: occupancy query says %d\n", per_cu); }
        (void)hipGetLastError();
        grid = cus;
    }
    if (grid < 0) return;
    if (hipMemsetAsync((char*)d_ws + WS_CTL, 0, CTL_ZERO_BYTES, stream) != hipSuccess) return;
    Args a{};
    for (int i = 0; i < 19; ++i) a.in[i] = (const float*)d_in[i];
    a.out = (float*)d_out; a.ws = (unsigned char*)d_ws;
    hipLaunchKernelGGL(fwd_kernel, dim3(grid), dim3(NWAVES * 64), LDS_BYTES, stream, a);
}
```

```cpp
#include <hip/hip_runtime.h>
#include <hip/hip_bf16.h>
#include <cstdio>
#include <cstdint>
namespace pg8 {
#define PG8_LAS __attribute__((address_space(3)))
typedef unsigned short bf16_t;
typedef short bf16x8 __attribute__((ext_vector_type(8)));
typedef float f32x4 __attribute__((ext_vector_type(4)));
typedef unsigned u32x4 __attribute__((ext_vector_type(4)));
constexpr int BM = 256, BK = 64, HALF = 128, HTB = HALF * BK * 2  , STAGE_BYTES = 8 * HTB, NXCD = 8, WGM = 8;

__host__ __device__ __forceinline__ int lds_byte(int r, int c) { const int st = (r >> 4) * 2 + (c >> 5), rr = r & 15, cc = c & 31, ob = rr * 64 + cc * 2; return st * 1024 + (ob ^ (((ob >> 9) & 1) << 5)); }
__host__ __device__ __forceinline__ void stage_rc(int b, int& R, int& C) { const int st = b / 1024, sb = b % 1024, swz = sb ^ (((sb >> 9) & 1) << 5); R = (st >> 1) * 16 + swz / 64; C = (st & 1) * 32 + (swz % 64) / 2; }
__host__ __device__ __forceinline__ int perm32(int rho) { const int n = rho >> 4, i = rho & 15; return 8 * (i >> 2) + 4 * n + (i & 3); }

struct Unit { int pm, pn; };
struct Gemm { const bf16_t* A; const bf16_t* Bt; int M, N, K; };

struct StaticOrder {
    int nM, nN, nwg, G, c;
    __host__ __device__ void init(int M, int N, int G_, int c_) { nM = M / BM; nN = N / BM; nwg = nM * nN; G = G_; c = c_; }
    __host__ __device__ bool next(int i, Unit& u) const {
        const long L = (long)i * G + c; if (L >= nwg) return false;
        int wgid = (int)L; { const int q = nwg / NXCD, r = nwg % NXCD, xcd = wgid % NXCD, off = wgid / NXCD; wgid = (xcd < r ? xcd * (q + 1) : r * (q + 1) + (xcd - r) * q) + off; }
        const int nig = WGM * nN, gid = wgid / nig, fm = gid * WGM, gsz = (nM - fm) < WGM ? (nM - fm) : WGM;
        u.pm = fm + ((wgid % nig) % gsz); u.pn = (wgid % nig) / gsz; return true;
    }
    __device__ __forceinline__ void a_ready(const Unit&) const {}
    __device__ __forceinline__ void done(const Unit&) const {}
};

__device__ __forceinline__ unsigned cvt_pk_bf16(float lo, float hi) { unsigned r; asm volatile("v_cvt_pk_bf16_f32 %0, %1, %2" : "=v"(r) : "v"(lo), "v"(hi)); return r; }
typedef float f32x2 __attribute__((ext_vector_type(2)));
typedef __bf16 bf16x2_t __attribute__((ext_vector_type(2)));
__device__ __forceinline__ unsigned pk_bf16(float lo, float hi) { f32x2 v = {lo, hi}; bf16x2_t b = __builtin_convertvector(v, bf16x2_t); return __builtin_bit_cast(unsigned, b); }
__device__ __forceinline__ float silu_f(float g) { return g * __builtin_amdgcn_rcpf(1.0f + __expf(-g)); }

struct EpiF32 {
    static constexpr bool PERM = false, AFTER_DRAIN = false;
    float* C; int ldc;
    __device__ __forceinline__ void operator()(const f32x4 (&acc)[2][2][4][2], const Unit& u, int wr, int wc, int fr, int fq) const {
        const int row0 = u.pm * BM + wr * 64 + fr, col0 = u.pn * BM + wc * 32 + 4 * fq;
#pragma unroll
        for (int ai = 0; ai < 2; ++ai)
#pragma unroll
            for (int m = 0; m < 4; ++m) { float* rowp = C + (size_t)(row0 + ai * HALF + m * 16) * ldc + col0;
#pragma unroll
                for (int bj = 0; bj < 2; ++bj)
#pragma unroll
                    for (int n = 0; n < 2; ++n) *(f32x4*)(rowp + bj * HALF + n * 16) = acc[ai][bj][m][n]; }
    }
};
struct EpiSwiGLU {
    static constexpr bool PERM = true, AFTER_DRAIN = false;
    bf16_t* O; int ldc;
    __device__ __forceinline__ void operator()(const f32x4 (&acc)[2][2][4][2], const Unit& u, int wr, int wc, int fr, int fq) const {
        const int row0 = u.pm * BM + wr * 64 + fr, col0 = u.pn * HALF + wc * 32 + 8 * fq;
#pragma unroll
        for (int ai = 0; ai < 2; ++ai)
#pragma unroll
            for (int m = 0; m < 4; ++m) { bf16_t* rowp = O + (size_t)(row0 + ai * HALF + m * 16) * ldc + col0;
                const f32x4 g0 = acc[ai][0][m][0], g1 = acc[ai][0][m][1], u0 = acc[ai][1][m][0], u1 = acc[ai][1][m][1];
                u32x4 w;
                w.x = pk_bf16(silu_f(g0[0]) * u0[0], silu_f(g0[1]) * u0[1]); w.y = pk_bf16(silu_f(g0[2]) * u0[2], silu_f(g0[3]) * u0[3]);
                w.z = pk_bf16(silu_f(g1[0]) * u1[0], silu_f(g1[1]) * u1[1]); w.w = pk_bf16(silu_f(g1[2]) * u1[2], silu_f(g1[3]) * u1[3]);
                *(u32x4*)rowp = w; }
    }
};
struct EpiProj {
    static constexpr bool PERM = true, AFTER_DRAIN = false;
    bf16_t* O; int ldc; float* dtf; int nbf;
    __device__ __forceinline__ void operator()(const f32x4 (&acc)[2][2][4][2], const Unit& u, int wr, int wc, int fr, int fq) const {
        const int row0 = u.pm * BM + wr * 64 + fr;
        if (u.pn < nbf) {
            const int col0 = u.pn * BM + wc * 32 + 8 * fq;
#pragma unroll
            for (int ai = 0; ai < 2; ++ai)
#pragma unroll
                for (int m = 0; m < 4; ++m) { bf16_t* rowp = O + (size_t)(row0 + ai * HALF + m * 16) * ldc + col0;
#pragma unroll
                    for (int bj = 0; bj < 2; ++bj) { const f32x4 v0 = acc[ai][bj][m][0], v1 = acc[ai][bj][m][1];
                        u32x4 w; w.x = pk_bf16(v0[0], v0[1]); w.y = pk_bf16(v0[2], v0[3]); w.z = pk_bf16(v1[0], v1[1]); w.w = pk_bf16(v1[2], v1[3]);
                        *(u32x4*)(rowp + bj * HALF) = w; } }
        } else if (wc == 0) {
#pragma unroll
            for (int ai = 0; ai < 2; ++ai)
#pragma unroll
                for (int m = 0; m < 4; ++m) { float* rp = dtf + (size_t)(row0 + ai * HALF + m * 16) * 32 + 8 * fq;
                    *(f32x4*)rp = acc[ai][0][m][0]; *(f32x4*)(rp + 4) = acc[ai][0][m][1]; }
        }
    }
};
template <class Epi, class Sched, bool ALIGN_EPI = false, bool SP2 = false>
__device__ __forceinline__ void gemm_phase(PG8_LAS unsigned char* lds, const Gemm g, const Sched& S, const Epi& E) {
    int tid_ = threadIdx.x; asm volatile("" : "+v"(tid_)); const int tid = tid_, wid = __builtin_amdgcn_readfirstlane(tid >> 6), lane = tid & 63, wr = wid >> 2, wc = wid & 3, fr = lane & 15, fq = lane >> 4;
    const int K = g.K, nt = K / BK;
    unsigned voffA[2], voffB[2];
#pragma unroll
    for (int i = 0; i < 2; ++i) { int R, C; stage_rc(tid * 16 + i * 8192, R, C); const int Rb = Epi::PERM ? ((R & ~31) + perm32(R & 31)) : R;
        voffA[i] = (unsigned)(R * K + C) * 2u; voffB[i] = (unsigned)(Rb * K + C) * 2u; }
    const size_t kstep = (size_t)(BK * 2);
    const size_t hstep = (size_t)HALF * K * 2;
    const size_t tstep = 2 * hstep;
    const unsigned ldsw = (unsigned)wid * 1024u;
    const int aoff = lds_byte(wr * 64 + fr, fq * 8), boff = lds_byte(wc * 32 + fr, fq * 8);
#define PG8_SA(b, h) (((b) * 2 + (h)) * HTB)
#define PG8_SB(b, h) ((4 + (b) * 2 + (h)) * HTB)
#define PG8_STAGE(bufoff, gbase, voff) do { _Pragma("unroll") for (int _i = 0; _i < 2; ++_i) \
        __builtin_amdgcn_global_load_lds((const unsigned*)((const char*)(gbase) + (voff)[_i]), (PG8_LAS unsigned*)(lds + (bufoff) + ldsw + _i * 8192), 16, 0, 0); } while (0)
#define PG8_LDA(dst, b, h) do { _Pragma("unroll") for (int m = 0; m < 4; ++m) _Pragma("unroll") for (int k = 0; k < 2; ++k) dst[m][k] = *(const PG8_LAS bf16x8*)(lds + PG8_SA(b, h) + aoff + m * 2048 + k * 1024); } while (0)
#define PG8_LDB(dst, b, h) do { _Pragma("unroll") for (int n = 0; n < 2; ++n) _Pragma("unroll") for (int k = 0; k < 2; ++k) dst[n][k] = *(const PG8_LAS bf16x8*)(lds + PG8_SB(b, h) + boff + n * 2048 + k * 1024); } while (0)
#define PG8_MMA(ai, bj, At, Bt) do { __builtin_amdgcn_s_setprio(1); _Pragma("unroll") for (int m = 0; m < 4; ++m) _Pragma("unroll") for (int n = 0; n < 2; ++n) _Pragma("unroll") for (int k = 0; k < 2; ++k) \
        acc[ai][bj][m][n] = __builtin_amdgcn_mfma_f32_16x16x32_bf16(Bt[n][k], At[m][k], acc[ai][bj][m][n], 0, 0, 0); __builtin_amdgcn_s_setprio(0); } while (0)
#define PG8_WAIT_V(n) asm volatile("s_waitcnt vmcnt(" #n ")" ::: "memory")
#define PG8_WAIT_L(n) asm volatile("s_waitcnt lgkmcnt(" #n ")" ::: "memory")
#define PG8_BAR __builtin_amdgcn_s_barrier()
#define PG8_SCHED __builtin_amdgcn_sched_barrier(0)
    Unit cur, nxt; int ui = 0;
    if (!S.next(0, cur)) return;
    f32x4 acc[2][2][4][2];
#pragma unroll
    for (int a = 0; a < 2; ++a)
#pragma unroll
        for (int b = 0; b < 2; ++b)
#pragma unroll
            for (int m = 0; m < 4; ++m)
#pragma unroll
                for (int n = 0; n < 2; ++n) acc[a][b][m][n] = (f32x4){0.f, 0.f, 0.f, 0.f};
    bf16x8 At[4][2], B0[2][2], B1[2][2];
    const char* cA = (const char*)g.A + (size_t)cur.pm * tstep; const char* cB = (const char*)g.Bt + (size_t)cur.pn * tstep;
    S.a_ready(cur);
    if constexpr (SP2) {
        PG8_STAGE(PG8_SB(0, 0), cB, voffB); PG8_STAGE(PG8_SB(0, 1), cB + hstep, voffB); PG8_STAGE(PG8_SA(0, 0), cA, voffA); PG8_STAGE(PG8_SA(0, 1), cA + hstep, voffA);
        if (wr == 1) PG8_BAR;
        PG8_WAIT_V(2); PG8_BAR;
        PG8_STAGE(PG8_SB(1, 0), cB + kstep, voffB); PG8_STAGE(PG8_SA(1, 0), cA + kstep, voffA); PG8_STAGE(PG8_SB(1, 1), cB + hstep + kstep, voffB);
        PG8_WAIT_V(6); PG8_BAR;
    } else {
        PG8_STAGE(PG8_SB(0, 0), cB, voffB); PG8_STAGE(PG8_SA(0, 0), cA, voffA); PG8_STAGE(PG8_SB(0, 1), cB + hstep, voffB); PG8_STAGE(PG8_SA(0, 1), cA + hstep, voffA);
        if (wr == 1) PG8_BAR;
        PG8_WAIT_V(4); PG8_BAR;
        PG8_STAGE(PG8_SB(1, 0), cB + kstep, voffB); PG8_STAGE(PG8_SA(1, 0), cA + kstep, voffA); PG8_STAGE(PG8_SB(1, 1), cB + hstep + kstep, voffB);
        PG8_WAIT_V(6); PG8_BAR;
    }
    for (;;) {
        const bool has_next = S.next(ui + 1, nxt);
        const char* nA = has_next ? (const char*)g.A + (size_t)nxt.pm * tstep : cA; const char* nB = has_next ? (const char*)g.Bt + (size_t)nxt.pn * tstep : cB;
        for (int t = 0; t < nt; t += 2) {
            const bool last = (t == nt - 2);
            const char* a1 = cA + (size_t)(t + 1) * kstep;
            const char* a2 = last ? nA : cA + (size_t)(t + 2) * kstep; const char* b2 = last ? nB : cB + (size_t)(t + 2) * kstep;
            const char* a3 = a2 + kstep; const char* b3 = b2 + kstep;
            if (last && has_next) S.a_ready(nxt);
            if constexpr (SP2) {
            PG8_LDB(B0, 0, 0); PG8_LDB(B1, 0, 1); PG8_SCHED; PG8_LDA(At, 0, 0); PG8_STAGE(PG8_SA(1, 1), a1 + hstep, voffA);
            PG8_WAIT_V(8); PG8_WAIT_L(0); PG8_BAR; PG8_MMA(0, 0, At, B0); PG8_MMA(0, 1, At, B1); PG8_BAR; PG8_SCHED;
            PG8_LDA(At, 0, 1); PG8_STAGE(PG8_SB(0, 0), b2, voffB); PG8_STAGE(PG8_SB(0, 1), b2 + hstep, voffB); PG8_STAGE(PG8_SA(0, 0), a2, voffA);
            PG8_WAIT_V(8); PG8_WAIT_L(0); PG8_BAR; PG8_MMA(1, 0, At, B0); PG8_MMA(1, 1, At, B1); PG8_BAR; PG8_SCHED;
            PG8_LDB(B0, 1, 0); PG8_LDB(B1, 1, 1); PG8_SCHED; PG8_LDA(At, 1, 0); PG8_STAGE(PG8_SA(0, 1), a2 + hstep, voffA);
            PG8_WAIT_V(8); PG8_WAIT_L(0); PG8_BAR; PG8_MMA(0, 0, At, B0); PG8_MMA(0, 1, At, B1); PG8_BAR; PG8_SCHED;
            PG8_LDA(At, 1, 1); PG8_STAGE(PG8_SB(1, 0), b3, voffB); PG8_STAGE(PG8_SB(1, 1), b3 + hstep, voffB); PG8_STAGE(PG8_SA(1, 0), a3, voffA);
            PG8_WAIT_V(8); PG8_WAIT_L(0); PG8_BAR; PG8_MMA(1, 0, At, B0); PG8_MMA(1, 1, At, B1); PG8_BAR; PG8_SCHED;
            } else {
            PG8_LDB(B0, 0, 0); PG8_SCHED; PG8_LDA(At, 0, 0); PG8_STAGE(PG8_SA(1, 1), a1 + hstep, voffA);
            PG8_WAIT_L(8); PG8_BAR; PG8_WAIT_L(0); PG8_MMA(0, 0, At, B0); PG8_BAR; PG8_SCHED;
            PG8_LDB(B1, 0, 1); PG8_STAGE(PG8_SB(0, 0), b2, voffB);
            PG8_BAR; PG8_WAIT_L(0); PG8_MMA(0, 1, At, B1); PG8_BAR;
            PG8_LDA(At, 0, 1); PG8_STAGE(PG8_SA(0, 0), a2, voffA);
            PG8_BAR; PG8_WAIT_L(0); PG8_MMA(1, 0, At, B0); PG8_BAR; PG8_SCHED;
            PG8_STAGE(PG8_SB(0, 1), b2 + hstep, voffB);
            PG8_WAIT_V(6); PG8_BAR; PG8_MMA(1, 1, At, B1); PG8_BAR;
            PG8_LDB(B0, 1, 0); PG8_SCHED; PG8_LDA(At, 1, 0); PG8_STAGE(PG8_SA(0, 1), a2 + hstep, voffA);
            PG8_WAIT_L(8); PG8_BAR; PG8_WAIT_L(0); PG8_MMA(0, 0, At, B0); PG8_BAR; PG8_SCHED;
            PG8_LDB(B1, 1, 1); PG8_STAGE(PG8_SB(1, 0), b3, voffB);
            PG8_BAR; PG8_WAIT_L(0); PG8_MMA(0, 1, At, B1); PG8_BAR;
            PG8_LDA(At, 1, 1); PG8_STAGE(PG8_SA(1, 0), a3, voffA);
            PG8_BAR; PG8_WAIT_L(0); PG8_MMA(1, 0, At, B0); PG8_BAR; PG8_SCHED;
            PG8_STAGE(PG8_SB(1, 1), b3 + hstep, voffB);
            PG8_WAIT_V(6); PG8_BAR; PG8_MMA(1, 1, At, B1); PG8_BAR;
            }
        }
        if constexpr (ALIGN_EPI) { if (wr == 0) PG8_BAR; }
        if constexpr (!Epi::AFTER_DRAIN) { E(acc, cur, wr, wc, fr, fq); S.done(cur); }
        if (!has_next) break;
#pragma unroll
        for (int a = 0; a < 2; ++a)
#pragma unroll
            for (int b = 0; b < 2; ++b)
#pragma unroll
                for (int m = 0; m < 4; ++m)
#pragma unroll
                    for (int n = 0; n < 2; ++n) acc[a][b][m][n] = (f32x4){0.f, 0.f, 0.f, 0.f};
        cur = nxt; cA = nA; cB = nB; ++ui;
        if constexpr (ALIGN_EPI) { if (wr == 1) PG8_BAR; }
    }
    PG8_WAIT_V(0);
    if constexpr (!ALIGN_EPI) { if (wr == 0) PG8_BAR; }
    PG8_BAR;
    if constexpr (Epi::AFTER_DRAIN) { E.fused(acc, cur, wr, wc, fr, fq, lds, wid, lane); S.done(cur); }
#undef PG8_SA
#undef PG8_SB
#undef PG8_STAGE
#undef PG8_LDA
#undef PG8_LDB
#undef PG8_MMA
#undef PG8_WAIT_V
#undef PG8_WAIT_L
#undef PG8_BAR
#undef PG8_SCHED
}
}

constexpr int NWAVES = 8, NTHR = NWAVES * 64;
constexpr int NB = 4, SEQ = 2048, DM = 2048, DEPTH = 4, M = NB * SEQ;
constexpr int CHUNK = 64, NCH = SEQ / CHUNK;
constexpr int DSSM = 1024, SP = 64, SH = 16, SG = 2, HPG = 8, SN = 128, CONVD = 1536;
constexpr int DATT = 1024, AHD = 128, AH = 8;
constexpr int DFF = 5632, NMOD = 9, MODW = NMOD * DM, NGU = 2 * DFF;
constexpr int DIN = 5656, DINB = 5632, DINP = 5888;
constexpr int PC_Z = 0, PC_X = 1024, PC_B = 2048, PC_C = 2304, PC_Q = 2560, PC_K = 3584, PC_V = 4608;
constexpr float EPS = 1e-6f;

constexpr size_t MiB = 1u << 20;
constexpr size_t WS_CTL = 0, CTL_ZERO_BYTES = 4 * MiB;
constexpr size_t WS_MOD = 1 * MiB;
constexpr size_t WS_WGU = 4 * MiB;
constexpr size_t WS_WDN = WS_WGU + (size_t)DEPTH * 2 * NGU * DM * 2;
constexpr size_t WS_WIN = WS_WDN + (size_t)DEPTH * 2 * DM * DFF * 2;
constexpr size_t WS_WOUT = WS_WIN + (size_t)DEPTH * DINP * DM * 2;
constexpr size_t WS_HB = WS_WOUT + (size_t)DEPTH * DM * DM * 2;
constexpr size_t WS_ACT = WS_HB + (size_t)M * DM * 2;
constexpr size_t WS_Y = WS_ACT + (size_t)M * DFF * 2;
constexpr size_t WS_DTF = WS_Y + (size_t)M * DM * 4;
constexpr size_t WS_XBC = WS_DTF + (size_t)M * 32 * 4;
constexpr size_t WS_DT = WS_XBC + (size_t)M * CONVD * 2;
constexpr size_t WS_ACS = WS_DT + (size_t)M * 16 * 4;
constexpr size_t WS_CUMF = WS_ACS + (size_t)M * 16 * 4;
constexpr size_t WS_ST = WS_CUMF + (size_t)NB * AH * SEQ * 4;
constexpr size_t WS_YCAT = WS_ST + (size_t)NB * NCH * SH * SP * SN * 4;
constexpr size_t WS_PART = WS_YCAT + (size_t)M * DM * 2;
constexpr size_t WS_END = WS_PART + (size_t)8 * DEPTH * NB * MODW * 4;
constexpr int CW_BAR = 4096;

constexpr int RING_BYTES = 131072;
constexpr int LDSCTL_OFF = RING_BYTES, MISC_OFF = LDSCTL_OFF + 320;
constexpr int LDS_BYTES = 147456;

#define GAS __attribute__((address_space(1)))
#define LAS __attribute__((address_space(3)))
typedef unsigned short bf16;
typedef unsigned v4u __attribute__((ext_vector_type(4)));
typedef float f32x4 __attribute__((ext_vector_type(4)));
typedef short bf16x8 __attribute__((ext_vector_type(8)));
typedef GAS unsigned gu32;
typedef GAS unsigned long long gu64;
#define RLX_AGENT __ATOMIC_RELAXED, __HIP_MEMORY_SCOPE_AGENT
#define LDS_WAIT() asm volatile("s_waitcnt lgkmcnt(0)" ::: "memory")
#define VM_WAIT() asm volatile("s_waitcnt vmcnt(0)" ::: "memory")
__device__ __forceinline__ unsigned long long rt() { return __builtin_amdgcn_s_memrealtime(); }
__device__ __forceinline__ unsigned f2bf(float f) { unsigned u = __builtin_bit_cast(unsigned, f); return (u + 0x7fffu + ((u >> 16) & 1u)) >> 16; }
__device__ __forceinline__ unsigned pk2(float lo, float hi) { return f2bf(lo) | (f2bf(hi) << 16); }

#define XB_TMO      128
#define XB_XCNT(j)  (256  + 64 * (j))
#define XB_XSUB(j)  (1280 + 64 * (j))
#define XB_XGEN(j)  (2304 + 64 * (j))
#define XB_TOP      3328
#define XB_TOPGEN   3392
#define XCD_BAR_WORDS 3456
#define XB_SPIN_CAP (1u << 18)

__device__ __forceinline__ unsigned xb_ld(unsigned* p)              { return __hip_atomic_load(p, __ATOMIC_RELAXED, __HIP_MEMORY_SCOPE_AGENT); }
__device__ __forceinline__ unsigned xb_add(unsigned* p, unsigned v) { return __hip_atomic_fetch_add(p, v, __ATOMIC_RELAXED, __HIP_MEMORY_SCOPE_AGENT); }
__device__ __forceinline__ unsigned xb_xcc_id() { return (unsigned)__builtin_amdgcn_s_getreg((3 << 11) | 20) & 0xFu; }
#define XB_SPIN(cond, bar) do { unsigned _sp = 0; while (cond) { __builtin_amdgcn_s_sleep(1); \
    if ((++_sp & 255u) == 0u) { if (xb_ld(&(bar)[XB_TMO])) break; if (_sp > XB_SPIN_CAP) { atomicAdd(&(bar)[XB_TMO], 1u); break; } } } } while (0)

struct XcdBarrier {
    unsigned* bar; unsigned x;
    volatile LAS unsigned* st;
};

__device__ __forceinline__ XcdBarrier xcd_barrier_post(unsigned* bar, volatile LAS unsigned* st) {
    XcdBarrier b; b.bar = bar; b.x = xb_xcc_id(); b.st = st;
    if (threadIdx.x == 0) (void)xb_add(&bar[XB_XCNT(b.x)], 1u);
    return b;
}
__device__ __forceinline__ void xcd_barrier_complete(unsigned* bar, unsigned x, unsigned& nloc, unsigned& nx) {
    const unsigned G = gridDim.x * gridDim.y * gridDim.z;
    unsigned sum, cnt, mine, sp = 0u;
    for (;;) {
        sum = 0u; cnt = 0u; mine = 0u;
#pragma unroll
        for (unsigned j = 0; j < 16; ++j) { const unsigned c = xb_ld(&bar[XB_XCNT(j)]); sum += c; cnt += (c > 0u) ? 1u : 0u; mine = (j == x) ? c : mine; }
        if (sum == G) break;
        __builtin_amdgcn_s_sleep(1);
        if ((++sp & 255u) == 0u) { if (xb_ld(&bar[XB_TMO])) break; if (sp > XB_SPIN_CAP) { atomicAdd(&bar[XB_TMO], 1u); break; } }
    }
    nloc = mine > 0u ? mine : 1u; nx = cnt > 0u ? cnt : 1u;
}

__device__ __forceinline__ void xcd_barrier(const XcdBarrier& b) {
    asm volatile("s_waitcnt vmcnt(0)" ::: "memory");
    __syncthreads();
    if (threadIdx.x == 0) {
        unsigned* bar = b.bar;
        __builtin_amdgcn_s_waitcnt(0);
        unsigned nloc = b.st[0], nx = b.st[1];
        if (nloc == 0u) { xcd_barrier_complete(bar, b.x, nloc, nx); b.st[0] = nloc; b.st[1] = nx; }
        const unsigned old = xb_add(&bar[XB_XSUB(b.x)], 1u);
        const unsigned gen = old / nloc;
        if (old + 1u == (gen + 1u) * nloc) {
            __builtin_amdgcn_fence(__ATOMIC_RELEASE, "agent");
            asm volatile("s_waitcnt vmcnt(0)" ::: "memory");
            const unsigned og = xb_add(&bar[XB_TOP], 1u);
            const unsigned tg = og / nx;
            if (og + 1u == (tg + 1u) * nx) xb_add(&bar[XB_TOPGEN], 1u);
            else XB_SPIN(xb_ld(&bar[XB_TOPGEN]) == tg, bar);
            __builtin_amdgcn_fence(__ATOMIC_ACQUIRE, "agent");
            xb_add(&bar[XB_XGEN(b.x)], 1u);
            asm volatile("s_waitcnt vmcnt(0)" ::: "memory");
        } else {
            XB_SPIN(xb_ld(&bar[XB_XGEN(b.x)]) == gen, bar);
            __builtin_amdgcn_fence(__ATOMIC_ACQUIRE, "agent");
            asm volatile("s_waitcnt vmcnt(0)" ::: "memory");
        }
    }
    __syncthreads();
}
namespace fa {
constexpr int D = 128, LDK = 5632, LDO = 2048;
constexpr bool WSKIP = false; constexpr float THR = 8.f; constexpr float NEPS = 1e-6f;
template <class A, class Bt> struct same_t { static constexpr bool v = false; };
template <class A> struct same_t<A, A> { static constexpr bool v = true; };
constexpr float SCALE = 0.08838834764831845f;
constexpr int NW = 8, QBLK = 32, KVBLK = 64, QB = NW * QBLK;
constexpr int SHM_V = KVBLK * D * 2, SHM_K = KVBLK * D * 2;
constexpr int LDS_BYTES = 2 * SHM_V + 2 * SHM_K + NW * 64 * 4;
using bf16 = __hip_bfloat16;
typedef short bf16x8 __attribute__((ext_vector_type(8)));
typedef short s16x4 __attribute__((ext_vector_type(4)));
typedef float f32x16 __attribute__((ext_vector_type(16)));
typedef float f32x4 __attribute__((ext_vector_type(4)));
typedef unsigned u32x4 __attribute__((ext_vector_type(4)));
#define KSWZ(row, colB) ((row) * 256 + ((colB) ^ (((row) & 7) << 4)))
#define SBAR() __builtin_amdgcn_sched_barrier(0)
__device__ __forceinline__ int v_st(int k, int c) { const int kk = (k & ~0xC) | ((k & 4) << 1) | ((k & 8) >> 1); return ((kk >> 3) * 4 + (c >> 5)) * 512 + ((kk & 7) * 32 + (c & 31)) * 2; }
__device__ __forceinline__ int v_rd_base(int lane) { return ((lane & 3) << 3) | (((lane >> 2) & 3) << 6) | (((lane >> 4) & 1) << 5) | (((lane >> 5) & 1) << 8); }
constexpr int v_rd_off(int d0, int ks, int half) { return d0 * 512 + ks * 4096 + half * 2048; }
__device__ __forceinline__ int crow(int r, int hi) { return (r & 3) + 8 * (r >> 2) + 4 * hi; }
__device__ __forceinline__ unsigned cvtpk(float lo, float hi) {
    unsigned r; asm volatile("v_cvt_pk_bf16_f32 %0, %1, %2" : "=v"(r) : "v"(lo), "v"(hi)); return r;
}
__device__ __forceinline__ bf16x8 pack8(f32x4 a, f32x4 b) {
    u32x4 w = {cvtpk(a[0], a[1]), cvtpk(a[2], a[3]), cvtpk(b[0], b[1]), cvtpk(b[2], b[3])};
    return *reinterpret_cast<bf16x8*>(&w);
}
template <class T> __device__ __forceinline__ bf16x8 load8(const T* p) {
    if constexpr (same_t<T, float>::v) { return pack8(*(const f32x4*)p, *(const f32x4*)(p + 4)); }
    else { return *reinterpret_cast<const bf16x8*>(p); }
}
__device__ __forceinline__ void mask_tile(f32x16& p0, f32x16& p1, int dq, unsigned W) {
    const float NEG = -__builtin_inff();
#pragma unroll
    for (int r = 0; r < 16; ++r) {
        const int c = (r & 3) + 8 * (r >> 2);
        if ((unsigned)(dq - c) >= W) p0[r] = NEG;
        if ((unsigned)(dq - c - 32) >= W) p1[r] = NEG;
    }
}
__device__ __forceinline__ void partialSM(f32x16& p0, f32x16& p1, float& m_reg, float& mn, float& alpha) {
    float pmax = p0[0]; for (int r = 1; r < 16; ++r) pmax = fmaxf(pmax, p0[r]); for (int r = 0; r < 16; ++r) pmax = fmaxf(pmax, p1[r]);
    { auto rr = __builtin_amdgcn_permlane32_swap(__float_as_uint(pmax), __float_as_uint(pmax), false, false);
      pmax = fmaxf(__uint_as_float(rr[0]), __uint_as_float(rr[1])); }
    constexpr float C2 = 1.4426950408889634f * SCALE;
    if (__builtin_expect(__all((pmax - m_reg) * SCALE <= THR), 1)) { mn = m_reg; alpha = 1.f; }
    else { mn = fmaxf(m_reg, pmax); alpha = __builtin_amdgcn_exp2f((m_reg - mn) * C2); m_reg = mn; }
    const float mnL = -mn * C2;
    for (int r = 0; r < 16; ++r) p0[r] = fmaf(p0[r], C2, mnL); for (int r = 0; r < 16; ++r) p1[r] = fmaf(p1[r], C2, mnL);
    for (int r = 0; r < 16; ++r) p0[r] = __builtin_amdgcn_exp2f(p0[r]);
}
__device__ __forceinline__ void finishSM(f32x16& p0, f32x16& p1, float alpha, float& l_reg, bf16x8& pa0, bf16x8& pa1, bf16x8& pa2, bf16x8& pa3) {
    for (int r = 0; r < 16; ++r) p1[r] = __builtin_amdgcn_exp2f(p1[r]);
    float ps = 0; for (int r = 0; r < 16; ++r) ps += p0[r]; for (int r = 0; r < 16; ++r) ps += p1[r];
    { auto rr = __builtin_amdgcn_permlane32_swap(__float_as_uint(ps), __float_as_uint(ps), false, false);
      ps = __uint_as_float(rr[0]) + __uint_as_float(rr[1]); }
    l_reg = l_reg * alpha + ps;
#define PK4(P, B_, OUT) do { unsigned a0 = cvtpk(P[B_+0], P[B_+1]), a1 = cvtpk(P[B_+2], P[B_+3]);                          \
        unsigned b0 = cvtpk(P[B_+4], P[B_+5]), b1 = cvtpk(P[B_+6], P[B_+7]);                                             \
        auto r0 = __builtin_amdgcn_permlane32_swap(a0, b0, false, false); auto r1 = __builtin_amdgcn_permlane32_swap(a1, b1, false, false); \
        u32x4 w = {r0[0], r1[0], r0[1], r1[1]}; OUT = *reinterpret_cast<bf16x8*>(&w); } while (0)
    PK4(p0, 0, pa0); PK4(p0, 8, pa1); PK4(p1, 0, pa2); PK4(p1, 8, pa3);
#undef PK4
}
template <int KB, bool SK>
__device__ __forceinline__ void qkt(f32x16& p0, f32x16& p1, const char* K_lds, int r32, int hi, const bf16x8* qr, bool act) {
    if (SK && !act) { const float NEG = -__builtin_inff();
#pragma unroll
        for (int r = 0; r < 16; ++r) { p0[r] = NEG; p1[r] = NEG; } return; }
    p0 = f32x16{}; p1 = f32x16{};
    const char* kb[4];
#pragma unroll
    for (int dd = 0; dd < 4; ++dd) kb[dd] = K_lds + KB * SHM_K + KSWZ(r32, (dd * 16 + hi * 8) * 2);
#pragma unroll
    for (int d0 = 0; d0 < 8; ++d0) { const char* a = kb[d0 & 3] + (d0 >> 2) * 128;
        bf16x8 b0 = *reinterpret_cast<const bf16x8*>(a);
        bf16x8 b1 = *reinterpret_cast<const bf16x8*>(a + 32 * 256);
        p0 = __builtin_amdgcn_mfma_f32_32x32x16_bf16(b0, qr[d0], p0, 0, 0, 0);
        p1 = __builtin_amdgcn_mfma_f32_32x32x16_bf16(b1, qr[d0], p1, 0, 0, 0); }
}
template <int VB, bool SK>
__device__ __forceinline__ void pv_tile(f32x16* o, int vb0, bf16x8 pa0, bf16x8 pa1, bf16x8 pa2, bf16x8 pa3, bool act) {
    if (SK && !act) return;
#define TRRD(dst, off) asm volatile("ds_read_b64_tr_b16 %0, %1 offset:%2" : "=&v"(dst) : "v"(vb0), "i"(off) : "memory")
#define PV_D0(d0) do { s16x4 l0, l1, l2, l3, h0, h1, h2, h3; constexpr int b_ = VB * SHM_V + v_rd_off(d0, 0, 0);     \
        TRRD(l0, b_); TRRD(h0, b_ + 2048); TRRD(l1, b_ + 4096); TRRD(h1, b_ + 6144); TRRD(l2, b_ + 8192); TRRD(h2, b_ + 10240); TRRD(l3, b_ + 12288); TRRD(h3, b_ + 14336); \
        asm volatile("s_waitcnt lgkmcnt(0)" ::: "memory"); SBAR();                 \
        o[d0] = __builtin_amdgcn_mfma_f32_32x32x16_bf16(pa0, (bf16x8){l0[0], l0[1], l0[2], l0[3], h0[0], h0[1], h0[2], h0[3]}, o[d0], 0, 0, 0);   \
        o[d0] = __builtin_amdgcn_mfma_f32_32x32x16_bf16(pa1, (bf16x8){l1[0], l1[1], l1[2], l1[3], h1[0], h1[1], h1[2], h1[3]}, o[d0], 0, 0, 0);   \
        o[d0] = __builtin_amdgcn_mfma_f32_32x32x16_bf16(pa2, (bf16x8){l2[0], l2[1], l2[2], l2[3], h2[0], h2[1], h2[2], h2[3]}, o[d0], 0, 0, 0);   \
        o[d0] = __builtin_amdgcn_mfma_f32_32x32x16_bf16(pa3, (bf16x8){l3[0], l3[1], l3[2], l3[3], h3[0], h3[1], h3[2], h3[3]}, o[d0], 0, 0, 0); } while (0)
    PV_D0(0); PV_D0(1); PV_D0(2); PV_D0(3);
#undef PV_D0
#undef TRRD
}
template <class TIn, class TOut> struct BlockRef { const TIn* Q; const TIn* K; const TIn* V; TOut* O; const float* G; int P0; };
template <class TIn> struct Seam {
    bf16x8 qr[8];
    bf16x8 st_v0, st_v1, st_k0, st_k1; f32x4 sf0, sf1, sf2, sf3;
    f32x4 tq[16];
};
__device__ __forceinline__ int swa_jlo(int P0, int W) { const int lowk = P0 - W + 1; return lowk > 0 ? lowk / KVBLK : 0; }
#define ROW(p, k0, rr) ((p) + (size_t)((k0) + (rr)) * LDK + sc)
#define VMW() asm volatile("s_waitcnt vmcnt(0)" ::: "memory")
#define VMWN(n) asm volatile("s_waitcnt vmcnt(%0)" :: "i"(n) : "memory")
#define SLOAD_H(Kp, Vp, k0) do { S.st_v0 = load8<TIn>(ROW(Vp, k0, sr)); S.st_v1 = load8<TIn>(ROW(Vp, k0, 32 + sr));              \
                         S.st_k0 = load8<TIn>(ROW(Kp, k0, sr)); S.st_k1 = load8<TIn>(ROW(Kp, k0, 32 + sr)); } while (0)
#define SWRITE_HK(bf) do { *(bf16x8*)(K_lds + (bf) * SHM_K + kws) = S.st_k0; *(bf16x8*)(K_lds + (bf) * SHM_K + kws + 32 * 256) = S.st_k1; } while (0)
#define SWRITE_HV(bf) do { *(bf16x8*)(V_lds + (bf) * SHM_V + vst0) = S.st_v0; *(bf16x8*)(V_lds + (bf) * SHM_V + vst1) = S.st_v1; } while (0)
#define SWRITE_H(bf) do { SWRITE_HV(bf); SWRITE_HK(bf); } while (0)
#define SLOAD_F(p, k0) do { S.sf0 = *(const f32x4*)ROW(p, k0, sr); S.sf1 = *(const f32x4*)(ROW(p, k0, sr) + 4);                \
                            S.sf2 = *(const f32x4*)ROW(p, k0, 32 + sr); S.sf3 = *(const f32x4*)(ROW(p, k0, 32 + sr) + 4); } while (0)
#define SWRITE_KF(bf) do { *(bf16x8*)(K_lds + (bf) * SHM_K + kws) = pack8(S.sf0, S.sf1); *(bf16x8*)(K_lds + (bf) * SHM_K + kws + 32 * 256) = pack8(S.sf2, S.sf3); } while (0)
#define SWRITE_VF(bf) do { *(bf16x8*)(V_lds + (bf) * SHM_V + vst0) = pack8(S.sf0, S.sf1); *(bf16x8*)(V_lds + (bf) * SHM_V + vst1) = pack8(S.sf2, S.sf3); } while (0)
template <class TIn, class TOut>
__device__ __forceinline__ void causal_swa_prime(const BlockRef<TIn, TOut>& cur, int W, char* lds, Seam<TIn>& S) {
    constexpr bool F32 = same_t<TIn, float>::v;
    int tid_ = threadIdx.x; asm volatile("" : "+v"(tid_)); const int tid = tid_, wid = __builtin_amdgcn_readfirstlane(tid >> 6), lane = tid & 63, r32 = lane & 31, hi = lane >> 5;
    const int sr = tid >> 4, sc = (tid & 15) * 8, kws = KSWZ(sr, sc * 2); char* K_lds = lds + 2 * SHM_V;
    const int kb0 = swa_jlo(cur.P0, W) * KVBLK;
    for (int d0 = 0; d0 < 8; ++d0) S.qr[d0] = load8<TIn>(cur.Q + (size_t)(wid * QBLK + r32) * LDK + d0 * 16 + hi * 8);
    if constexpr (F32) { SLOAD_F((const float*)cur.K, kb0); VMW(); SWRITE_KF(0); SBAR(); SLOAD_F((const float*)cur.V, kb0); }
    else { SLOAD_H(cur.K, cur.V, kb0); VMW(); SWRITE_HK(0); }
    __syncthreads();
}
template <class TIn, class TOut>
__device__ __forceinline__ void causal_swa_block(const BlockRef<TIn, TOut>& cur, const BlockRef<TIn, TOut>& nxt, int skv, int W, char* lds, Seam<TIn>& S) {
    constexpr bool F32 = same_t<TIn, float>::v;
    int tid_ = threadIdx.x; asm volatile("" : "+v"(tid_)); const int tid = tid_, wid = __builtin_amdgcn_readfirstlane(tid >> 6), lane = tid & 63, r32 = lane & 31, hi = lane >> 5;
    const int j_lo = swa_jlo(cur.P0, W);
    int j_hi = (cur.P0 + QB - 1) / KVBLK + 1; if (j_hi > skv / KVBLK) j_hi = skv / KVBLK;
    const int NT = j_hi - j_lo;
    const int kbn = swa_jlo(nxt.P0, W) * KVBLK;
    const int qlo = cur.P0 + wid * QBLK, qm = qlo + r32 - 4 * hi;
    char* V_lds = lds; char* K_lds = lds + 2 * SHM_V;
    float* ws = (float*)(lds + 2 * SHM_V + 2 * SHM_K) + wid * 64; float* li_l = ws, * al_l = ws + 32;
    float m_reg = -1e30f, l_reg = 0; f32x16 o[4] = {};
    const int sr = tid >> 4, sc = (tid & 15) * 8, vst0 = v_st(sr, sc), vst1 = v_st(32 + sr, sc), kws = KSWZ(sr, sc * 2);
    const int vb0 = (int)(uintptr_t)V_lds + v_rd_base(lane);
    const TIn* Kh = cur.K; const TIn* Vh = cur.V;
#define RESC(a) do { if (__any((a) < 1.f)) { if (hi == 0) al_l[r32] = (a); asm volatile("s_waitcnt lgkmcnt(0)" ::: "memory");              \
                     for (int d_ = 0; d_ < 4; ++d_) for (int r = 0; r < 16; ++r) o[d_][r] *= al_l[crow(r, hi)]; } } while (0)
#define KBASE(t) ((j_lo + (t)) * KVBLK)
#define ACT(t) (KBASE(t) <= qlo + QBLK - 1 && KBASE(t) + KVBLK - 1 >= qlo - W + 1)
#define MASKT(P0_, P1_, t) do { const int kb_ = KBASE(t); if ((!SK || ACT(t)) && (kb_ + KVBLK - 1 > qlo || kb_ <= qlo + QBLK - 1 - W)) mask_tile(P0_, P1_, qm - kb_, (unsigned)W); } while (0)
    const float* cks = (const float*)(lds + LDS_BYTES); const float cq = cks[qlo + r32];
#define BIAS(P0_, P1_, t) do { const float* ck_ = cks + KBASE(t) + 4 * hi; \
        _Pragma("unroll") for (int g_ = 0; g_ < 4; ++g_) { const f32x4 c0_ = *(const f32x4*)(ck_ + 8 * g_), c1_ = *(const f32x4*)(ck_ + 32 + 8 * g_); \
            _Pragma("unroll") for (int e_ = 0; e_ < 4; ++e_) { P0_[4 * g_ + e_] += cq - c0_[e_]; P1_[4 * g_ + e_] += cq - c1_[e_]; } } } while (0)
    constexpr int NQL = F32 ? 16 : 8;
    constexpr bool SK = WSKIP && !F32;
#define SEAM_K0() do { VMWN(NQL); if constexpr (F32) { SWRITE_KF(0); SBAR(); SLOAD_F((const float*)nxt.V, kbn); } else { SWRITE_HK(0); } SBAR(); } while (0)
    f32x16 pA0, pA1, pB0, pB1; float mnA, mnB, alA, alB; bf16x8 pa0, pa1, pa2, pa3;
    if constexpr (F32) { VMW(); SWRITE_VF(0); SBAR(); } else { SWRITE_HV(0); SBAR(); }
    if (NT > 1) { if constexpr (F32) SLOAD_F((const float*)Kh, KBASE(1)); else SLOAD_H(Kh, Vh, KBASE(1)); }
    SBAR(); qkt<0, SK>(pA0, pA1, K_lds, r32, hi, S.qr, ACT(0));
    if constexpr (F32) { if (NT > 1) { VMW(); SWRITE_KF(1); SBAR(); SLOAD_F((const float*)Vh, KBASE(1)); } }
    BIAS(pA0, pA1, 0); MASKT(pA0, pA1, 0); partialSM(pA0, pA1, m_reg, mnA, alA);
    if (NT > 1) { VMW(); if constexpr (F32) { SWRITE_VF(1); SBAR(); if (NT > 2) SLOAD_F((const float*)Kh, KBASE(2)); } else SWRITE_H(1); }
    __syncthreads();
#define HALF_STEP(PX0, PX1, mnX, alX, PY0, PY1, alY, t, KB, VB, SB) do {                                                      \
        SBAR(); qkt<KB, SK>(PX0, PX1, K_lds, r32, hi, S.qr, ACT(t));                                             \
        finishSM(PY0, PY1, alY, l_reg, pa0, pa1, pa2, pa3); SBAR();                                                           \
        if ((t) + 1 < NT) { if constexpr (F32) { VMW(); SWRITE_KF(SB); SBAR(); SLOAD_F((const float*)Vh, KBASE((t) + 1)); }  \
                            else { SLOAD_H(Kh, Vh, KBASE((t) + 1)); } SBAR(); }                                               \
        pv_tile<VB, SK>(o, vb0, pa0, pa1, pa2, pa3, ACT((t) - 1)); BIAS(PX0, PX1, (t)); MASKT(PX0, PX1, (t)); partialSM(PX0, PX1, m_reg, mnX, alX);                                        \
        __syncthreads();                                                                                                      \
        if ((t) + 1 < NT) { VMW(); if constexpr (F32) { SWRITE_VF(SB); SBAR(); if ((t) + 2 < NT) SLOAD_F((const float*)Kh, KBASE((t) + 2)); } \
                            else { SWRITE_H(SB); } }                                                                          \
        RESC(alX); __syncthreads(); } while (0)
    for (int t = 1; t + 1 < NT; t += 2) {
        HALF_STEP(pB0, pB1, mnB, alB, pA0, pA1, alA, t, 1, 0, 0);
        HALF_STEP(pA0, pA1, mnA, alA, pB0, pB1, alB, t + 1, 0, 1, 1);
    }
    const bool even = (NT & 1) == 0;
    if (even) { SBAR(); qkt<1, SK>(pB0, pB1, K_lds, r32, hi, S.qr, ACT(NT - 1)); SBAR(); }
#define QROW(e) (nxt.Q + (size_t)(wid * QBLK + r32) * LDK + ((e) >> 1) * 16 + hi * 8 + ((e) & 1) * 4)
    if constexpr (F32) { SLOAD_F((const float*)nxt.K, kbn); SBAR();
#pragma unroll
        for (int e = 0; e < 8; ++e) S.tq[e] = *(const f32x4*)QROW(e); }
    else { SLOAD_H(nxt.K, nxt.V, kbn); SBAR();
#pragma unroll
        for (int d0 = 0; d0 < 8; ++d0) S.qr[d0] = load8<TIn>(nxt.Q + (size_t)(wid * QBLK + r32) * LDK + d0 * 16 + hi * 8); }
    SBAR();
    finishSM(pA0, pA1, alA, l_reg, pa0, pa1, pa2, pa3); SBAR();
    if constexpr (F32) {
#pragma unroll
        for (int e = 8; e < 16; ++e) S.tq[e] = *(const f32x4*)QROW(e); SBAR(); }
#undef QROW
    pv_tile<0, SK>(o, vb0, pa0, pa1, pa2, pa3, ACT(even ? NT - 2 : NT - 1));
    if (even) { BIAS(pB0, pB1, NT - 1); MASKT(pB0, pB1, NT - 1); partialSM(pB0, pB1, m_reg, mnB, alB); __syncthreads(); RESC(alB);
        finishSM(pB0, pB1, alB, l_reg, pa0, pa1, pa2, pa3); SBAR(); pv_tile<1, SK>(o, vb0, pa0, pa1, pa2, pa3, ACT(NT - 1)); }
    SBAR(); SEAM_K0();
    if (hi == 0) li_l[r32] = l_reg; asm volatile("s_waitcnt lgkmcnt(0)" ::: "memory");
    float rli[16];
#pragma unroll
    for (int r = 0; r < 16; ++r) rli[r] = __builtin_amdgcn_rcpf(li_l[crow(r, hi)]);
    TOut* Ow = cur.O + (size_t)(wid * QBLK) * LDO;
    const float gw0 = cur.G[r32], gw1 = cur.G[32 + r32], gw2 = cur.G[64 + r32], gw3 = cur.G[96 + r32];
#pragma unroll
    for (int r = 0; r < 16; ++r) { const int orow = crow(r, hi);
        float v0 = o[0][r] * rli[r], v1 = o[1][r] * rli[r], v2 = o[2][r] * rli[r], v3 = o[3][r] * rli[r];
        float ss = (v0 * v0 + v1 * v1) + (v2 * v2 + v3 * v3);
        ss += __shfl_xor(ss, 1); ss += __shfl_xor(ss, 2); ss += __shfl_xor(ss, 4); ss += __shfl_xor(ss, 8); ss += __shfl_xor(ss, 16);
        const float rn = 1.0f / sqrtf(ss * (1.0f / 128.0f) + NEPS);
        v0 *= rn * gw0; v1 *= rn * gw1; v2 *= rn * gw2; v3 *= rn * gw3;
        const float n0 = __shfl_xor(v0, 1), n1 = __shfl_xor(v1, 1), n2 = __shfl_xor(v2, 1), n3 = __shfl_xor(v3, 1);
        if ((r32 & 1) == 0) { TOut* op = Ow + (size_t)orow * LDO + r32;
            *(unsigned*)(op) = cvtpk(v0, n0); *(unsigned*)(op + 32) = cvtpk(v1, n1); *(unsigned*)(op + 64) = cvtpk(v2, n2); *(unsigned*)(op + 96) = cvtpk(v3, n3); } }
    if constexpr (F32) {
#pragma unroll
        for (int d0 = 0; d0 < 8; ++d0) S.qr[d0] = pack8(S.tq[2 * d0], S.tq[2 * d0 + 1]); }
    __syncthreads();
#undef RESC
#undef KBASE
#undef ACT
#undef MASKT
#undef BIAS
#undef SEAM_K0
#undef HALF_STEP
}
#undef ROW
#undef VMW
#undef VMWN
#undef SLOAD_H
#undef SWRITE_HK
#undef SWRITE_HV
#undef SWRITE_H
#undef SLOAD_F
#undef SWRITE_KF
#undef SWRITE_VF

#undef KSWZ
#undef SBAR
}

typedef unsigned u32x2 __attribute__((ext_vector_type(2)));
struct Frame {
    LAS unsigned char* lds;
    volatile LAS unsigned* MISC;
    unsigned char* ws;
    float* X;
    int vcu, G;
};
static_assert(19 * 8 <= 320, "pointer table fits below MISC");
enum { I_x, I_c, I_norm_pre, I_norm_post, I_w_mod, I_b_mod, I_w_gate, I_w_up, I_w_down, I_w_in, I_conv_w, I_conv_b, I_dt_bias, I_a_log, I_d_skip, I_ssm_norm, I_f_bias, I_attn_norm, I_w_out, I_N };
__device__ __forceinline__ const float* inp(const Frame& F, int k) {
    const LAS unsigned* t = (const LAS unsigned*)(F.lds + LDSCTL_OFF) + 2 * k;
    const unsigned lo = __builtin_amdgcn_readfirstlane(t[0]), hi = __builtin_amdgcn_readfirstlane(t[1]);
    return (const float*)(const GAS float*)(((unsigned long long)hi << 32) | lo);
}
template <class T> __device__ __forceinline__ T* wsp(const Frame& F, size_t off) { GAS unsigned char* p = (GAS unsigned char*)F.ws; asm volatile("" : "+s"(p)); return (T*)(GAS T*)(p + off); }

__device__ __forceinline__ float bf2f(unsigned short u) { return __uint_as_float((unsigned)u << 16); }
__device__ __forceinline__ float bflo(unsigned w) { return __uint_as_float(w << 16); }
__device__ __forceinline__ float bfhi(unsigned w) { return __uint_as_float(w & 0xffff0000u); }
__device__ __forceinline__ float wave_sum(float v) {
#pragma unroll
    for (int o = 1; o < 64; o <<= 1) v += __shfl_xor(v, o);
    return v;
}
__device__ __forceinline__ float wave_max(float v) {
#pragma unroll
    for (int o = 1; o < 64; o <<= 1) v = fmaxf(v, __shfl_xor(v, o));
    return v;
}
__device__ __forceinline__ float softplus_f(float x) { return fmaxf(x, 0.f) + log1pf(__expf(-fabsf(x))); }
__device__ __forceinline__ float silu_f(float g) { return g * __builtin_amdgcn_rcpf(1.0f + __expf(-g)); }
__device__ __forceinline__ unsigned pkb(float lo, float hi) { return pg8::pk_bf16(lo, hi); }
__device__ __forceinline__ float rl(float v, int l) { return __int_as_float(__builtin_amdgcn_readlane(__float_as_int(v), l)); }
__device__ __forceinline__ int fresh_tid() { int t = threadIdx.x; asm volatile("" : "+v"(t)); return t; }
#define PHASE_IDS const int tid = fresh_tid(), lane = tid & 63, wave = __builtin_amdgcn_readfirstlane(tid >> 6); (void)tid; (void)lane; (void)wave
#define MFMA16(a, b, c) __builtin_amdgcn_mfma_f32_16x16x32_bf16((a), (b), (c), 0, 0, 0)

__device__ __forceinline__ void tr_item(const float* __restrict__ W, int N, int srccol0, bf16* __restrict__ WT, int K, int drow0, int k0, LAS unsigned* T, int lane) {
    const int r = lane >> 4, q = lane & 15;
    f32x4 a[8], b[8];
#pragma unroll
    for (int i = 0; i < 8; ++i) { const int kp = 4 * i + r; const float* p = W + (size_t)(k0 + 2 * kp) * N + srccol0 + 4 * q; a[i] = *(const f32x4*)p; b[i] = *(const f32x4*)(p + N); }
#pragma unroll
    for (int i = 0; i < 8; ++i) { const int kp = 4 * i + r; LAS unsigned* t = T + kp * 65 + 4 * q;
        t[0] = pkb(a[i][0], b[i][0]); t[1] = pkb(a[i][1], b[i][1]); t[2] = pkb(a[i][2], b[i][2]); t[3] = pkb(a[i][3], b[i][3]); }
    LDS_WAIT(); asm volatile("" ::: "memory");
    const int c = lane & 7;
#pragma unroll
    for (int i = 0; i < 8; ++i) { const int n = 8 * i + (lane >> 3); const LAS unsigned* t = T + (4 * c) * 65 + n;
        v4u o; o.x = t[0]; o.y = t[65]; o.z = t[130]; o.w = t[195];
        *(v4u*)(WT + (size_t)(drow0 + n) * K + k0 + 8 * c) = o; }
    LDS_WAIT(); asm volatile("" ::: "memory");
}
__device__ __forceinline__ void p0_prologue(Frame& F) {
    PHASE_IDS;
    const int gw = F.vcu * NWAVES + wave, NGW = F.G * NWAVES;
    {
        LAS unsigned* T = (LAS unsigned*)(F.lds) + wave * (32 * 65);
        constexpr int I_FF = (DM / 64) * (DFF / 64);
        constexpr int I_OUT = (DM / 64) * (DM / 64);
        constexpr int E_G = 8 * I_FF, E_U = 16 * I_FF, E_D = 24 * I_FF, E_I = 28 * I_FF, E_O = E_I + 4 * I_OUT;
        for (int it = gw; it < E_O; it += NGW) {
            if (it < E_U) {
                const int up = it >= E_G ? 1 : 0, r0 = it - up * E_G, lf = r0 / I_FF, r = r0 % I_FF, kb = r / 88, nb = r % 88;
                const float* W = (up ? inp(F, I_w_up) : inp(F, I_w_gate)) + (size_t)lf * DM * DFF;
                tr_item(W, DFF, 64 * nb, wsp<bf16>(F, WS_WGU) + (size_t)lf * NGU * DM, DM, (nb >> 1) * 256 + (nb & 1) * 64 + up * 128, 64 * kb, T, lane);
            } else if (it < E_D) {
                const int r0 = it - E_U, lf = r0 / I_FF, r = r0 % I_FF, kb = r / 32, nb = r % 32;
                tr_item(inp(F, I_w_down) + (size_t)lf * DFF * DM, DM, 64 * nb, wsp<bf16>(F, WS_WDN) + (size_t)lf * DM * DFF, DFF, 64 * nb, 64 * kb, T, lane);
            } else if (it < E_I) {
                const int r0 = it - E_D, l = r0 / I_FF, r = r0 % I_FF, kb = r / 88, nb = r % 88;
                const int src = 64 * nb + (64 * nb >= 2560 ? 16 : 0);
                tr_item(inp(F, I_w_in) + (size_t)l * DM * DIN, DIN, src, wsp<bf16>(F, WS_WIN) + (size_t)l * DINP * DM, DM, 64 * nb, 64 * kb, T, lane);
            } else {
                const int r0 = it - E_I, l = r0 / I_OUT, r = r0 % I_OUT, kb = r / 32, nb = r % 32;
                tr_item(inp(F, I_w_out) + (size_t)l * DM * DM, DM, 64 * nb, wsp<bf16>(F, WS_WOUT) + (size_t)l * DM * DM, DM, 64 * nb, 64 * kb, T, lane);
            }
        }
        const int gtid = blockIdx.x * NTHR + tid, NT = F.G * NTHR;
        for (int i = gtid; i < DEPTH * 256 * 256; i += NT) {
            const int kc = i & 255, j = (i >> 8) & 255, l = i >> 16;
            const int src = j < 16 ? 2560 + j : (j < 24 ? 5648 + (j - 16) : -1);
            v4u o = {0u, 0u, 0u, 0u};
            if (src >= 0) { const float* p = inp(F, I_w_in) + (size_t)l * DM * DIN + (size_t)(8 * kc) * DIN + src;
                o.x = pkb(p[0], p[DIN]); o.y = pkb(p[2 * DIN], p[3 * DIN]); o.z = pkb(p[4 * DIN], p[5 * DIN]); o.w = pkb(p[6 * DIN], p[7 * DIN]); }
            *(v4u*)(wsp<bf16>(F, WS_WIN) + (size_t)l * DINP * DM + (size_t)(DINB + j) * DM + 8 * kc) = o;
        }
    }
    {
        LAS float* cact = (LAS float*)(F.lds + 81920);
        for (int i = tid; i < NB * DM; i += NTHR) cact[i] = silu_f(inp(F, I_c)[i]);
        __syncthreads();
        const int gtid = blockIdx.x * NTHR + tid, NT = F.G * NTHR;
        constexpr int J4 = MODW / 4, KS = 8, KL = DM / KS;
        for (int i = gtid; i < DEPTH * KS * J4; i += NT) {
            const int j4 = i % J4, ks = (i / J4) % KS, l = i / (J4 * KS);
            const float* wp = inp(F, I_w_mod) + ((size_t)l * DM + ks * KL) * MODW + 4 * j4;
            const LAS float* cp = cact + ks * KL;
            f32x4 acc[NB];
#pragma unroll
            for (int b = 0; b < NB; ++b) acc[b] = (f32x4){0.f, 0.f, 0.f, 0.f};
            for (int k = 0; k < KL; k += 8) {
                f32x4 w[8];
#pragma unroll
                for (int u = 0; u < 8; ++u) w[u] = *(const f32x4*)(wp + (size_t)(k + u) * MODW);
#pragma unroll
                for (int u = 0; u < 8; ++u)
#pragma unroll
                    for (int b = 0; b < NB; ++b) acc[b] += cp[b * DM + k + u] * w[u];
            }
#pragma unroll
            for (int b = 0; b < NB; ++b) *(f32x4*)(wsp<float>(F, WS_PART) + ((size_t)(ks * DEPTH + l) * NB + b) * MODW + 4 * j4) = acc[b];
        }
        __syncthreads();
    }
}

__device__ __forceinline__ void mod_reduce_phase(Frame& F) {
    PHASE_IDS;
    const int gtid = blockIdx.x * NTHR + tid, NT = F.G * NTHR;
    for (int i = gtid; i < DEPTH * NB * (MODW / 4); i += NT) {
        const int j4 = i % (MODW / 4), lb = i / (MODW / 4), l = lb / NB;
        f32x4 a = *(const f32x4*)(inp(F, I_b_mod) + (size_t)l * MODW + 4 * j4);
#pragma unroll
        for (int ks = 0; ks < 8; ++ks) a += *(const f32x4*)(wsp<float>(F, WS_PART) + ((size_t)ks * DEPTH * NB + lb) * MODW + 4 * j4);
        *(f32x4*)(wsp<float>(F, WS_MOD) + (size_t)lb * MODW + 4 * j4) = a;
    }
}

__device__ __forceinline__ void thin_phase(Frame& F, const float* xin, bool has_prev, const float* gate, const float* npost, float gscale,
                                           bool has_next, const float* npre, const float* sh, const float* sc) {
    PHASE_IDS;
    const int gw = F.vcu * NWAVES + wave, NGW = F.G * NWAVES;
    for (int row = gw; row < M; row += NGW) {
        const int b = row / SEQ;
        const f32x4* xr = (const f32x4*)(xin + (size_t)row * DM) + lane;
        f32x4 xv[8];
#pragma unroll
        for (int j = 0; j < 8; ++j) xv[j] = xr[64 * j];
        if (has_prev) {
            const f32x4* yr = (const f32x4*)(wsp<float>(F, WS_Y) + (size_t)row * DM) + lane;
            f32x4 yv[8]; float ss = 0.f;
#pragma unroll
            for (int j = 0; j < 8; ++j) { yv[j] = yr[64 * j]; ss += (yv[j][0] * yv[j][0] + yv[j][1] * yv[j][1]) + (yv[j][2] * yv[j][2] + yv[j][3] * yv[j][3]); }
            const float r = 1.0f / sqrtf(wave_sum(ss) * (1.0f / DM) + EPS);
            const f32x4* gp = (const f32x4*)(gate + (size_t)b * MODW) + lane; const f32x4* np = (const f32x4*)npost + lane;
#pragma unroll
            for (int j = 0; j < 8; ++j) xv[j] += (gp[64 * j] * gscale) * ((yv[j] * r) * np[64 * j]);
        }
        f32x4* xo = (f32x4*)(F.X + (size_t)row * DM) + lane;
#pragma unroll
        for (int j = 0; j < 8; ++j) xo[64 * j] = xv[j];
        if (has_next) {
            float ss = 0.f;
#pragma unroll
            for (int j = 0; j < 8; ++j) ss += (xv[j][0] * xv[j][0] + xv[j][1] * xv[j][1]) + (xv[j][2] * xv[j][2] + xv[j][3] * xv[j][3]);
            const float r = 1.0f / sqrtf(wave_sum(ss) * (1.0f / DM) + EPS);
            const f32x4* np = (const f32x4*)npre + lane; const f32x4* shp = (const f32x4*)(sh + (size_t)b * MODW) + lane; const f32x4* scp = (const f32x4*)(sc + (size_t)b * MODW) + lane;
            u32x2* ho = (u32x2*)(wsp<bf16>(F, WS_HB) + (size_t)row * DM) + lane;
#pragma unroll
            for (int j = 0; j < 8; ++j) { const f32x4 hv = ((xv[j] * r) * np[64 * j]) * (scp[64 * j] + 1.0f) + shp[64 * j];
                u32x2 w; w.x = pkb(hv[0], hv[1]); w.y = pkb(hv[2], hv[3]); ho[64 * j] = w; }
        }
    }
}

__device__ __forceinline__ void prep_phase(Frame& F, int l) {
    PHASE_IDS;
    const int gtid = blockIdx.x * NTHR + tid, NT = F.G * NTHR;
    for (int i = gtid; i < NB * NCH * SH; i += NT) {
        const int h = i & 15, c = (i >> 4) & 31, b = i >> 9;
        const float a = -__expf(inp(F, I_a_log)[l * SH + h]), bias = inp(F, I_dt_bias)[l * SH + h];
        const int r0 = b * SEQ + c * CHUNK; float acc = 0.f;
        for (int t = 0; t < CHUNK; ++t) { const float dt = softplus_f(wsp<float>(F, WS_DTF)[(size_t)(r0 + t) * 32 + h] + bias); wsp<float>(F, WS_DT)[(r0 + t) * 16 + h] = dt; acc += dt * a; wsp<float>(F, WS_ACS)[(r0 + t) * 16 + h] = acc; }
    }
    {
        const int gwr = F.G * NWAVES - 1 - (blockIdx.x * NWAVES + wave), NGW = F.G * NWAVES;
        for (int i = gwr; i < NB * AH; i += NGW) {
            const int b = i / AH, h = i % AH; const float fb = inp(F, I_f_bias)[l * AH + h];
            float v[32]; float run = 0.f;
#pragma unroll
            for (int e = 0; e < 32; ++e) { const float xx = wsp<float>(F, WS_DTF)[(size_t)(b * SEQ + 32 * lane + e) * 32 + 16 + h] + fb; run += -softplus_f(-xx); v[e] = run; }
            float inc = run;
#pragma unroll
            for (int o = 1; o < 64; o <<= 1) { const float t = __shfl_up(inc, o); if (lane >= o) inc += t; }
            const float excl = inc - run;
#pragma unroll
            for (int e = 0; e < 32; ++e) wsp<float>(F, WS_CUMF)[(size_t)i * SEQ + 32 * lane + e] = (excl + v[e]) * 11.313708498984761f;
        }
    }
    for (int i = gtid; i < M * (CONVD / 8); i += NT) {
        const int row = i / (CONVD / 8), g8 = i % (CONVD / 8), t = row % SEQ, c0 = 8 * g8;
        float acc[8];
        { const f32x4 b0 = *(const f32x4*)(inp(F, I_conv_b) + l * CONVD + c0), b1 = *(const f32x4*)(inp(F, I_conv_b) + l * CONVD + c0 + 4);
          acc[0] = b0[0]; acc[1] = b0[1]; acc[2] = b0[2]; acc[3] = b0[3]; acc[4] = b1[0]; acc[5] = b1[1]; acc[6] = b1[2]; acc[7] = b1[3]; }
#pragma unroll
        for (int k = 0; k < 4; ++k) {
            if (t - 3 + k >= 0) {
                const v4u u = *(const v4u*)(wsp<bf16>(F, WS_ACT) + (size_t)(row - 3 + k) * DINB + PC_X + c0);
                const f32x4 w0 = *(const f32x4*)(inp(F, I_conv_w) + (size_t)(l * 4 + k) * CONVD + c0), w1 = *(const f32x4*)(inp(F, I_conv_w) + (size_t)(l * 4 + k) * CONVD + c0 + 4);
                acc[0] += w0[0] * bflo(u.x); acc[1] += w0[1] * bfhi(u.x); acc[2] += w0[2] * bflo(u.y); acc[3] += w0[3] * bfhi(u.y);
                acc[4] += w1[0] * bflo(u.z); acc[5] += w1[1] * bfhi(u.z); acc[6] += w1[2] * bflo(u.w); acc[7] += w1[3] * bfhi(u.w);
            }
        }
        v4u o; o.x = pkb(silu_f(acc[0]), silu_f(acc[1])); o.y = pkb(silu_f(acc[2]), silu_f(acc[3])); o.z = pkb(silu_f(acc[4]), silu_f(acc[5])); o.w = pkb(silu_f(acc[6]), silu_f(acc[7]));
        *(v4u*)(wsp<bf16>(F, WS_XBC) + (size_t)row * CONVD + c0) = o;
    }
}

__device__ __forceinline__ void ssd_states_phase(Frame& F, int l) {
    PHASE_IDS;
    LAS bf16* BT = (LAS bf16*)F.lds;
    LAS bf16* XsT = (LAS bf16*)(F.lds + 128 * 72 * 2) + wave * (64 * 72);
    const int fr = lane & 15, fq = lane >> 4;
    for (int unit = blockIdx.x; unit < NB * NCH * SG; unit += F.G) {
        const int g = unit & 1, c = (unit >> 1) & 31, b = unit >> 6, t0 = b * SEQ + c * CHUNK, h = g * HPG + wave;
        {   const int n = tid & 127, lq = tid >> 7; const bf16* src = wsp<bf16>(F, WS_XBC) + (size_t)t0 * CONVD + PC_B - PC_X + 128 * g + n;
#pragma unroll
            for (int jj = 0; jj < 2; ++jj) { v4u w; unsigned ww[4];
#pragma unroll
                for (int e2 = 0; e2 < 4; ++e2) { const int l0 = 16 * lq + 8 * jj + 2 * e2; ww[e2] = (unsigned)src[(size_t)l0 * CONVD] | ((unsigned)src[(size_t)(l0 + 1) * CONVD] << 16); }
                w.x = ww[0]; w.y = ww[1]; w.z = ww[2]; w.w = ww[3];
                *(LAS v4u*)(BT + n * 72 + 16 * lq + 8 * jj) = w; } }
        {   const float dtl = wsp<float>(F, WS_DT)[(t0 + lane) * 16 + h], al = wsp<float>(F, WS_ACS)[(t0 + lane) * 16 + h], alast = wsp<float>(F, WS_ACS)[(t0 + 63) * 16 + h];
            const float wl = dtl * __expf(alast - al);
            const bf16* src = wsp<bf16>(F, WS_XBC) + (size_t)t0 * CONVD + 64 * h + lane;
#pragma unroll
            for (int jj = 0; jj < 8; ++jj) { unsigned ww[4];
#pragma unroll
                for (int e2 = 0; e2 < 4; ++e2) { const int l0 = 8 * jj + 2 * e2; ww[e2] = pkb(bf2f(src[(size_t)l0 * CONVD]) * rl(wl, l0), bf2f(src[(size_t)(l0 + 1) * CONVD]) * rl(wl, l0 + 1)); }
                v4u w; w.x = ww[0]; w.y = ww[1]; w.z = ww[2]; w.w = ww[3];
                *(LAS v4u*)(XsT + lane * 72 + 8 * jj) = w; } }
        __syncthreads();
        float* stp = wsp<float>(F, WS_ST) + (size_t)((b * NCH + c) * SH + h) * (SP * SN);
#pragma unroll
        for (int nh = 0; nh < 2; ++nh) {
            f32x4 acc[4][4];
#pragma unroll
            for (int i = 0; i < 4; ++i)
#pragma unroll
                for (int j = 0; j < 4; ++j) acc[i][j] = (f32x4){0.f, 0.f, 0.f, 0.f};
#pragma unroll
            for (int ks = 0; ks < 2; ++ks) {
                bf16x8 xa[4], yb[4];
#pragma unroll
                for (int nt = 0; nt < 4; ++nt) xa[nt] = *(const LAS bf16x8*)(BT + (64 * nh + 16 * nt + fr) * 72 + 32 * ks + 8 * fq);
#pragma unroll
                for (int pt = 0; pt < 4; ++pt) yb[pt] = *(const LAS bf16x8*)(XsT + (16 * pt + fr) * 72 + 32 * ks + 8 * fq);
#pragma unroll
                for (int nt = 0; nt < 4; ++nt)
#pragma unroll
                    for (int pt = 0; pt < 4; ++pt) acc[nt][pt] = MFMA16(xa[nt], yb[pt], acc[nt][pt]);
            }
#pragma unroll
            for (int nt = 0; nt < 4; ++nt)
#pragma unroll
                for (int pt = 0; pt < 4; ++pt) *(f32x4*)(stp + (16 * pt + fr) * SN + 64 * nh + 16 * nt + 4 * fq) = acc[nt][pt];
        }
        __syncthreads();
    }
}

static_assert(fa::LDK == DINB && fa::LDO == DM && fa::D == AHD && fa::LDS_BYTES + SEQ * 4 <= RING_BYTES, "attention body geometry");
__device__ __forceinline__ void attn_phase(Frame& F, int l, char* lds) {
    PHASE_IDS;
    float* cks = (float*)(lds + fa::LDS_BYTES);
    constexpr int W = 1 << 24;
    for (int item = blockIdx.x; item < NB * AH * (SEQ / 256); item += F.G) {
        const int xcd = item & 7, slot = item >> 3, bh = xcd + 8 * (slot >> 3), qb = slot & 7, b = bh / AH, h = bh % AH;
        fa::BlockRef<fa::bf16, fa::bf16> cur;
        cur.Q = (const fa::bf16*)(wsp<bf16>(F, WS_ACT) + (size_t)(b * SEQ + qb * 256) * DINB + PC_Q + h * AHD);
        cur.K = (const fa::bf16*)(wsp<bf16>(F, WS_ACT) + (size_t)(b * SEQ) * DINB + PC_K + h * AHD);
        cur.V = (const fa::bf16*)(wsp<bf16>(F, WS_ACT) + (size_t)(b * SEQ) * DINB + PC_V + h * AHD);
        cur.O = (fa::bf16*)(wsp<bf16>(F, WS_YCAT) + (size_t)(b * SEQ + qb * 256) * DM + DSSM + h * AHD);
        cur.G = inp(F, I_attn_norm) + l * DATT + h * AHD; cur.P0 = qb * 256;
        const float* ck = wsp<float>(F, WS_CUMF) + (size_t)bh * SEQ;
        for (int i = tid; i < cur.P0 + 256; i += NTHR) cks[i] = ck[i];
        fa::Seam<fa::bf16> S;
        fa::causal_swa_prime<fa::bf16, fa::bf16>(cur, W, lds, S);
        fa::causal_swa_block<fa::bf16, fa::bf16>(cur, cur, SEQ, W, lds, S);
    }
}

__device__ __forceinline__ void ssd_scan_phase(Frame& F) {
    PHASE_IDS;
    const int gtid = blockIdx.x * NTHR + tid, NT = F.G * NTHR;
    for (int i = gtid; i < NB * SH * (SP * SN / 4); i += NT) {
        const int e4 = i & 2047, h = (i >> 11) & 15, b = i >> 15;
        f32x4 hs = (f32x4){0.f, 0.f, 0.f, 0.f};
#pragma unroll 4
        for (int c = 0; c < NCH; ++c) {
            f32x4* p = (f32x4*)(wsp<float>(F, WS_ST) + (size_t)((b * NCH + c) * SH + h) * (SP * SN)) + e4;
            const f32x4 st = *p; const float dec = __expf(wsp<float>(F, WS_ACS)[(b * SEQ + c * CHUNK + 63) * 16 + h]);
            *p = hs; hs = hs * dec + st;
        }
    }
}

__device__ __forceinline__ void ssd_out_phase(Frame& F, int l) {
    PHASE_IDS;
    LAS bf16* Cn = (LAS bf16*)F.lds;
    LAS bf16* Bn = Cn + 64 * 136;
    LAS bf16* XTb = Bn + 64 * 136;
    LAS bf16* Swb = XTb + 4 * 64 * 72;
    LAS float* ACSh = (LAS float*)(Swb + 8 * 32 * 72);
    LAS float* DTh = ACSh + 256;
    LAS float* SSP = DTh + 256;
    const int fr = lane & 15, fq = lane >> 4, w = wave, hh = w >> 1, lh = w & 1;
    LAS bf16* XT = XTb + hh * (64 * 72); LAS bf16* Sw = Swb + w * (32 * 72);
    for (int unit = blockIdx.x; unit < NB * NCH * SG; unit += F.G) {
        const int g = unit & 1, c = (unit >> 1) & 31, b = unit >> 6, t0 = b * SEQ + c * CHUNK;
#pragma unroll
        for (int i = 0; i < 2; ++i) { const int idx = tid + NTHR * i, row = idx >> 4, ch = idx & 15; const bf16* src = wsp<bf16>(F, WS_XBC) + (size_t)(t0 + row) * CONVD + 128 * g + 8 * ch;
            *(LAS v4u*)(Bn + row * 136 + 8 * ch) = *(const v4u*)(src + (PC_B - PC_X));
            *(LAS v4u*)(Cn + row * 136 + 8 * ch) = *(const v4u*)(src + (PC_C - PC_X)); }
        f32x4 yv[2][2][4];
#pragma unroll
        for (int q = 0; q < 2; ++q) {
            const int h = g * HPG + 4 * q + hh;
            {   const bf16* src = wsp<bf16>(F, WS_XBC) + (size_t)(t0 + 32 * lh) * CONVD + 64 * h + lane;
#pragma unroll
                for (int jj = 0; jj < 4; ++jj) { unsigned ww[4];
#pragma unroll
                    for (int e2 = 0; e2 < 4; ++e2) { const int s0 = 8 * jj + 2 * e2; ww[e2] = (unsigned)src[(size_t)s0 * CONVD] | ((unsigned)src[(size_t)(s0 + 1) * CONVD] << 16); }
                    v4u wv; wv.x = ww[0]; wv.y = ww[1]; wv.z = ww[2]; wv.w = ww[3];
                    *(LAS v4u*)(XT + lane * 72 + 32 * lh + 8 * jj) = wv; }
                if (lh == 0) { ACSh[hh * 64 + lane] = wsp<float>(F, WS_ACS)[(t0 + lane) * 16 + h]; DTh[hh * 64 + lane] = wsp<float>(F, WS_DT)[(t0 + lane) * 16 + h]; } }
            __syncthreads();
            const LAS float* acsv = ACSh + hh * 64; const LAS float* dtv = DTh + hh * 64;
#pragma unroll
            for (int ltl = 0; ltl < 2; ++ltl) {
                const int lrow = 32 * lh + 16 * ltl + fr; const float al = acsv[lrow];
                bf16x8 yc[4];
#pragma unroll
                for (int ks = 0; ks < 4; ++ks) yc[ks] = *(const LAS bf16x8*)(Cn + lrow * 136 + 32 * ks + 8 * fq);
#pragma unroll
                for (int st = 0; st < 4; ++st) {
                    f32x4 a = (f32x4){0.f, 0.f, 0.f, 0.f};
#pragma unroll
                    for (int ks = 0; ks < 4; ++ks) { const bf16x8 xb = *(const LAS bf16x8*)(Bn + (16 * st + fr) * 136 + 32 * ks + 8 * fq); a = MFMA16(xb, yc[ks], a); }
                    float v[4];
#pragma unroll
                    for (int j = 0; j < 4; ++j) { const int s = 16 * st + 4 * fq + j; v[j] = (s <= lrow) ? a[j] * __expf(al - acsv[s]) * dtv[s] : 0.f; }
                    u32x2 pw; pw.x = pkb(v[0], v[1]); pw.y = pkb(v[2], v[3]);
                    *(LAS u32x2*)(Sw + (16 * ltl + fr) * 72 + 16 * st + 4 * fq) = pw;
                }
            }
            __syncthreads();
            const float dsk = inp(F, I_d_skip)[l * SH + h];
            const float* prev = wsp<float>(F, WS_ST) + (size_t)((b * NCH + c) * SH + h) * (SP * SN);
#pragma unroll
            for (int ltl = 0; ltl < 2; ++ltl) {
                const int lrow = 32 * lh + 16 * ltl + fr; const float eal = __expf(acsv[lrow]);
                bf16x8 ys[2], yc[4];
#pragma unroll
                for (int ks = 0; ks < 2; ++ks) ys[ks] = *(const LAS bf16x8*)(Sw + (16 * ltl + fr) * 72 + 32 * ks + 8 * fq);
#pragma unroll
                for (int ks = 0; ks < 4; ++ks) yc[ks] = *(const LAS bf16x8*)(Cn + lrow * 136 + 32 * ks + 8 * fq);
                float ssq = 0.f;
#pragma unroll
                for (int pt = 0; pt < 4; ++pt) {
                    f32x4 a = (f32x4){0.f, 0.f, 0.f, 0.f}, o = (f32x4){0.f, 0.f, 0.f, 0.f};
#pragma unroll
                    for (int ks = 0; ks < 2; ++ks) { const bf16x8 xx = *(const LAS bf16x8*)(XT + (16 * pt + fr) * 72 + 32 * ks + 8 * fq); a = MFMA16(xx, ys[ks], a); }
#pragma unroll
                    for (int ks = 0; ks < 4; ++ks) { const float* pp = prev + (16 * pt + fr) * SN + 32 * ks + 8 * fq; const f32x4 p0 = *(const f32x4*)pp, p1 = *(const f32x4*)(pp + 4);
                        v4u pk; pk.x = pkb(p0[0], p0[1]); pk.y = pkb(p0[2], p0[3]); pk.z = pkb(p1[0], p1[1]); pk.w = pkb(p1[2], p1[3]);
                        o = MFMA16(__builtin_bit_cast(bf16x8, pk), yc[ks], o); }
                    const int pc = 16 * pt + 4 * fq;
                    const u32x2 zz = *(const u32x2*)(wsp<bf16>(F, WS_ACT) + (size_t)(t0 + lrow) * DINB + PC_Z + 64 * h + pc);
                    f32x4 y;
                    y[0] = (a[0] + eal * o[0] + dsk * bf2f(XT[(pc + 0) * 72 + lrow])) * silu_f(bflo(zz.x));
                    y[1] = (a[1] + eal * o[1] + dsk * bf2f(XT[(pc + 1) * 72 + lrow])) * silu_f(bfhi(zz.x));
                    y[2] = (a[2] + eal * o[2] + dsk * bf2f(XT[(pc + 2) * 72 + lrow])) * silu_f(bflo(zz.y));
                    y[3] = (a[3] + eal * o[3] + dsk * bf2f(XT[(pc + 3) * 72 + lrow])) * silu_f(bfhi(zz.y));
                    yv[q][ltl][pt] = y; ssq += (y[0] * y[0] + y[1] * y[1]) + (y[2] * y[2] + y[3] * y[3]);
                }
                ssq += __shfl_xor(ssq, 16); ssq += __shfl_xor(ssq, 32);
                if (fq == 0) SSP[lrow * 8 + 4 * q + hh] = ssq;
            }
            __syncthreads();
        }
#pragma unroll
        for (int ltl = 0; ltl < 2; ++ltl) {
            const int lrow = 32 * lh + 16 * ltl + fr;
            const f32x4 s0 = *(const LAS f32x4*)(SSP + lrow * 8), s1 = *(const LAS f32x4*)(SSP + lrow * 8 + 4);
            const float r = 1.0f / sqrtf(((s0[0] + s0[1]) + (s0[2] + s0[3]) + (s1[0] + s1[1]) + (s1[2] + s1[3])) * (1.0f / 512.0f) + EPS);
#pragma unroll
            for (int q = 0; q < 2; ++q) { const int h = g * HPG + 4 * q + hh;
#pragma unroll
                for (int pt = 0; pt < 4; ++pt) { const int pc = 16 * pt + 4 * fq; const f32x4 wn = *(const f32x4*)(inp(F, I_ssm_norm) + l * DSSM + 64 * h + pc); const f32x4 y = yv[q][ltl][pt];
                    u32x2 ow; ow.x = pkb(y[0] * r * wn[0], y[1] * r * wn[1]); ow.y = pkb(y[2] * r * wn[2], y[3] * r * wn[3]);
                    *(u32x2*)(wsp<bf16>(F, WS_YCAT) + (size_t)(t0 + lrow) * DM + 64 * h + pc) = ow; } }
        }
        __syncthreads();
    }
}

struct Args { const float* in[19]; float* out; unsigned char* ws; };
__global__ void __launch_bounds__(NWAVES * 64, 2) fwd_kernel(Args args) {
    extern __shared__ __attribute__((aligned(16))) unsigned char lds[];
    Frame F;
    F.lds = (LAS unsigned char*)lds;
    F.MISC = (volatile LAS unsigned*)(F.lds + MISC_OFF);
    F.G = gridDim.x; { const int bx = blockIdx.x; F.vcu = (F.G % 8 == 0) ? (bx % 8) * (F.G / 8) + bx / 8 : bx; }
    F.ws = args.ws; F.X = args.out;
    for (int u = threadIdx.x; u < (LDS_BYTES - LDSCTL_OFF) / 4; u += NWAVES * 64) ((LAS unsigned*)(F.lds + LDSCTL_OFF))[u] = 0u;
    __syncthreads();
    if (threadIdx.x == 0) { LAS unsigned* t = (LAS unsigned*)(F.lds + LDSCTL_OFF);
#pragma unroll
        for (int k = 0; k < I_N; ++k) { const unsigned long long p = (unsigned long long)args.in[k]; t[2 * k] = (unsigned)p; t[2 * k + 1] = (unsigned)(p >> 32); } }
    __syncthreads();
    XcdBarrier bar = xcd_barrier_post((unsigned*)(args.ws + WS_CTL) + CW_BAR, F.MISC + 8);
#define GRID_BAR() do { XcdBarrier b_ = bar; GAS unsigned* p_ = (GAS unsigned*)bar.bar; asm volatile("" : "+s"(p_), "+s"(b_.x)); b_.bar = (unsigned*)p_; xcd_barrier(b_); } while (0)

    p0_prologue(F);
    GRID_BAR();
    mod_reduce_phase(F);
    GRID_BAR();
    for (int s = 0; s <= 3 * DEPTH; ++s) {
        const bool has_prev = s > 0, has_next = s < 3 * DEPTH;
        const int l = s / 3, sub = s % 3, lp = has_prev ? (s - 1) / 3 : 0, subp = has_prev ? (s - 1) % 3 : 0;
        const int lc = has_next ? l : DEPTH - 1, subc = has_next ? sub : 0;
        thin_phase(F, s == 0 ? inp(F, I_x) : F.X, has_prev,
                   wsp<float>(F, WS_MOD) + (size_t)lp * NB * MODW + (3 * subp + 2) * DM, inp(F, I_norm_post) + (lp * 3 + subp) * DM, subp == 1 ? 1.0f : 0.5f,
                   has_next, inp(F, I_norm_pre) + (lc * 3 + subc) * DM, wsp<float>(F, WS_MOD) + (size_t)lc * NB * MODW + (3 * subc) * DM, wsp<float>(F, WS_MOD) + (size_t)lc * NB * MODW + (3 * subc + 1) * DM);
        if (!has_next) break;
        GRID_BAR();
        if (sub != 1) {
            const int lf = l * 2 + (sub == 2 ? 1 : 0);
            pg8::Gemm g{wsp<bf16>(F, WS_HB), wsp<bf16>(F, WS_WGU) + (size_t)lf * NGU * DM, M, NGU, DM}; pg8::StaticOrder S; S.init(M, NGU, F.G, (int)blockIdx.x);
            pg8::EpiSwiGLU E{wsp<bf16>(F, WS_ACT), DFF};
            pg8::gemm_phase<pg8::EpiSwiGLU, pg8::StaticOrder, true, true>(F.lds, g, S, E);
            GRID_BAR();
        } else {
            {   pg8::Gemm g{wsp<bf16>(F, WS_HB), wsp<bf16>(F, WS_WIN) + (size_t)l * DINP * DM, M, DINP, DM}; pg8::StaticOrder S; S.init(M, DINP, F.G, (int)blockIdx.x);
                pg8::EpiProj E{wsp<bf16>(F, WS_ACT), DINB, wsp<float>(F, WS_DTF), DINB / 256};
                pg8::gemm_phase<pg8::EpiProj, pg8::StaticOrder, true, true>(F.lds, g, S, E); }
            GRID_BAR();
            prep_phase(F, l);
            GRID_BAR();
            ssd_states_phase(F, l);
            attn_phase(F, l, (char*)lds);
            GRID_BAR();
            ssd_scan_phase(F);
            GRID_BAR();
            ssd_out_phase(F, l);
            GRID_BAR();
        }
        {   const bool mix = (sub == 1); const int lf = l * 2 + (sub == 2 ? 1 : 0);
            pg8::Gemm g{mix ? wsp<bf16>(F, WS_YCAT) : wsp<bf16>(F, WS_ACT), mix ? wsp<bf16>(F, WS_WOUT) + (size_t)l * DM * DM : wsp<bf16>(F, WS_WDN) + (size_t)lf * DM * DFF, M, DM, mix ? DM : DFF}; pg8::StaticOrder S; S.init(M, DM, F.G, (int)blockIdx.x);
            pg8::EpiF32 E{wsp<float>(F, WS_Y), DM};
            pg8::gemm_phase<pg8::EpiF32, pg8::StaticOrder, true, true>(F.lds, g, S, E); }
        GRID_BAR();
    }
}

extern "C" void kernel_launch(void* const* d_in, const int* in_sizes, int n_in, void* d_out, int out_size, void* d_ws, size_t ws_size, hipStream_t stream) {
    static int grid = 0;
    if (grid == 0) {
        if (n_in != 19 || in_sizes[0] != M * DM || out_size != M * DM || ws_size < WS_END) { fprintf(stderr, "kernel_launch: unexpected shapes (n_in %d, in0 %d, out %d, ws %zu < %zu)\n", n_in, n_in > 0 ? in_sizes[0] : -1, out_size, ws_size, (size_t)WS_END); grid = -1; return; }
        int dev = 0, cus = 0, per_cu = 0;
        if (hipGetDevice(&dev) != hipSuccess || hipDeviceGetAttribute(&cus, hipDeviceAttributeMultiprocessorCount, dev) != hipSuccess) { grid = -1; return; }
        if (hipFuncSetAttribute((const void*)fwd_kernel, hipFuncAttributeMaxDynamicSharedMemorySize, LDS_BYTES) != hipSuccess) { fprintf(stderr, "kernel_launch: hipFuncSetAttribute failed\n"); grid = -1; return; }
        if (hipOccupancyMaxActiveBlocksPerMultiprocessor(&per_cu, (const void*)fwd_kernel, NWAVES * 64, LDS_BYTES) != hipSuccess || per_cu < 1) { fprintf(stderr, "kernel_launch: occupancy query says %d\n", per_cu); }
        (void)hipGetLastError();
        grid = cus;
    }
    if (grid < 0) return;
    if (hipMemsetAsync((char*)d_ws + WS_CTL, 0, CTL_ZERO_BYTES, stream) != hipSuccess) return;
    Args a{};
    for (int i = 0; i < 19; ++i) a.in[i] = (const float*)d_in[i];
    a.out = (float*)d_out; a.ws = (unsigned char*)d_ws;
    hipLaunchKernelGGL(fwd_kernel, dim3(grid), dim3(NWAVES * 64), LDS_BYTES, stream, a);
}
```

```cpp
#include <hip/hip_runtime.h>
#include <hip/hip_bf16.h>
#include <cstdio>
#include <cstdint>
namespace pg8 {
#define PG8_LAS __attribute__((address_space(3)))
typedef unsigned short bf16_t;
typedef short bf16x8 __attribute__((ext_vector_type(8)));
typedef float f32x4 __attribute__((ext_vector_type(4)));
typedef unsigned u32x4 __attribute__((ext_vector_type(4)));
constexpr int BM = 256, BK = 64, HALF = 128, HTB = HALF * BK * 2  , STAGE_BYTES = 8 * HTB, NXCD = 8, WGM = 8;

__host__ __device__ __forceinline__ int lds_byte(int r, int c) { const int st = (r >> 4) * 2 + (c >> 5), rr = r & 15, cc = c & 31, ob = rr * 64 + cc * 2; return st * 1024 + (ob ^ (((ob >> 9) & 1) << 5)); }
__host__ __device__ __forceinline__ void stage_rc(int b, int& R, int& C) { const int st = b / 1024, sb = b % 1024, swz = sb ^ (((sb >> 9) & 1) << 5); R = (st >> 1) * 16 + swz / 64; C = (st & 1) * 32 + (swz % 64) / 2; }
__host__ __device__ __forceinline__ int perm32(int rho) { const int n = rho >> 4, i = rho & 15; return 8 * (i >> 2) + 4 * n + (i & 3); }

struct Unit { int pm, pn; };
struct Gemm { const bf16_t* A; const bf16_t* Bt; int M, N, K; };

struct StaticOrder {
    int nM, nN, nwg, G, c;
    __host__ __device__ void init(int M, int N, int G_, int c_) { nM = M / BM; nN = N / BM; nwg = nM * nN; G = G_; c = c_; }
    __host__ __device__ bool next(int i, Unit& u) const {
        const long L = (long)i * G + c; if (L >= nwg) return false;
        int wgid = (int)L; { const int q = nwg / NXCD, r = nwg % NXCD, xcd = wgid % NXCD, off = wgid / NXCD; wgid = (xcd < r ? xcd * (q + 1) : r * (q + 1) + (xcd - r) * q) + off; }
        const int nig = WGM * nN, gid = wgid / nig, fm = gid * WGM, gsz = (nM - fm) < WGM ? (nM - fm) : WGM;
        u.pm = fm + ((wgid % nig) % gsz); u.pn = (wgid % nig) / gsz; return true;
    }
    __device__ __forceinline__ void a_ready(const Unit&) const {}
    __device__ __forceinline__ void done(const Unit&) const {}
};

__device__ __forceinline__ unsigned cvt_pk_bf16(float lo, float hi) { unsigned r; asm volatile("v_cvt_pk_bf16_f32 %0, %1, %2" : "=v"(r) : "v"(lo), "v"(hi)); return r; }
typedef float f32x2 __attribute__((ext_vector_type(2)));
typedef __bf16 bf16x2_t __attribute__((ext_vector_type(2)));
__device__ __forceinline__ unsigned pk_bf16(float lo, float hi) { f32x2 v = {lo, hi}; bf16x2_t b = __builtin_convertvector(v, bf16x2_t); return __builtin_bit_cast(unsigned, b); }
__device__ __forceinline__ float silu_f(float g) { return g * __builtin_amdgcn_rcpf(1.0f + __expf(-g)); }

struct EpiF32 {
    static constexpr bool PERM = false, AFTER_DRAIN = false;
    float* C; int ldc;
    __device__ __forceinline__ void operator()(const f32x4 (&acc)[2][2][4][2], const Unit& u, int wr, int wc, int fr, int fq) const {
        const int row0 = u.pm * BM + wr * 64 + fr, col0 = u.pn * BM + wc * 32 + 4 * fq;
#pragma unroll
        for (int ai = 0; ai < 2; ++ai)
#pragma unroll
            for (int m = 0; m < 4; ++m) { float* rowp = C + (size_t)(row0 + ai * HALF + m * 16) * ldc + col0;
#pragma unroll
                for (int bj = 0; bj < 2; ++bj)
#pragma unroll
                    for (int n = 0; n < 2; ++n) *(f32x4*)(rowp + bj * HALF + n * 16) = acc[ai][bj][m][n]; }
    }
};
struct EpiSwiGLU {
    static constexpr bool PERM = true, AFTER_DRAIN = false;
    bf16_t* O; int ldc;
    __device__ __forceinline__ void operator()(const f32x4 (&acc)[2][2][4][2], const Unit& u, int wr, int wc, int fr, int fq) const {
        const int row0 = u.pm * BM + wr * 64 + fr, col0 = u.pn * HALF + wc * 32 + 8 * fq;
#pragma unroll
        for (int ai = 0; ai < 2; ++ai)
#pragma unroll
            for (int m = 0; m < 4; ++m) { bf16_t* rowp = O + (size_t)(row0 + ai * HALF + m * 16) * ldc + col0;
                const f32x4 g0 = acc[ai][0][m][0], g1 = acc[ai][0][m][1], u0 = acc[ai][1][m][0], u1 = acc[ai][1][m][1];
                u32x4 w;
                w.x = pk_bf16(silu_f(g0[0]) * u0[0], silu_f(g0[1]) * u0[1]); w.y = pk_bf16(silu_f(g0[2]) * u0[2], silu_f(g0[3]) * u0[3]);
                w.z = pk_bf16(silu_f(g1[0]) * u1[0], silu_f(g1[1]) * u1[1]); w.w = pk_bf16(silu_f(g1[2]) * u1[2], silu_f(g1[3]) * u1[3]);
                *(u32x4*)rowp = w; }
    }
};
struct EpiProj {
    static constexpr bool PERM = true, AFTER_DRAIN = false;
    bf16_t* O; int ldc; float* dtf; int nbf;
    __device__ __forceinline__ void operator()(const f32x4 (&acc)[2][2][4][2], const Unit& u, int wr, int wc, int fr, int fq) const {
        const int row0 = u.pm * BM + wr * 64 + fr;
        if (u.pn < nbf) {
            const int col0 = u.pn * BM + wc * 32 + 8 * fq;
#pragma unroll
            for (int ai = 0; ai < 2; ++ai)
#pragma unroll
                for (int m = 0; m < 4; ++m) { bf16_t* rowp = O + (size_t)(row0 + ai * HALF + m * 16) * ldc + col0;
#pragma unroll
                    for (int bj = 0; bj < 2; ++bj) { const f32x4 v0 = acc[ai][bj][m][0], v1 = acc[ai][bj][m][1];
                        u32x4 w; w.x = pk_bf16(v0[0], v0[1]); w.y = pk_bf16(v0[2], v0[3]); w.z = pk_bf16(v1[0], v1[1]); w.w = pk_bf16(v1[2], v1[3]);
                        *(u32x4*)(rowp + bj * HALF) = w; } }
        } else if (wc == 0) {
#pragma unroll
            for (int ai = 0; ai < 2; ++ai)
#pragma unroll
                for (int m = 0; m < 4; ++m) { float* rp = dtf + (size_t)(row0 + ai * HALF + m * 16) * 32 + 8 * fq;
                    *(f32x4*)rp = acc[ai][0][m][0]; *(f32x4*)(rp + 4) = acc[ai][0][m][1]; }
        }
    }
};
template <class Epi, class Sched, bool ALIGN_EPI = false, bool SP2 = false>
__device__ __forceinline__ void gemm_phase(PG8_LAS unsigned char* lds, const Gemm g, const Sched& S, const Epi& E) {
    int tid_ = threadIdx.x; asm volatile("" : "+v"(tid_)); const int tid = tid_, wid = __builtin_amdgcn_readfirstlane(tid >> 6), lane = tid & 63, wr = wid >> 2, wc = wid & 3, fr = lane & 15, fq = lane >> 4;
    const int K = g.K, nt = K / BK;
    unsigned voffA[2], voffB[2];
#pragma unroll
    for (int i = 0; i < 2; ++i) { int R, C; stage_rc(tid * 16 + i * 8192, R, C); const int Rb = Epi::PERM ? ((R & ~31) + perm32(R & 31)) : R;
        voffA[i] = (unsigned)(R * K + C) * 2u; voffB[i] = (unsigned)(Rb * K + C) * 2u; }
    const size_t kstep = (size_t)(BK * 2);
    const size_t hstep = (size_t)HALF * K * 2;
    const size_t tstep = 2 * hstep;
    const unsigned ldsw = (unsigned)wid * 1024u;
    const int aoff = lds_byte(wr * 64 + fr, fq * 8), boff = lds_byte(wc * 32 + fr, fq * 8);
#define PG8_SA(b, h) (((b) * 2 + (h)) * HTB)
#define PG8_SB(b, h) ((4 + (b) * 2 + (h)) * HTB)
#define PG8_STAGE(bufoff, gbase, voff) do { _Pragma("unroll") for (int _i = 0; _i < 2; ++_i) \
        __builtin_amdgcn_global_load_lds((const unsigned*)((const char*)(gbase) + (voff)[_i]), (PG8_LAS unsigned*)(lds + (bufoff) + ldsw + _i * 8192), 16, 0, 0); } while (0)
#define PG8_LDA(dst, b, h) do { _Pragma("unroll") for (int m = 0; m < 4; ++m) _Pragma("unroll") for (int k = 0; k < 2; ++k) dst[m][k] = *(const PG8_LAS bf16x8*)(lds + PG8_SA(b, h) + aoff + m * 2048 + k * 1024); } while (0)
#define PG8_LDB(dst, b, h) do { _Pragma("unroll") for (int n = 0; n < 2; ++n) _Pragma("unroll") for (int k = 0; k < 2; ++k) dst[n][k] = *(const PG8_LAS bf16x8*)(lds + PG8_SB(b, h) + boff + n * 2048 + k * 1024); } while (0)
#define PG8_MMA(ai, bj, At, Bt) do { __builtin_amdgcn_s_setprio(1); _Pragma("unroll") for (int m = 0; m < 4; ++m) _Pragma("unroll") for (int n = 0; n < 2; ++n) _Pragma("unroll") for (int k = 0; k < 2; ++k) \
        acc[ai][bj][m][n] = __builtin_amdgcn_mfma_f32_16x16x32_bf16(Bt[n][k], At[m][k], acc[ai][bj][m][n], 0, 0, 0); __builtin_amdgcn_s_setprio(0); } while (0)
#define PG8_WAIT_V(n) asm volatile("s_waitcnt vmcnt(" #n ")" ::: "memory")
#define PG8_WAIT_L(n) asm volatile("s_waitcnt lgkmcnt(" #n ")" ::: "memory")
#define PG8_BAR __builtin_amdgcn_s_barrier()
#define PG8_SCHED __builtin_amdgcn_sched_barrier(0)
    Unit cur, nxt; int ui = 0;
    if (!S.next(0, cur)) return;
    f32x4 acc[2][2][4][2];
#pragma unroll
    for (int a = 0; a < 2; ++a)
#pragma unroll
        for (int b = 0; b < 2; ++b)
#pragma unroll
            for (int m = 0; m < 4; ++m)
#pragma unroll
                for (int n = 0; n < 2; ++n) acc[a][b][m][n] = (f32x4){0.f, 0.f, 0.f, 0.f};
    bf16x8 At[4][2], B0[2][2], B1[2][2];
    const char* cA = (const char*)g.A + (size_t)cur.pm * tstep; const char* cB = (const char*)g.Bt + (size_t)cur.pn * tstep;
    S.a_ready(cur);
    if constexpr (SP2) {
        PG8_STAGE(PG8_SB(0, 0), cB, voffB); PG8_STAGE(PG8_SB(0, 1), cB + hstep, voffB); PG8_STAGE(PG8_SA(0, 0), cA, voffA); PG8_STAGE(PG8_SA(0, 1), cA + hstep, voffA);
        if (wr == 1) PG8_BAR;
        PG8_WAIT_V(2); PG8_BAR;
        PG8_STAGE(PG8_SB(1, 0), cB + kstep, voffB); PG8_STAGE(PG8_SA(1, 0), cA + kstep, voffA); PG8_STAGE(PG8_SB(1, 1), cB + hstep + kstep, voffB);
        PG8_WAIT_V(6); PG8_BAR;
    } else {
        PG8_STAGE(PG8_SB(0, 0), cB, voffB); PG8_STAGE(PG8_SA(0, 0), cA, voffA); PG8_STAGE(PG8_SB(0, 1), cB + hstep, voffB); PG8_STAGE(PG8_SA(0, 1), cA + hstep, voffA);
        if (wr == 1) PG8_BAR;
        PG8_WAIT_V(4); PG8_BAR;
        PG8_STAGE(PG8_SB(1, 0), cB + kstep, voffB); PG8_STAGE(PG8_SA(1, 0), cA + kstep, voffA); PG8_STAGE(PG8_SB(1, 1), cB + hstep + kstep, voffB);
        PG8_WAIT_V(6); PG8_BAR;
    }
    for (;;) {
        const bool has_next = S.next(ui + 1, nxt);
        const char* nA = has_next ? (const char*)g.A + (size_t)nxt.pm * tstep : cA; const char* nB = has_next ? (const char*)g.Bt + (size_t)nxt.pn * tstep : cB;
        for (int t = 0; t < nt; t += 2) {
            const bool last = (t == nt - 2);
            const char* a1 = cA + (size_t)(t + 1) * kstep;
            const char* a2 = last ? nA : cA + (size_t)(t + 2) * kstep; const char* b2 = last ? nB : cB + (size_t)(t + 2) * kstep;
            const char* a3 = a2 + kstep; const char* b3 = b2 + kstep;
            if (last && has_next) S.a_ready(nxt);
            if constexpr (SP2) {
            PG8_LDB(B0, 0, 0); PG8_LDB(B1, 0, 1); PG8_SCHED; PG8_LDA(At, 0, 0); PG8_STAGE(PG8_SA(1, 1), a1 + hstep, voffA);
            PG8_WAIT_V(8); PG8_WAIT_L(0); PG8_BAR; PG8_MMA(0, 0, At, B0); PG8_MMA(0, 1, At, B1); PG8_BAR; PG8_SCHED;
            PG8_LDA(At, 0, 1); PG8_STAGE(PG8_SB(0, 0), b2, voffB); PG8_STAGE(PG8_SB(0, 1), b2 + hstep, voffB); PG8_STAGE(PG8_SA(0, 0), a2, voffA);
            PG8_WAIT_V(8); PG8_WAIT_L(0); PG8_BAR; PG8_MMA(1, 0, At, B0); PG8_MMA(1, 1, At, B1); PG8_BAR; PG8_SCHED;
            PG8_LDB(B0, 1, 0); PG8_LDB(B1, 1, 1); PG8_SCHED; PG8_LDA(At, 1, 0); PG8_STAGE(PG8_SA(0, 1), a2 + hstep, voffA);
            PG8_WAIT_V(8); PG8_WAIT_L(0); PG8_BAR; PG8_MMA(0, 0, At, B0); PG8_MMA(0, 1, At, B1); PG8_BAR; PG8_SCHED;
            PG8_LDA(At, 1, 1); PG8_STAGE(PG8_SB(1, 0), b3, voffB); PG8_STAGE(PG8_SB(1, 1), b3 + hstep, voffB); PG8_STAGE(PG8_SA(1, 0), a3, voffA);
            PG8_WAIT_V(8); PG8_WAIT_L(0); PG8_BAR; PG8_MMA(1, 0, At, B0); PG8_MMA(1, 1, At, B1); PG8_BAR; PG8_SCHED;
            } else {
            PG8_LDB(B0, 0, 0); PG8_SCHED; PG8_LDA(At, 0, 0); PG8_STAGE(PG8_SA(1, 1), a1 + hstep, voffA);
            PG8_WAIT_L(8); PG8_BAR; PG8_WAIT_L(0); PG8_MMA(0, 0, At, B0); PG8_BAR; PG8_SCHED;
            PG8_LDB(B1, 0, 1); PG8_STAGE(PG8_SB(0, 0), b2, voffB);
            PG8_BAR; PG8_WAIT_L(0); PG8_MMA(0, 1, At, B1); PG8_BAR;
            PG8_LDA(At, 0, 1); PG8_STAGE(PG8_SA(0, 0), a2, voffA);
            PG8_BAR; PG8_WAIT_L(0); PG8_MMA(1, 0, At, B0); PG8_BAR; PG8_SCHED;
            PG8_STAGE(PG8_SB(0, 1), b2 + hstep, voffB);
            PG8_WAIT_V(6); PG8_BAR; PG8_MMA(1, 1, At, B1); PG8_BAR;
            PG8_LDB(B0, 1, 0); PG8_SCHED; PG8_LDA(At, 1, 0); PG8_STAGE(PG8_SA(0, 1), a2 + hstep, voffA);
            PG8_WAIT_L(8); PG8_BAR; PG8_WAIT_L(0); PG8_MMA(0, 0, At, B0); PG8_BAR; PG8_SCHED;
            PG8_LDB(B1, 1, 1); PG8_STAGE(PG8_SB(1, 0), b3, voffB);
            PG8_BAR; PG8_WAIT_L(0); PG8_MMA(0, 1, At, B1); PG8_BAR;
            PG8_LDA(At, 1, 1); PG8_STAGE(PG8_SA(1, 0), a3, voffA);
            PG8_BAR; PG8_WAIT_L(0); PG8_MMA(1, 0, At, B0); PG8_BAR; PG8_SCHED;
            PG8_STAGE(PG8_SB(1, 1), b3 + hstep, voffB);
            PG8_WAIT_V(6); PG8_BAR; PG8_MMA(1, 1, At, B1); PG8_BAR;
            }
        }
        if constexpr (ALIGN_EPI) { if (wr == 0) PG8_BAR; }
        if constexpr (!Epi::AFTER_DRAIN) { E(acc, cur, wr, wc, fr, fq); S.done(cur); }
        if (!has_next) break;
#pragma unroll
        for (int a = 0; a < 2; ++a)
#pragma unroll
            for (int b = 0; b < 2; ++b)
#pragma unroll
                for (int m = 0; m < 4; ++m)
#pragma unroll
                    for (int n = 0; n < 2; ++n) acc[a][b][m][n] = (f32x4){0.f, 0.f, 0.f, 0.f};
        cur = nxt; cA = nA; cB = nB; ++ui;
        if constexpr (ALIGN_EPI) { if (wr == 1) PG8_BAR; }
    }
    PG8_WAIT_V(0);
    if constexpr (!ALIGN_EPI) { if (wr == 0) PG8_BAR; }
    PG8_BAR;
    if constexpr (Epi::AFTER_DRAIN) { E.fused(acc, cur, wr, wc, fr, fq, lds, wid, lane); S.done(cur); }
#undef PG8_SA
#undef PG8_SB
#undef PG8_STAGE
#undef PG8_LDA
#undef PG8_LDB
#undef PG8_MMA
#undef PG8_WAIT_V
#undef PG8_WAIT_L
#undef PG8_BAR
#undef PG8_SCHED
}
}

constexpr int NWAVES = 8, NTHR = NWAVES * 64;
constexpr int NB = 4, SEQ = 2048, DM = 2048, DEPTH = 4, M = NB * SEQ;
constexpr int CHUNK = 64, NCH = SEQ / CHUNK;
constexpr int DSSM = 1024, SP = 64, SH = 16, SG = 2, HPG = 8, SN = 128, CONVD = 1536;
constexpr int DATT = 1024, AHD = 128, AH = 8;
constexpr int DFF = 5632, NMOD = 9, MODW = NMOD * DM, NGU = 2 * DFF;
constexpr int DIN = 5656, DINB = 5632, DINP = 5888;
constexpr int PC_Z = 0, PC_X = 1024, PC_B = 2048, PC_C = 2304, PC_Q = 2560, PC_K = 3584, PC_V = 4608;
constexpr float EPS = 1e-6f;

constexpr size_t MiB = 1u << 20;
constexpr size_t WS_CTL = 0, CTL_ZERO_BYTES = 4 * MiB;
constexpr size_t WS_MOD = 1 * MiB;
constexpr size_t WS_WGU = 4 * MiB;
constexpr size_t WS_WDN = WS_WGU + (size_t)DEPTH * 2 * NGU * DM * 2;
constexpr size_t WS_WIN = WS_WDN + (size_t)DEPTH * 2 * DM * DFF * 2;
constexpr size_t WS_WOUT = WS_WIN + (size_t)DEPTH * DINP * DM * 2;
constexpr size_t WS_HB = WS_WOUT + (size_t)DEPTH * DM * DM * 2;
constexpr size_t WS_ACT = WS_HB + (size_t)M * DM * 2;
constexpr size_t WS_Y = WS_ACT + (size_t)M * DFF * 2;
constexpr size_t WS_DTF = WS_Y + (size_t)M * DM * 4;
constexpr size_t WS_XBC = WS_DTF + (size_t)M * 32 * 4;
constexpr size_t WS_DT = WS_XBC + (size_t)M * CONVD * 2;
constexpr size_t WS_ACS = WS_DT + (size_t)M * 16 * 4;
constexpr size_t WS_CUMF = WS_ACS + (size_t)M * 16 * 4;
constexpr size_t WS_ST = WS_CUMF + (size_t)NB * AH * SEQ * 4;
constexpr size_t WS_YCAT = WS_ST + (size_t)NB * NCH * SH * SP * SN * 4;
constexpr size_t WS_PART = WS_YCAT + (size_t)M * DM * 2;
constexpr size_t WS_XB = WS_PART + (size_t)8 * DEPTH * NB * MODW * 4;
constexpr size_t WS_END = WS_XB + (size_t)M * DM * 2;
constexpr int CW_BAR = 4096;

constexpr int RING_BYTES = 131072;
constexpr int LDSCTL_OFF = RING_BYTES, MISC_OFF = LDSCTL_OFF + 320;
constexpr int LDS_BYTES = 147456;

#define GAS __attribute__((address_space(1)))
#define LAS __attribute__((address_space(3)))
typedef unsigned short bf16;
typedef unsigned v4u __attribute__((ext_vector_type(4)));
typedef float f32x4 __attribute__((ext_vector_type(4)));
typedef short bf16x8 __attribute__((ext_vector_type(8)));
typedef GAS unsigned gu32;
typedef GAS unsigned long long gu64;
#define RLX_AGENT __ATOMIC_RELAXED, __HIP_MEMORY_SCOPE_AGENT
#define LDS_WAIT() asm volatile("s_waitcnt lgkmcnt(0)" ::: "memory")
#define VM_WAIT() asm volatile("s_waitcnt vmcnt(0)" ::: "memory")
__device__ __forceinline__ unsigned long long rt() { return __builtin_amdgcn_s_memrealtime(); }
__device__ __forceinline__ unsigned f2bf(float f) { unsigned u = __builtin_bit_cast(unsigned, f); return (u + 0x7fffu + ((u >> 16) & 1u)) >> 16; }
__device__ __forceinline__ unsigned pk2(float lo, float hi) { return f2bf(lo) | (f2bf(hi) << 16); }

#define XB_TMO      128
#define XB_XCNT(j)  (256  + 64 * (j))
#define XB_XSUB(j)  (1280 + 64 * (j))
#define XB_XGEN(j)  (2304 + 64 * (j))
#define XB_TOP      3328
#define XB_TOPGEN   3392
#define XCD_BAR_WORDS 3456
#define XB_SPIN_CAP (1u << 18)

__device__ __forceinline__ unsigned xb_ld(unsigned* p)              { return __hip_atomic_load(p, __ATOMIC_RELAXED, __HIP_MEMORY_SCOPE_AGENT); }
__device__ __forceinline__ unsigned xb_add(unsigned* p, unsigned v) { return __hip_atomic_fetch_add(p, v, __ATOMIC_RELAXED, __HIP_MEMORY_SCOPE_AGENT); }
__device__ __forceinline__ unsigned xb_xcc_id() { return (unsigned)__builtin_amdgcn_s_getreg((3 << 11) | 20) & 0xFu; }
#define XB_SPIN(cond, bar) do { unsigned _sp = 0; while (cond) { __builtin_amdgcn_s_sleep(1); \
    if ((++_sp & 255u) == 0u) { if (xb_ld(&(bar)[XB_TMO])) break; if (_sp > XB_SPIN_CAP) { atomicAdd(&(bar)[XB_TMO], 1u); break; } } } } while (0)

struct XcdBarrier {
    unsigned* bar; unsigned x;
    volatile LAS unsigned* st;
};

__device__ __forceinline__ XcdBarrier xcd_barrier_post(unsigned* bar, volatile LAS unsigned* st) {
    XcdBarrier b; b.bar = bar; b.x = xb_xcc_id(); b.st = st;
    if (threadIdx.x == 0) (void)xb_add(&bar[XB_XCNT(b.x)], 1u);
    return b;
}
__device__ __forceinline__ void xcd_barrier_complete(unsigned* bar, unsigned x, unsigned& nloc, unsigned& nx) {
    const unsigned G = gridDim.x * gridDim.y * gridDim.z;
    unsigned sum, cnt, mine, sp = 0u;
    for (;;) {
        sum = 0u; cnt = 0u; mine = 0u;
#pragma unroll
        for (unsigned j = 0; j < 16; ++j) { const unsigned c = xb_ld(&bar[XB_XCNT(j)]); sum += c; cnt += (c > 0u) ? 1u : 0u; mine = (j == x) ? c : mine; }
        if (sum == G) break;
        __builtin_amdgcn_s_sleep(1);
        if ((++sp & 255u) == 0u) { if (xb_ld(&bar[XB_TMO])) break; if (sp > XB_SPIN_CAP) { atomicAdd(&bar[XB_TMO], 1u); break; } }
    }
    nloc = mine > 0u ? mine : 1u; nx = cnt > 0u ? cnt : 1u;
}

__device__ __forceinline__ void xcd_barrier(const XcdBarrier& b) {
    asm volatile("s_waitcnt vmcnt(0)" ::: "memory");
    __syncthreads();
    if (threadIdx.x == 0) {
        unsigned* bar = b.bar;
        __builtin_amdgcn_s_waitcnt(0);
        unsigned nloc = b.st[0], nx = b.st[1];
        if (nloc == 0u) { xcd_barrier_complete(bar, b.x, nloc, nx); b.st[0] = nloc; b.st[1] = nx; }
        const unsigned old = xb_add(&bar[XB_XSUB(b.x)], 1u);
        const unsigned gen = old / nloc;
        if (old + 1u == (gen + 1u) * nloc) {
            __builtin_amdgcn_fence(__ATOMIC_RELEASE, "agent");
            asm volatile("s_waitcnt vmcnt(0)" ::: "memory");
            const unsigned og = xb_add(&bar[XB_TOP], 1u);
            const unsigned tg = og / nx;
            if (og + 1u == (tg + 1u) * nx) xb_add(&bar[XB_TOPGEN], 1u);
            else XB_SPIN(xb_ld(&bar[XB_TOPGEN]) == tg, bar);
            __builtin_amdgcn_fence(__ATOMIC_ACQUIRE, "agent");
            xb_add(&bar[XB_XGEN(b.x)], 1u);
            asm volatile("s_waitcnt vmcnt(0)" ::: "memory");
        } else {
            XB_SPIN(xb_ld(&bar[XB_XGEN(b.x)]) == gen, bar);
            __builtin_amdgcn_fence(__ATOMIC_ACQUIRE, "agent");
            asm volatile("s_waitcnt vmcnt(0)" ::: "memory");
        }
    }
    __syncthreads();
}
namespace fa {
constexpr int D = 128, LDK = 5632, LDO = 2048;
constexpr bool WSKIP = false; constexpr float THR = 8.f; constexpr float NEPS = 1e-6f;
template <class A, class Bt> struct same_t { static constexpr bool v = false; };
template <class A> struct same_t<A, A> { static constexpr bool v = true; };
constexpr float SCALE = 0.08838834764831845f;
constexpr int NW = 8, QBLK = 32, KVBLK = 64, QB = NW * QBLK;
constexpr int SHM_V = KVBLK * D * 2, SHM_K = KVBLK * D * 2;
constexpr int LDS_BYTES = 2 * SHM_V + 2 * SHM_K + NW * 64 * 4;
using bf16 = __hip_bfloat16;
typedef short bf16x8 __attribute__((ext_vector_type(8)));
typedef short s16x4 __attribute__((ext_vector_type(4)));
typedef float f32x16 __attribute__((ext_vector_type(16)));
typedef float f32x4 __attribute__((ext_vector_type(4)));
typedef unsigned u32x4 __attribute__((ext_vector_type(4)));
#define KSWZ(row, colB) ((row) * 256 + ((colB) ^ (((row) & 7) << 4)))
#define SBAR() __builtin_amdgcn_sched_barrier(0)
__device__ __forceinline__ int v_st(int k, int c) { const int kk = (k & ~0xC) | ((k & 4) << 1) | ((k & 8) >> 1); return ((kk >> 3) * 4 + (c >> 5)) * 512 + ((kk & 7) * 32 + (c & 31)) * 2; }
__device__ __forceinline__ int v_rd_base(int lane) { return ((lane & 3) << 3) | (((lane >> 2) & 3) << 6) | (((lane >> 4) & 1) << 5) | (((lane >> 5) & 1) << 8); }
constexpr int v_rd_off(int d0, int ks, int half) { return d0 * 512 + ks * 4096 + half * 2048; }
__device__ __forceinline__ int crow(int r, int hi) { return (r & 3) + 8 * (r >> 2) + 4 * hi; }
__device__ __forceinline__ unsigned cvtpk(float lo, float hi) {
    unsigned r; asm volatile("v_cvt_pk_bf16_f32 %0, %1, %2" : "=v"(r) : "v"(lo), "v"(hi)); return r;
}
__device__ __forceinline__ bf16x8 pack8(f32x4 a, f32x4 b) {
    u32x4 w = {cvtpk(a[0], a[1]), cvtpk(a[2], a[3]), cvtpk(b[0], b[1]), cvtpk(b[2], b[3])};
    return *reinterpret_cast<bf16x8*>(&w);
}
template <class T> __device__ __forceinline__ bf16x8 load8(const T* p) {
    if constexpr (same_t<T, float>::v) { return pack8(*(const f32x4*)p, *(const f32x4*)(p + 4)); }
    else { return *reinterpret_cast<const bf16x8*>(p); }
}
__device__ __forceinline__ void mask_tile(f32x16& p0, f32x16& p1, int dq, unsigned W) {
    const float NEG = -__builtin_inff();
#pragma unroll
    for (int r = 0; r < 16; ++r) {
        const int c = (r & 3) + 8 * (r >> 2);
        if ((unsigned)(dq - c) >= W) p0[r] = NEG;
        if ((unsigned)(dq - c - 32) >= W) p1[r] = NEG;
    }
}
__device__ __forceinline__ void partialSM(f32x16& p0, f32x16& p1, float& m_reg, float& mn, float& alpha) {
    float pmax = p0[0]; for (int r = 1; r < 16; ++r) pmax = fmaxf(pmax, p0[r]); for (int r = 0; r < 16; ++r) pmax = fmaxf(pmax, p1[r]);
    { auto rr = __builtin_amdgcn_permlane32_swap(__float_as_uint(pmax), __float_as_uint(pmax), false, false);
      pmax = fmaxf(__uint_as_float(rr[0]), __uint_as_float(rr[1])); }
    constexpr float C2 = 1.4426950408889634f * SCALE;
    if (__builtin_expect(__all((pmax - m_reg) * SCALE <= THR), 1)) { mn = m_reg; alpha = 1.f; }
    else { mn = fmaxf(m_reg, pmax); alpha = __builtin_amdgcn_exp2f((m_reg - mn) * C2); m_reg = mn; }
    const float mnL = -mn * C2;
    for (int r = 0; r < 16; ++r) p0[r] = fmaf(p0[r], C2, mnL); for (int r = 0; r < 16; ++r) p1[r] = fmaf(p1[r], C2, mnL);
    for (int r = 0; r < 16; ++r) p0[r] = __builtin_amdgcn_exp2f(p0[r]);
}
__device__ __forceinline__ void finishSM(f32x16& p0, f32x16& p1, float alpha, float& l_reg, bf16x8& pa0, bf16x8& pa1, bf16x8& pa2, bf16x8& pa3) {
    for (int r = 0; r < 16; ++r) p1[r] = __builtin_amdgcn_exp2f(p1[r]);
    float ps = 0; for (int r = 0; r < 16; ++r) ps += p0[r]; for (int r = 0; r < 16; ++r) ps += p1[r];
    { auto rr = __builtin_amdgcn_permlane32_swap(__float_as_uint(ps), __float_as_uint(ps), false, false);
      ps = __uint_as_float(rr[0]) + __uint_as_float(rr[1]); }
    l_reg = l_reg * alpha + ps;
#define PK4(P, B_, OUT) do { unsigned a0 = cvtpk(P[B_+0], P[B_+1]), a1 = cvtpk(P[B_+2], P[B_+3]);                          \
        unsigned b0 = cvtpk(P[B_+4], P[B_+5]), b1 = cvtpk(P[B_+6], P[B_+7]);                                             \
        auto r0 = __builtin_amdgcn_permlane32_swap(a0, b0, false, false); auto r1 = __builtin_amdgcn_permlane32_swap(a1, b1, false, false); \
        u32x4 w = {r0[0], r1[0], r0[1], r1[1]}; OUT = *reinterpret_cast<bf16x8*>(&w); } while (0)
    PK4(p0, 0, pa0); PK4(p0, 8, pa1); PK4(p1, 0, pa2); PK4(p1, 8, pa3);
#undef PK4
}
template <int KB, bool SK>
__device__ __forceinline__ void qkt(f32x16& p0, f32x16& p1, const char* K_lds, int r32, int hi, const bf16x8* qr, bool act) {
    if (SK && !act) { const float NEG = -__builtin_inff();
#pragma unroll
        for (int r = 0; r < 16; ++r) { p0[r] = NEG; p1[r] = NEG; } return; }
    p0 = f32x16{}; p1 = f32x16{};
    const char* kb[4];
#pragma unroll
    for (int dd = 0; dd < 4; ++dd) kb[dd] = K_lds + KB * SHM_K + KSWZ(r32, (dd * 16 + hi * 8) * 2);
#pragma unroll
    for (int d0 = 0; d0 < 8; ++d0) { const char* a = kb[d0 & 3] + (d0 >> 2) * 128;
        bf16x8 b0 = *reinterpret_cast<const bf16x8*>(a);
        bf16x8 b1 = *reinterpret_cast<const bf16x8*>(a + 32 * 256);
        p0 = __builtin_amdgcn_mfma_f32_32x32x16_bf16(b0, qr[d0], p0, 0, 0, 0);
        p1 = __builtin_amdgcn_mfma_f32_32x32x16_bf16(b1, qr[d0], p1, 0, 0, 0); }
}
template <int VB, bool SK>
__device__ __forceinline__ void pv_tile(f32x16* o, int vb0, bf16x8 pa0, bf16x8 pa1, bf16x8 pa2, bf16x8 pa3, bool act) {
    if (SK && !act) return;
#define TRRD(dst, off) asm volatile("ds_read_b64_tr_b16 %0, %1 offset:%2" : "=&v"(dst) : "v"(vb0), "i"(off) : "memory")
#define PV_D0(d0) do { s16x4 l0, l1, l2, l3, h0, h1, h2, h3; constexpr int b_ = VB * SHM_V + v_rd_off(d0, 0, 0);     \
        TRRD(l0, b_); TRRD(h0, b_ + 2048); TRRD(l1, b_ + 4096); TRRD(h1, b_ + 6144); TRRD(l2, b_ + 8192); TRRD(h2, b_ + 10240); TRRD(l3, b_ + 12288); TRRD(h3, b_ + 14336); \
        asm volatile("s_waitcnt lgkmcnt(0)" ::: "memory"); SBAR();                 \
        o[d0] = __builtin_amdgcn_mfma_f32_32x32x16_bf16(pa0, (bf16x8){l0[0], l0[1], l0[2], l0[3], h0[0], h0[1], h0[2], h0[3]}, o[d0], 0, 0, 0);   \
        o[d0] = __builtin_amdgcn_mfma_f32_32x32x16_bf16(pa1, (bf16x8){l1[0], l1[1], l1[2], l1[3], h1[0], h1[1], h1[2], h1[3]}, o[d0], 0, 0, 0);   \
        o[d0] = __builtin_amdgcn_mfma_f32_32x32x16_bf16(pa2, (bf16x8){l2[0], l2[1], l2[2], l2[3], h2[0], h2[1], h2[2], h2[3]}, o[d0], 0, 0, 0);   \
        o[d0] = __builtin_amdgcn_mfma_f32_32x32x16_bf16(pa3, (bf16x8){l3[0], l3[1], l3[2], l3[3], h3[0], h3[1], h3[2], h3[3]}, o[d0], 0, 0, 0); } while (0)
    PV_D0(0); PV_D0(1); PV_D0(2); PV_D0(3);
#undef PV_D0
#undef TRRD
}
template <class TIn, class TOut> struct BlockRef { const TIn* Q; const TIn* K; const TIn* V; TOut* O; const float* G; int P0; };
template <class TIn> struct Seam {
    bf16x8 qr[8];
    bf16x8 st_v0, st_v1, st_k0, st_k1; f32x4 sf0, sf1, sf2, sf3;
    f32x4 tq[16];
};
__device__ __forceinline__ int swa_jlo(int P0, int W) { const int lowk = P0 - W + 1; return lowk > 0 ? lowk / KVBLK : 0; }
#define ROW(p, k0, rr) ((p) + (size_t)((k0) + (rr)) * LDK + sc)
#define VMW() asm volatile("s_waitcnt vmcnt(0)" ::: "memory")
#define VMWN(n) asm volatile("s_waitcnt vmcnt(%0)" :: "i"(n) : "memory")
#define SLOAD_H(Kp, Vp, k0) do { S.st_v0 = load8<TIn>(ROW(Vp, k0, sr)); S.st_v1 = load8<TIn>(ROW(Vp, k0, 32 + sr));              \
                         S.st_k0 = load8<TIn>(ROW(Kp, k0, sr)); S.st_k1 = load8<TIn>(ROW(Kp, k0, 32 + sr)); } while (0)
#define SWRITE_HK(bf) do { *(bf16x8*)(K_lds + (bf) * SHM_K + kws) = S.st_k0; *(bf16x8*)(K_lds + (bf) * SHM_K + kws + 32 * 256) = S.st_k1; } while (0)
#define SWRITE_HV(bf) do { *(bf16x8*)(V_lds + (bf) * SHM_V + vst0) = S.st_v0; *(bf16x8*)(V_lds + (bf) * SHM_V + vst1) = S.st_v1; } while (0)
#define SWRITE_H(bf) do { SWRITE_HV(bf); SWRITE_HK(bf); } while (0)
#define SLOAD_F(p, k0) do { S.sf0 = *(const f32x4*)ROW(p, k0, sr); S.sf1 = *(const f32x4*)(ROW(p, k0, sr) + 4);                \
                            S.sf2 = *(const f32x4*)ROW(p, k0, 32 + sr); S.sf3 = *(const f32x4*)(ROW(p, k0, 32 + sr) + 4); } while (0)
#define SWRITE_KF(bf) do { *(bf16x8*)(K_lds + (bf) * SHM_K + kws) = pack8(S.sf0, S.sf1); *(bf16x8*)(K_lds + (bf) * SHM_K + kws + 32 * 256) = pack8(S.sf2, S.sf3); } while (0)
#define SWRITE_VF(bf) do { *(bf16x8*)(V_lds + (bf) * SHM_V + vst0) = pack8(S.sf0, S.sf1); *(bf16x8*)(V_lds + (bf) * SHM_V + vst1) = pack8(S.sf2, S.sf3); } while (0)
template <class TIn, class TOut>
__device__ __forceinline__ void causal_swa_prime(const BlockRef<TIn, TOut>& cur, int W, char* lds, Seam<TIn>& S) {
    constexpr bool F32 = same_t<TIn, float>::v;
    int tid_ = threadIdx.x; asm volatile("" : "+v"(tid_)); const int tid = tid_, wid = __builtin_amdgcn_readfirstlane(tid >> 6), lane = tid & 63, r32 = lane & 31, hi = lane >> 5;
    const int sr = tid >> 4, sc = (tid & 15) * 8, kws = KSWZ(sr, sc * 2); char* K_lds = lds + 2 * SHM_V;
    const int kb0 = swa_jlo(cur.P0, W) * KVBLK;
    for (int d0 = 0; d0 < 8; ++d0) S.qr[d0] = load8<TIn>(cur.Q + (size_t)(wid * QBLK + r32) * LDK + d0 * 16 + hi * 8);
    if constexpr (F32) { SLOAD_F((const float*)cur.K, kb0); VMW(); SWRITE_KF(0); SBAR(); SLOAD_F((const float*)cur.V, kb0); }
    else { SLOAD_H(cur.K, cur.V, kb0); VMW(); SWRITE_HK(0); }
    __syncthreads();
}
template <class TIn, class TOut>
__device__ __forceinline__ void causal_swa_block(const BlockRef<TIn, TOut>& cur, const BlockRef<TIn, TOut>& nxt, int skv, int W, char* lds, Seam<TIn>& S) {
    constexpr bool F32 = same_t<TIn, float>::v;
    int tid_ = threadIdx.x; asm volatile("" : "+v"(tid_)); const int tid = tid_, wid = __builtin_amdgcn_readfirstlane(tid >> 6), lane = tid & 63, r32 = lane & 31, hi = lane >> 5;
    const int j_lo = swa_jlo(cur.P0, W);
    int j_hi = (cur.P0 + QB - 1) / KVBLK + 1; if (j_hi > skv / KVBLK) j_hi = skv / KVBLK;
    const int NT = j_hi - j_lo;
    const int kbn = swa_jlo(nxt.P0, W) * KVBLK;
    const int qlo = cur.P0 + wid * QBLK, qm = qlo + r32 - 4 * hi;
    char* V_lds = lds; char* K_lds = lds + 2 * SHM_V;
    float* ws = (float*)(lds + 2 * SHM_V + 2 * SHM_K) + wid * 64; float* li_l = ws, * al_l = ws + 32;
    float m_reg = -1e30f, l_reg = 0; f32x16 o[4] = {};
    const int sr = tid >> 4, sc = (tid & 15) * 8, vst0 = v_st(sr, sc), vst1 = v_st(32 + sr, sc), kws = KSWZ(sr, sc * 2);
    const int vb0 = (int)(uintptr_t)V_lds + v_rd_base(lane);
    const TIn* Kh = cur.K; const TIn* Vh = cur.V;
#define RESC(a) do { if (__any((a) < 1.f)) { if (hi == 0) al_l[r32] = (a); asm volatile("s_waitcnt lgkmcnt(0)" ::: "memory");              \
                     for (int d_ = 0; d_ < 4; ++d_) for (int r = 0; r < 16; ++r) o[d_][r] *= al_l[crow(r, hi)]; } } while (0)
#define KBASE(t) ((j_lo + (t)) * KVBLK)
#define ACT(t) (KBASE(t) <= qlo + QBLK - 1 && KBASE(t) + KVBLK - 1 >= qlo - W + 1)
#define MASKT(P0_, P1_, t) do { const int kb_ = KBASE(t); if ((!SK || ACT(t)) && (kb_ + KVBLK - 1 > qlo || kb_ <= qlo + QBLK - 1 - W)) mask_tile(P0_, P1_, qm - kb_, (unsigned)W); } while (0)
    const float* cks = (const float*)(lds + LDS_BYTES); const float cq = cks[qlo + r32];
#define BIAS(P0_, P1_, t) do { const float* ck_ = cks + KBASE(t) + 4 * hi; \
        _Pragma("unroll") for (int g_ = 0; g_ < 4; ++g_) { const f32x4 c0_ = *(const f32x4*)(ck_ + 8 * g_), c1_ = *(const f32x4*)(ck_ + 32 + 8 * g_); \
            _Pragma("unroll") for (int e_ = 0; e_ < 4; ++e_) { P0_[4 * g_ + e_] += cq - c0_[e_]; P1_[4 * g_ + e_] += cq - c1_[e_]; } } } while (0)
    constexpr int NQL = F32 ? 16 : 8;
    constexpr bool SK = WSKIP && !F32;
#define SEAM_K0() do { VMWN(NQL); if constexpr (F32) { SWRITE_KF(0); SBAR(); SLOAD_F((const float*)nxt.V, kbn); } else { SWRITE_HK(0); } SBAR(); } while (0)
    f32x16 pA0, pA1, pB0, pB1; float mnA, mnB, alA, alB; bf16x8 pa0, pa1, pa2, pa3;
    if constexpr (F32) { VMW(); SWRITE_VF(0); SBAR(); } else { SWRITE_HV(0); SBAR(); }
    if (NT > 1) { if constexpr (F32) SLOAD_F((const float*)Kh, KBASE(1)); else SLOAD_H(Kh, Vh, KBASE(1)); }
    SBAR(); qkt<0, SK>(pA0, pA1, K_lds, r32, hi, S.qr, ACT(0));
    if constexpr (F32) { if (NT > 1) { VMW(); SWRITE_KF(1); SBAR(); SLOAD_F((const float*)Vh, KBASE(1)); } }
    BIAS(pA0, pA1, 0); MASKT(pA0, pA1, 0); partialSM(pA0, pA1, m_reg, mnA, alA);
    if (NT > 1) { VMW(); if constexpr (F32) { SWRITE_VF(1); SBAR(); if (NT > 2) SLOAD_F((const float*)Kh, KBASE(2)); } else SWRITE_H(1); }
    __syncthreads();
#define HALF_STEP(PX0, PX1, mnX, alX, PY0, PY1, alY, t, KB, VB, SB) do {                                                      \
        SBAR(); qkt<KB, SK>(PX0, PX1, K_lds, r32, hi, S.qr, ACT(t));                                             \
        finishSM(PY0, PY1, alY, l_reg, pa0, pa1, pa2, pa3); SBAR();                                                           \
        if ((t) + 1 < NT) { if constexpr (F32) { VMW(); SWRITE_KF(SB); SBAR(); SLOAD_F((const float*)Vh, KBASE((t) + 1)); }  \
                            else { SLOAD_H(Kh, Vh, KBASE((t) + 1)); } SBAR(); }                                               \
        pv_tile<VB, SK>(o, vb0, pa0, pa1, pa2, pa3, ACT((t) - 1)); BIAS(PX0, PX1, (t)); MASKT(PX0, PX1, (t)); partialSM(PX0, PX1, m_reg, mnX, alX);                                        \
        __syncthreads();                                                                                                      \
        if ((t) + 1 < NT) { VMW(); if constexpr (F32) { SWRITE_VF(SB); SBAR(); if ((t) + 2 < NT) SLOAD_F((const float*)Kh, KBASE((t) + 2)); } \
                            else { SWRITE_H(SB); } }                                                                          \
        RESC(alX); __syncthreads(); } while (0)
    for (int t = 1; t + 1 < NT; t += 2) {
        HALF_STEP(pB0, pB1, mnB, alB, pA0, pA1, alA, t, 1, 0, 0);
        HALF_STEP(pA0, pA1, mnA, alA, pB0, pB1, alB, t + 1, 0, 1, 1);
    }
    const bool even = (NT & 1) == 0;
    if (even) { SBAR(); qkt<1, SK>(pB0, pB1, K_lds, r32, hi, S.qr, ACT(NT - 1)); SBAR(); }
#define QROW(e) (nxt.Q + (size_t)(wid * QBLK + r32) * LDK + ((e) >> 1) * 16 + hi * 8 + ((e) & 1) * 4)
    if constexpr (F32) { SLOAD_F((const float*)nxt.K, kbn); SBAR();
#pragma unroll
        for (int e = 0; e < 8; ++e) S.tq[e] = *(const f32x4*)QROW(e); }
    else { SLOAD_H(nxt.K, nxt.V, kbn); SBAR();
#pragma unroll
        for (int d0 = 0; d0 < 8; ++d0) S.qr[d0] = load8<TIn>(nxt.Q + (size_t)(wid * QBLK + r32) * LDK + d0 * 16 + hi * 8); }
    SBAR();
    finishSM(pA0, pA1, alA, l_reg, pa0, pa1, pa2, pa3); SBAR();
    if constexpr (F32) {
#pragma unroll
        for (int e = 8; e < 16; ++e) S.tq[e] = *(const f32x4*)QROW(e); SBAR(); }
#undef QROW
    pv_tile<0, SK>(o, vb0, pa0, pa1, pa2, pa3, ACT(even ? NT - 2 : NT - 1));
    if (even) { BIAS(pB0, pB1, NT - 1); MASKT(pB0, pB1, NT - 1); partialSM(pB0, pB1, m_reg, mnB, alB); __syncthreads(); RESC(alB);
        finishSM(pB0, pB1, alB, l_reg, pa0, pa1, pa2, pa3); SBAR(); pv_tile<1, SK>(o, vb0, pa0, pa1, pa2, pa3, ACT(NT - 1)); }
    SBAR(); SEAM_K0();
    if (hi == 0) li_l[r32] = l_reg; asm volatile("s_waitcnt lgkmcnt(0)" ::: "memory");
    float rli[16];
#pragma unroll
    for (int r = 0; r < 16; ++r) rli[r] = __builtin_amdgcn_rcpf(li_l[crow(r, hi)]);
    TOut* Ow = cur.O + (size_t)(wid * QBLK) * LDO;
    const float gw0 = cur.G[r32], gw1 = cur.G[32 + r32], gw2 = cur.G[64 + r32], gw3 = cur.G[96 + r32];
#pragma unroll
    for (int r = 0; r < 16; ++r) { const int orow = crow(r, hi);
        float v0 = o[0][r] * rli[r], v1 = o[1][r] * rli[r], v2 = o[2][r] * rli[r], v3 = o[3][r] * rli[r];
        float ss = (v0 * v0 + v1 * v1) + (v2 * v2 + v3 * v3);
        ss += __shfl_xor(ss, 1); ss += __shfl_xor(ss, 2); ss += __shfl_xor(ss, 4); ss += __shfl_xor(ss, 8); ss += __shfl_xor(ss, 16);
        const float rn = 1.0f / sqrtf(ss * (1.0f / 128.0f) + NEPS);
        v0 *= rn * gw0; v1 *= rn * gw1; v2 *= rn * gw2; v3 *= rn * gw3;
        const float n0 = __shfl_xor(v0, 1), n1 = __shfl_xor(v1, 1), n2 = __shfl_xor(v2, 1), n3 = __shfl_xor(v3, 1);
        if ((r32 & 1) == 0) { TOut* op = Ow + (size_t)orow * LDO + r32;
            *(unsigned*)(op) = cvtpk(v0, n0); *(unsigned*)(op + 32) = cvtpk(v1, n1); *(unsigned*)(op + 64) = cvtpk(v2, n2); *(unsigned*)(op + 96) = cvtpk(v3, n3); } }
    if constexpr (F32) {
#pragma unroll
        for (int d0 = 0; d0 < 8; ++d0) S.qr[d0] = pack8(S.tq[2 * d0], S.tq[2 * d0 + 1]); }
    __syncthreads();
#undef RESC
#undef KBASE
#undef ACT
#undef MASKT
#undef BIAS
#undef SEAM_K0
#undef HALF_STEP
}
#undef ROW
#undef VMW
#undef VMWN
#undef SLOAD_H
#undef SWRITE_HK
#undef SWRITE_HV
#undef SWRITE_H
#undef SLOAD_F
#undef SWRITE_KF
#undef SWRITE_VF

#undef KSWZ
#undef SBAR
}

typedef unsigned u32x2 __attribute__((ext_vector_type(2)));
struct Frame {
    LAS unsigned char* lds;
    volatile LAS unsigned* MISC;
    unsigned char* ws;
    float* X;
    int vcu, G;
};
static_assert(19 * 8 <= 320, "pointer table fits below MISC");
enum { I_x, I_c, I_norm_pre, I_norm_post, I_w_mod, I_b_mod, I_w_gate, I_w_up, I_w_down, I_w_in, I_conv_w, I_conv_b, I_dt_bias, I_a_log, I_d_skip, I_ssm_norm, I_f_bias, I_attn_norm, I_w_out, I_N };
__device__ __forceinline__ const float* inp(const Frame& F, int k) {
    const LAS unsigned* t = (const LAS unsigned*)(F.lds + LDSCTL_OFF) + 2 * k;
    const unsigned lo = __builtin_amdgcn_readfirstlane(t[0]), hi = __builtin_amdgcn_readfirstlane(t[1]);
    return (const float*)(const GAS float*)(((unsigned long long)hi << 32) | lo);
}
template <class T> __device__ __forceinline__ T* wsp(const Frame& F, size_t off) { GAS unsigned char* p = (GAS unsigned char*)F.ws; asm volatile("" : "+s"(p)); return (T*)(GAS T*)(p + off); }

__device__ __forceinline__ float bf2f(unsigned short u) { return __uint_as_float((unsigned)u << 16); }
__device__ __forceinline__ float bflo(unsigned w) { return __uint_as_float(w << 16); }
__device__ __forceinline__ float bfhi(unsigned w) { return __uint_as_float(w & 0xffff0000u); }
__device__ __forceinline__ float wave_sum(float v) {
#pragma unroll
    for (int o = 1; o < 64; o <<= 1) v += __shfl_xor(v, o);
    return v;
}
__device__ __forceinline__ float wave_max(float v) {
#pragma unroll
    for (int o = 1; o < 64; o <<= 1) v = fmaxf(v, __shfl_xor(v, o));
    return v;
}
__device__ __forceinline__ float softplus_f(float x) { return fmaxf(x, 0.f) + log1pf(__expf(-fabsf(x))); }
__device__ __forceinline__ float silu_f(float g) { return g * __builtin_amdgcn_rcpf(1.0f + __expf(-g)); }
__device__ __forceinline__ unsigned pkb(float lo, float hi) { return pg8::pk_bf16(lo, hi); }
__device__ __forceinline__ float rl(float v, int l) { return __int_as_float(__builtin_amdgcn_readlane(__float_as_int(v), l)); }
__device__ __forceinline__ int fresh_tid() { int t = threadIdx.x; asm volatile("" : "+v"(t)); return t; }
#define PHASE_IDS const int tid = fresh_tid(), lane = tid & 63, wave = __builtin_amdgcn_readfirstlane(tid >> 6); (void)tid; (void)lane; (void)wave
#define MFMA16(a, b, c) __builtin_amdgcn_mfma_f32_16x16x32_bf16((a), (b), (c), 0, 0, 0)

__device__ __forceinline__ void tr_item(const float* __restrict__ W, int N, int srccol0, bf16* __restrict__ WT, int K, int drow0, int k0, LAS unsigned* T, int lane) {
    const int r = lane >> 4, q = lane & 15;
    f32x4 a[8], b[8];
#pragma unroll
    for (int i = 0; i < 8; ++i) { const int kp = 4 * i + r; const float* p = W + (size_t)(k0 + 2 * kp) * N + srccol0 + 4 * q; a[i] = *(const f32x4*)p; b[i] = *(const f32x4*)(p + N); }
#pragma unroll
    for (int i = 0; i < 8; ++i) { const int kp = 4 * i + r; LAS unsigned* t = T + kp * 65 + 4 * q;
        t[0] = pkb(a[i][0], b[i][0]); t[1] = pkb(a[i][1], b[i][1]); t[2] = pkb(a[i][2], b[i][2]); t[3] = pkb(a[i][3], b[i][3]); }
    LDS_WAIT(); asm volatile("" ::: "memory");
    const int c = lane & 7;
#pragma unroll
    for (int i = 0; i < 8; ++i) { const int n = 8 * i + (lane >> 3); const LAS unsigned* t = T + (4 * c) * 65 + n;
        v4u o; o.x = t[0]; o.y = t[65]; o.z = t[130]; o.w = t[195];
        *(v4u*)(WT + (size_t)(drow0 + n) * K + k0 + 8 * c) = o; }
    LDS_WAIT(); asm volatile("" ::: "memory");
}
constexpr int CV_IFF = (DM / 64) * (DFF / 64);
constexpr int CV_IOUT = (DM / 64) * (DM / 64);
constexpr int CV_ITEMS = 7 * CV_IFF + CV_IOUT;
__device__ __forceinline__ void convert_layer(Frame& F, int L, int q, int nq, int tq, int ntq, LAS unsigned* T, int lane) {
    for (int j = q; j < CV_ITEMS; j += nq) {
        if (j < 4 * CV_IFF) {
            const int up = j >= 2 * CV_IFF ? 1 : 0, r0 = j - up * 2 * CV_IFF, lf = 2 * L + r0 / CV_IFF, r = r0 % CV_IFF, kb = r / 88, nb = r % 88;
            const float* W = (up ? inp(F, I_w_up) : inp(F, I_w_gate)) + (size_t)lf * DM * DFF;
            tr_item(W, DFF, 64 * nb, wsp<bf16>(F, WS_WGU) + (size_t)lf * NGU * DM, DM, (nb >> 1) * 256 + (nb & 1) * 64 + up * 128, 64 * kb, T, lane);
        } else if (j < 6 * CV_IFF) {
            const int r0 = j - 4 * CV_IFF, lf = 2 * L + r0 / CV_IFF, r = r0 % CV_IFF, kb = r / 32, nb = r % 32;
            tr_item(inp(F, I_w_down) + (size_t)lf * DFF * DM, DM, 64 * nb, wsp<bf16>(F, WS_WDN) + (size_t)lf * DM * DFF, DFF, 64 * nb, 64 * kb, T, lane);
        } else if (j < 7 * CV_IFF) {
            const int r = j - 6 * CV_IFF, kb = r / 88, nb = r % 88;
            const int src = 64 * nb + (64 * nb >= 2560 ? 16 : 0);
            tr_item(inp(F, I_w_in) + (size_t)L * DM * DIN, DIN, src, wsp<bf16>(F, WS_WIN) + (size_t)L * DINP * DM, DM, 64 * nb, 64 * kb, T, lane);
        } else {
            const int r = j - 7 * CV_IFF, kb = r / 32, nb = r % 32;
            tr_item(inp(F, I_w_out) + (size_t)L * DM * DM, DM, 64 * nb, wsp<bf16>(F, WS_WOUT) + (size_t)L * DM * DM, DM, 64 * nb, 64 * kb, T, lane);
        }
    }
    for (int i = tq; i < 256 * 256; i += ntq) {
        const int kc = i & 255, j = i >> 8;
        const int src = j < 16 ? 2560 + j : (j < 24 ? 5648 + (j - 16) : -1);
        v4u o = {0u, 0u, 0u, 0u};
        if (src >= 0) { const float* p = inp(F, I_w_in) + (size_t)L * DM * DIN + (size_t)(8 * kc) * DIN + src;
            o.x = pkb(p[0], p[DIN]); o.y = pkb(p[2 * DIN], p[3 * DIN]); o.z = pkb(p[4 * DIN], p[5 * DIN]); o.w = pkb(p[6 * DIN], p[7 * DIN]); }
        *(v4u*)(wsp<bf16>(F, WS_WIN) + (size_t)L * DINP * DM + (size_t)(DINB + j) * DM + 8 * kc) = o;
    }
}
__device__ __forceinline__ void p0_prologue(Frame& F) {
    PHASE_IDS;
    const int gw = F.vcu * NWAVES + wave, NGW = F.G * NWAVES;
    {
        LAS unsigned* T = (LAS unsigned*)(F.lds) + wave * (32 * 65);
        const int nl = (F.G == 256) ? 1 : DEPTH;
        for (int L = 0; L < nl; ++L) convert_layer(F, L, gw, NGW, blockIdx.x * NTHR + tid, F.G * NTHR, T, lane);
    }
    {
        LAS float* cact = (LAS float*)(F.lds + 81920);
        for (int i = tid; i < NB * DM; i += NTHR) cact[i] = silu_f(inp(F, I_c)[i]);
        __syncthreads();
        const int gtid = blockIdx.x * NTHR + tid, NT = F.G * NTHR;
        constexpr int J4 = MODW / 4, KS = 8, KL = DM / KS;
        for (int i = gtid; i < DEPTH * KS * J4; i += NT) {
            const int j4 = i % J4, ks = (i / J4) % KS, l = i / (J4 * KS);
            const float* wp = inp(F, I_w_mod) + ((size_t)l * DM + ks * KL) * MODW + 4 * j4;
            const LAS float* cp = cact + ks * KL;
            f32x4 acc[NB];
#pragma unroll
            for (int b = 0; b < NB; ++b) acc[b] = (f32x4){0.f, 0.f, 0.f, 0.f};
            for (int k = 0; k < KL; k += 8) {
                f32x4 w[8];
#pragma unroll
                for (int u = 0; u < 8; ++u) w[u] = *(const f32x4*)(wp + (size_t)(k + u) * MODW);
#pragma unroll
                for (int u = 0; u < 8; ++u)
#pragma unroll
                    for (int b = 0; b < NB; ++b) acc[b] += cp[b * DM + k + u] * w[u];
            }
#pragma unroll
            for (int b = 0; b < NB; ++b) *(f32x4*)(wsp<float>(F, WS_PART) + ((size_t)(ks * DEPTH + l) * NB + b) * MODW + 4 * j4) = acc[b];
        }
        __syncthreads();
    }
}

__device__ __forceinline__ void mod_reduce_phase(Frame& F) {
    PHASE_IDS;
    const int gtid = blockIdx.x * NTHR + tid, NT = F.G * NTHR;
    for (int i = gtid; i < DEPTH * NB * 3 * (DM / 4); i += NT) {
        const int c4 = i % (DM / 4), sub = (i / (DM / 4)) % 3, lb = i / (3 * DM / 4), l = lb / NB, b = lb % NB, k = 3 * l + sub;
        f32x4 m[3];
#pragma unroll
        for (int q = 0; q < 3; ++q) { const int col = (3 * sub + q) * DM + 4 * c4; f32x4 a = *(const f32x4*)(inp(F, I_b_mod) + (size_t)l * MODW + col);
#pragma unroll
            for (int ks = 0; ks < 8; ++ks) a += *(const f32x4*)(wsp<float>(F, WS_PART) + ((size_t)ks * DEPTH * NB + lb) * MODW + col);
            m[q] = a; }
        const f32x4 npre = *(const f32x4*)(inp(F, I_norm_pre) + (size_t)k * DM + 4 * c4), npost = *(const f32x4*)(inp(F, I_norm_post) + (size_t)k * DM + 4 * c4);
        float* mc = wsp<float>(F, WS_MOD);
        *(f32x4*)(mc + ((size_t)(k * NB + b) * 3 + 1) * DM + 4 * c4) = npre * (m[1] + 1.0f);
        *(f32x4*)(mc + ((size_t)(k * NB + b) * 3 + 2) * DM + 4 * c4) = m[0];
        *(f32x4*)(mc + ((size_t)((k + 1) * NB + b) * 3 + 0) * DM + 4 * c4) = (m[2] * (sub == 1 ? 1.0f : 0.5f)) * npost;
    }
}

template <bool FIRST, bool LAST, int NR>
__device__ __forceinline__ void thin_phase(Frame& F, int k) {
    PHASE_IDS;
    const int gw = F.vcu * NWAVES + wave, NGW = F.G * NWAVES;
    for (int rq = gw; rq < M / NR; rq += NGW) {
        const int row0 = NR * rq, b = row0 / SEQ;
        u32x2 xb[NR][8], yv[FIRST ? 1 : NR][8]; float ssx[NR], r[NR];
        if constexpr (FIRST) {
            f32x4 xf[NR][8];
#pragma unroll
            for (int t = 0; t < NR; ++t) { const f32x4* xr = (const f32x4*)(inp(F, I_x) + (size_t)(row0 + t) * DM) + lane;
#pragma unroll
                for (int j = 0; j < 8; ++j) xf[t][j] = xr[64 * j]; }
#pragma unroll
            for (int t = 0; t < NR; ++t) { ssx[t] = 0.f; u32x2* xo = (u32x2*)(wsp<bf16>(F, WS_XB) + (size_t)(row0 + t) * DM) + lane;
#pragma unroll
                for (int j = 0; j < 8; ++j) { u32x2 w; w.x = pkb(xf[t][j][0], xf[t][j][1]); w.y = pkb(xf[t][j][2], xf[t][j][3]); xb[t][j] = w; xo[64 * j] = w;
                    const float a0 = bflo(w.x), a1 = bfhi(w.x), a2 = bflo(w.y), a3 = bfhi(w.y); ssx[t] += (a0 * a0 + a1 * a1) + (a2 * a2 + a3 * a3); } }
        } else {
#pragma unroll
            for (int t = 0; t < NR; ++t) { const u32x2* xr = (const u32x2*)(wsp<bf16>(F, WS_XB) + (size_t)(row0 + t) * DM) + lane; const u32x2* yr = (const u32x2*)(wsp<bf16>(F, WS_Y) + (size_t)(row0 + t) * DM) + lane;
#pragma unroll
                for (int j = 0; j < 8; ++j) { xb[t][j] = xr[64 * j]; yv[t][j] = yr[64 * j]; } }
            asm volatile("" ::: "memory");
#pragma unroll
            for (int t = 0; t < NR; ++t) { float ss = 0.f;
#pragma unroll
                for (int j = 0; j < 8; ++j) { const float a0 = bflo(yv[t][j].x), a1 = bfhi(yv[t][j].x), a2 = bflo(yv[t][j].y), a3 = bfhi(yv[t][j].y); ss += (a0 * a0 + a1 * a1) + (a2 * a2 + a3 * a3); }
                r[t] = 1.0f / sqrtf(wave_sum(ss) * (1.0f / DM) + EPS); ssx[t] = 0.f; }
            const f32x4* gp = (const f32x4*)(wsp<float>(F, WS_MOD) + ((size_t)(k * NB + b) * 3 + 0) * DM) + lane;
#pragma unroll
            for (int j = 0; j < 8; ++j) {
                const f32x4 gv = gp[64 * j];
#pragma unroll
                for (int t = 0; t < NR; ++t) {
                    const f32x4 xo4 = (f32x4){bflo(xb[t][j].x), bfhi(xb[t][j].x), bflo(xb[t][j].y), bfhi(xb[t][j].y)};
                    const f32x4 yf = (f32x4){bflo(yv[t][j].x), bfhi(yv[t][j].x), bflo(yv[t][j].y), bfhi(yv[t][j].y)};
                    const f32x4 xn = xo4 + gv * (yf * r[t]);
                    if constexpr (LAST) { ((f32x4*)(F.X + (size_t)(row0 + t) * DM) + lane)[64 * j] = xn; }
                    else { u32x2 w; w.x = pkb(xn[0], xn[1]); w.y = pkb(xn[2], xn[3]); xb[t][j] = w; ((u32x2*)(wsp<bf16>(F, WS_XB) + (size_t)(row0 + t) * DM) + lane)[64 * j] = w;
                        const float a0 = bflo(w.x), a1 = bfhi(w.x), a2 = bflo(w.y), a3 = bfhi(w.y); ssx[t] += (a0 * a0 + a1 * a1) + (a2 * a2 + a3 * a3); }
                }
                asm volatile("" ::: "memory");
            }
        }
        if constexpr (!LAST) {
#pragma unroll
            for (int t = 0; t < NR; ++t) r[t] = 1.0f / sqrtf(wave_sum(ssx[t]) * (1.0f / DM) + EPS);
            const f32x4* bp = (const f32x4*)(wsp<float>(F, WS_MOD) + ((size_t)(k * NB + b) * 3 + 1) * DM) + lane; const f32x4* cp = bp + DM / 4;
#pragma unroll
            for (int j = 0; j < 8; ++j) {
                const f32x4 bv = bp[64 * j], cv = cp[64 * j];
#pragma unroll
                for (int t = 0; t < NR; ++t) {
                    const f32x4 xn = (f32x4){bflo(xb[t][j].x), bfhi(xb[t][j].x), bflo(xb[t][j].y), bfhi(xb[t][j].y)};
                    const f32x4 hv = (xn * r[t]) * bv + cv;
                    u32x2 w; w.x = pkb(hv[0], hv[1]); w.y = pkb(hv[2], hv[3]); ((u32x2*)(wsp<bf16>(F, WS_HB) + (size_t)(row0 + t) * DM) + lane)[64 * j] = w;
                }
                asm volatile("" ::: "memory");
            }
        }
        asm volatile("" ::: "memory");
    }
}

__device__ __forceinline__ void ssd_states_phase(Frame& F, int l) {
    PHASE_IDS;
    LAS bf16* BT = (LAS bf16*)F.lds;
    LAS bf16* XsTb = (LAS bf16*)(F.lds + 128 * 72 * 2);
    LAS float* WL = (LAS float*)(F.lds + 128 * 72 * 2 + 8 * 64 * 72 * 2);
    const int fr = lane & 15, fq = lane >> 4;
    for (int unit = blockIdx.x; unit < NB * NCH * SG; unit += F.G) {
        const int g = unit & 1, c = (unit >> 1) & 31, b = unit >> 6, t0 = b * SEQ + c * CHUNK, h = g * HPG + wave;
        {
            const float a = -__expf(inp(F, I_a_log)[l * SH + h]), bias = inp(F, I_dt_bias)[l * SH + h];
            const float dt = softplus_f(wsp<float>(F, WS_DTF)[(size_t)(t0 + lane) * 32 + h] + bias);
            float inc = dt * a;
#pragma unroll
            for (int o = 1; o < 64; o <<= 1) { const float t = __shfl_up(inc, o); if (lane >= o) inc += t; }
            wsp<float>(F, WS_DT)[(t0 + lane) * 16 + h] = dt; wsp<float>(F, WS_ACS)[(t0 + lane) * 16 + h] = inc;
            WL[wave * 64 + lane] = dt * __expf(__shfl(inc, 63) - inc);
        }
        __syncthreads();
        if (tid < 384) {
            const int cc = tid % 96, seg = tid / 96;
            const int col = cc < 64 ? 512 * g + 8 * cc : (cc < 80 ? 1024 + 128 * g + 8 * (cc - 64) : 1280 + 128 * g + 8 * (cc - 80));
            float w[4][8], bs[8];
#pragma unroll
            for (int k = 0; k < 4; ++k) { const float* wp = inp(F, I_conv_w) + (size_t)(l * 4 + k) * CONVD + col; const f32x4 a0 = *(const f32x4*)wp, a1 = *(const f32x4*)(wp + 4);
                w[k][0] = a0[0]; w[k][1] = a0[1]; w[k][2] = a0[2]; w[k][3] = a0[3]; w[k][4] = a1[0]; w[k][5] = a1[1]; w[k][6] = a1[2]; w[k][7] = a1[3]; }
            { const float* bp = inp(F, I_conv_b) + l * CONVD + col; const f32x4 a0 = *(const f32x4*)bp, a1 = *(const f32x4*)(bp + 4);
              bs[0] = a0[0]; bs[1] = a0[1]; bs[2] = a0[2]; bs[3] = a0[3]; bs[4] = a1[0]; bs[5] = a1[1]; bs[6] = a1[2]; bs[7] = a1[3]; }
            const int lr0 = 16 * seg, tq0 = c * CHUNK + lr0;
            const bf16* src = wsp<bf16>(F, WS_ACT) + (size_t)(t0 + lr0) * DINB + PC_X + col;
            v4u win[19];
#pragma unroll
            for (int r = 0; r < 19; ++r) win[r] = (tq0 + r - 3 >= 0) ? *(const v4u*)(src + (long)(r - 3) * DINB) : (v4u){0u, 0u, 0u, 0u};
            bf16* dst = wsp<bf16>(F, WS_XBC) + (size_t)(t0 + lr0) * CONVD + col;
#pragma unroll
            for (int r = 0; r < 16; ++r) {
                float acc[8];
#pragma unroll
                for (int e = 0; e < 8; ++e) acc[e] = bs[e];
#pragma unroll
                for (int k = 0; k < 4; ++k) { const v4u u = win[r + k];
                    acc[0] += w[k][0] * bflo(u.x); acc[1] += w[k][1] * bfhi(u.x); acc[2] += w[k][2] * bflo(u.y); acc[3] += w[k][3] * bfhi(u.y);
                    acc[4] += w[k][4] * bflo(u.z); acc[5] += w[k][5] * bfhi(u.z); acc[6] += w[k][6] * bflo(u.w); acc[7] += w[k][7] * bfhi(u.w); }
#pragma unroll
                for (int e = 0; e < 8; ++e) acc[e] = silu_f(acc[e]);
                v4u o; o.x = pkb(acc[0], acc[1]); o.y = pkb(acc[2], acc[3]); o.z = pkb(acc[4], acc[5]); o.w = pkb(acc[6], acc[7]);
                *(v4u*)(dst + (size_t)r * CONVD) = o;
                const int lrow = lr0 + r;
                if (cc < 64) {
                    const float sc_ = WL[(cc >> 3) * 64 + lrow]; LAS bf16* d = XsTb + (cc >> 3) * (64 * 72) + (8 * (cc & 7)) * 72 + lrow;
                    const unsigned w0 = pkb(acc[0] * sc_, acc[1] * sc_), w1 = pkb(acc[2] * sc_, acc[3] * sc_), w2 = pkb(acc[4] * sc_, acc[5] * sc_), w3 = pkb(acc[6] * sc_, acc[7] * sc_);
                    d[0] = (bf16)w0; d[72] = (bf16)(w0 >> 16); d[144] = (bf16)w1; d[216] = (bf16)(w1 >> 16); d[288] = (bf16)w2; d[360] = (bf16)(w2 >> 16); d[432] = (bf16)w3; d[504] = (bf16)(w3 >> 16);
                } else if (cc < 80) {
                    LAS bf16* d = BT + (8 * (cc - 64)) * 72 + lrow;
                    d[0] = (bf16)o.x; d[72] = (bf16)(o.x >> 16); d[144] = (bf16)o.y; d[216] = (bf16)(o.y >> 16); d[288] = (bf16)o.z; d[360] = (bf16)(o.z >> 16); d[432] = (bf16)o.w; d[504] = (bf16)(o.w >> 16);
                }
            }
        }
        __syncthreads();
        const LAS bf16* XsT = XsTb + wave * (64 * 72);
        bf16* stp = wsp<bf16>(F, WS_ST) + (size_t)((b * NCH + c) * SH + h) * (SP * SN);
#pragma unroll
        for (int nh = 0; nh < 2; ++nh) {
            f32x4 acc[4][4];
#pragma unroll
            for (int i = 0; i < 4; ++i)
#pragma unroll
                for (int j = 0; j < 4; ++j) acc[i][j] = (f32x4){0.f, 0.f, 0.f, 0.f};
#pragma unroll
            for (int ks = 0; ks < 2; ++ks) {
                bf16x8 xa[4], yb[4];
#pragma unroll
                for (int nt = 0; nt < 4; ++nt) xa[nt] = *(const LAS bf16x8*)(BT + (64 * nh + 16 * nt + fr) * 72 + 32 * ks + 8 * fq);
#pragma unroll
                for (int pt = 0; pt < 4; ++pt) yb[pt] = *(const LAS bf16x8*)(XsT + (16 * pt + fr) * 72 + 32 * ks + 8 * fq);
#pragma unroll
                for (int nt = 0; nt < 4; ++nt)
#pragma unroll
                    for (int pt = 0; pt < 4; ++pt) acc[nt][pt] = MFMA16(xa[nt], yb[pt], acc[nt][pt]);
            }
#pragma unroll
            for (int nt = 0; nt < 4; ++nt)
#pragma unroll
                for (int pt = 0; pt < 4; ++pt) { u32x2 wv; wv.x = pkb(acc[nt][pt][0], acc[nt][pt][1]); wv.y = pkb(acc[nt][pt][2], acc[nt][pt][3]);
                    *(u32x2*)(stp + (16 * pt + fr) * SN + 64 * nh + 16 * nt + 4 * fq) = wv; }
        }
        __syncthreads();
    }
}

__device__ __forceinline__ void scan_block(Frame& F, int sb, int tid) {
    const int i = sb * NTHR + tid, e4 = i & 2047, h = (i >> 11) & 15, b = i >> 15;
    u32x2* p0 = (u32x2*)(wsp<bf16>(F, WS_ST) + (size_t)(b * NCH * SH + h) * (SP * SN)) + e4;
    const float* ap = wsp<float>(F, WS_ACS) + (size_t)(b * SEQ + 63) * 16 + h;
    u32x2 st[NCH]; float dec[NCH];
#pragma unroll
    for (int c = 0; c < NCH; ++c) { st[c] = p0[(size_t)c * (SH * SP * SN / 4)]; dec[c] = ap[c * CHUNK * 16]; }
    f32x4 hs = (f32x4){0.f, 0.f, 0.f, 0.f};
#pragma unroll
    for (int c = 0; c < NCH; ++c) {
        u32x2 w; w.x = pkb(hs[0], hs[1]); w.y = pkb(hs[2], hs[3]); p0[(size_t)c * (SH * SP * SN / 4)] = w;
        const float d = __expf(dec[c]);
        hs = hs * d + (f32x4){bflo(st[c].x), bfhi(st[c].x), bflo(st[c].y), bfhi(st[c].y)};
    }
}
static_assert(fa::LDK == DINB && fa::LDO == DM && fa::D == AHD && fa::LDS_BYTES + SEQ * 4 + 64 <= RING_BYTES, "attention body geometry");
__device__ __forceinline__ void attn_block(Frame& F, int l, char* lds, int bh, int qb, int tid) {
    const int lane = tid & 63, wave = __builtin_amdgcn_readfirstlane(tid >> 6), b = bh / AH, h = bh % AH;
    float* cks = (float*)(lds + fa::LDS_BYTES); float* wtot = cks + SEQ;
    constexpr int W = 1 << 24;
    const int n = qb * 256 + 256;
    {   const float fb = inp(F, I_f_bias)[l * AH + h]; const float* fr_ = wsp<float>(F, WS_DTF) + (size_t)(b * SEQ) * 32 + 16 + h;
        float v[4]; float run = 0.f;
#pragma unroll
        for (int e = 0; e < 4; ++e) { const int t = 4 * tid + e; const float xx = (t < n) ? fr_[(size_t)t * 32] + fb : 0.f; run += (t < n) ? -softplus_f(-xx) : 0.f; v[e] = run; }
        float inc = run;
#pragma unroll
        for (int o = 1; o < 64; o <<= 1) { const float t = __shfl_up(inc, o); if (lane >= o) inc += t; }
        if (lane == 63) wtot[wave] = inc;
        __syncthreads();
        float pre = inc - run;
#pragma unroll
        for (int w2 = 0; w2 < 8; ++w2) pre += (w2 < wave) ? wtot[w2] : 0.f;
        if (4 * tid < n) *(f32x4*)(cks + 4 * tid) = (f32x4){(pre + v[0]) * 11.313708498984761f, (pre + v[1]) * 11.313708498984761f, (pre + v[2]) * 11.313708498984761f, (pre + v[3]) * 11.313708498984761f};
    }
    fa::BlockRef<fa::bf16, fa::bf16> cur;
    const bf16* proj = wsp<bf16>(F, WS_ACT);
    cur.Q = (const fa::bf16*)(proj + (size_t)(b * SEQ + qb * 256) * DINB + PC_Q + h * AHD);
    cur.K = (const fa::bf16*)(proj + (size_t)(b * SEQ) * DINB + PC_K + h * AHD);
    cur.V = (const fa::bf16*)(proj + (size_t)(b * SEQ) * DINB + PC_V + h * AHD);
    cur.O = (fa::bf16*)(wsp<bf16>(F, WS_YCAT) + (size_t)(b * SEQ + qb * 256) * DM + DSSM + h * AHD);
    cur.G = inp(F, I_attn_norm) + l * DATT + h * AHD; cur.P0 = qb * 256;
    fa::Seam<fa::bf16> S;
    fa::causal_swa_prime<fa::bf16, fa::bf16>(cur, W, lds, S);
    fa::causal_swa_block<fa::bf16, fa::bf16>(cur, cur, SEQ, W, lds, S);
}
__device__ __forceinline__ void attn_scan_phase(Frame& F, int l, char* lds) {
    PHASE_IDS;
    if (F.G == 256) {
        const int c = blockIdx.x, xcd = c & 7, slot = c >> 3, qb = slot & 7, grp = xcd + 8 * (slot >> 3);
        const int nscan = qb < 2 ? 2 : (qb < 6 ? 1 : 0), first = qb < 2 ? 2 * qb : qb + 2;
        for (int k = 0; k < nscan; ++k) scan_block(F, grp * 8 + first + k, tid);
        attn_block(F, l, lds, grp, qb, tid);
    } else {
        for (int sb = blockIdx.x; sb < 256; sb += F.G) scan_block(F, sb, tid);
        for (int item = blockIdx.x; item < NB * AH * (SEQ / 256); item += F.G) attn_block(F, l, lds, item >> 3, item & 7, tid);
    }
}

__device__ __forceinline__ void ssd_out_phase(Frame& F, int l) {
    PHASE_IDS;
    LAS bf16* Cn = (LAS bf16*)F.lds;
    LAS bf16* Bn = Cn + 64 * 136;
    LAS bf16* XTb = Bn + 64 * 136;
    LAS bf16* Swb = XTb + 4 * 64 * 72;
    LAS float* ACSh = (LAS float*)(Swb + 8 * 32 * 72);
    LAS float* DTh = ACSh + 256;
    LAS float* SSP = DTh + 256;
    const int fr = lane & 15, fq = lane >> 4, w = wave, hh = w >> 1, lh = w & 1;
    LAS bf16* XT = XTb + hh * (64 * 72); LAS bf16* Sw = Swb + w * (32 * 72);
    for (int unit = blockIdx.x; unit < NB * NCH * SG; unit += F.G) {
        const int g = unit & 1, c = (unit >> 1) & 31, b = unit >> 6, t0 = b * SEQ + c * CHUNK;
#pragma unroll
        for (int i = 0; i < 2; ++i) { const int idx = tid + NTHR * i, row = idx >> 4, ch = idx & 15; const bf16* src = wsp<bf16>(F, WS_XBC) + (size_t)(t0 + row) * CONVD + 128 * g + 8 * ch;
            *(LAS v4u*)(Bn + row * 136 + 8 * ch) = *(const v4u*)(src + (PC_B - PC_X));
            *(LAS v4u*)(Cn + row * 136 + 8 * ch) = *(const v4u*)(src + (PC_C - PC_X)); }
        f32x4 yv[2][2][4];
#pragma unroll
        for (int q = 0; q < 2; ++q) {
            const int h = g * HPG + 4 * q + hh;
            {   const bf16* src = wsp<bf16>(F, WS_XBC) + (size_t)(t0 + 32 * lh) * CONVD + 64 * h;
#pragma unroll
                for (int i = 0; i < 4; ++i) { const int ss_ = 8 * i + (lane >> 3), ch = lane & 7; const v4u v = *(const v4u*)(src + (size_t)ss_ * CONVD + 8 * ch);
                    LAS bf16* d = XT + (8 * ch) * 72 + 32 * lh + ss_;
                    d[0] = (bf16)v.x; d[72] = (bf16)(v.x >> 16); d[144] = (bf16)v.y; d[216] = (bf16)(v.y >> 16); d[288] = (bf16)v.z; d[360] = (bf16)(v.z >> 16); d[432] = (bf16)v.w; d[504] = (bf16)(v.w >> 16); }
                if (lh == 0) { ACSh[hh * 64 + lane] = wsp<float>(F, WS_ACS)[(t0 + lane) * 16 + h]; DTh[hh * 64 + lane] = wsp<float>(F, WS_DT)[(t0 + lane) * 16 + h]; } }
            __syncthreads();
            const LAS float* acsv = ACSh + hh * 64; const LAS float* dtv = DTh + hh * 64;
#pragma unroll
            for (int ltl = 0; ltl < 2; ++ltl) {
                const int lrow = 32 * lh + 16 * ltl + fr; const float al = acsv[lrow];
                bf16x8 yc[4];
#pragma unroll
                for (int ks = 0; ks < 4; ++ks) yc[ks] = *(const LAS bf16x8*)(Cn + lrow * 136 + 32 * ks + 8 * fq);
#pragma unroll
                for (int st = 0; st < 4; ++st) {
                    f32x4 a = (f32x4){0.f, 0.f, 0.f, 0.f};
#pragma unroll
                    for (int ks = 0; ks < 4; ++ks) { const bf16x8 xb = *(const LAS bf16x8*)(Bn + (16 * st + fr) * 136 + 32 * ks + 8 * fq); a = MFMA16(xb, yc[ks], a); }
                    float v[4];
#pragma unroll
                    for (int j = 0; j < 4; ++j) { const int s = 16 * st + 4 * fq + j; v[j] = (s <= lrow) ? a[j] * __expf(al - acsv[s]) * dtv[s] : 0.f; }
                    u32x2 pw; pw.x = pkb(v[0], v[1]); pw.y = pkb(v[2], v[3]);
                    *(LAS u32x2*)(Sw + (16 * ltl + fr) * 72 + 16 * st + 4 * fq) = pw;
                }
            }
            __syncthreads();
            const float dsk = inp(F, I_d_skip)[l * SH + h];
            const bf16* prev = wsp<bf16>(F, WS_ST) + (size_t)((b * NCH + c) * SH + h) * (SP * SN);
#pragma unroll
            for (int ltl = 0; ltl < 2; ++ltl) {
                const int lrow = 32 * lh + 16 * ltl + fr; const float eal = __expf(acsv[lrow]);
                bf16x8 ys[2], yc[4];
#pragma unroll
                for (int ks = 0; ks < 2; ++ks) ys[ks] = *(const LAS bf16x8*)(Sw + (16 * ltl + fr) * 72 + 32 * ks + 8 * fq);
#pragma unroll
                for (int ks = 0; ks < 4; ++ks) yc[ks] = *(const LAS bf16x8*)(Cn + lrow * 136 + 32 * ks + 8 * fq);
                float ssq = 0.f;
#pragma unroll
                for (int pt = 0; pt < 4; ++pt) {
                    f32x4 a = (f32x4){0.f, 0.f, 0.f, 0.f}, o = (f32x4){0.f, 0.f, 0.f, 0.f};
#pragma unroll
                    for (int ks = 0; ks < 2; ++ks) { const bf16x8 xx = *(const LAS bf16x8*)(XT + (16 * pt + fr) * 72 + 32 * ks + 8 * fq); a = MFMA16(xx, ys[ks], a); }
#pragma unroll
                    for (int ks = 0; ks < 4; ++ks) { const bf16x8 xp = *(const bf16x8*)(prev + (16 * pt + fr) * SN + 32 * ks + 8 * fq); o = MFMA16(xp, yc[ks], o); }
                    const int pc = 16 * pt + 4 * fq;
                    const u32x2 zz = *(const u32x2*)(wsp<bf16>(F, WS_ACT) + (size_t)(t0 + lrow) * DINB + PC_Z + 64 * h + pc);
                    f32x4 y;
                    y[0] = (a[0] + eal * o[0] + dsk * bf2f(XT[(pc + 0) * 72 + lrow])) * silu_f(bflo(zz.x));
                    y[1] = (a[1] + eal * o[1] + dsk * bf2f(XT[(pc + 1) * 72 + lrow])) * silu_f(bfhi(zz.x));
                    y[2] = (a[2] + eal * o[2] + dsk * bf2f(XT[(pc + 2) * 72 + lrow])) * silu_f(bflo(zz.y));
                    y[3] = (a[3] + eal * o[3] + dsk * bf2f(XT[(pc + 3) * 72 + lrow])) * silu_f(bfhi(zz.y));
                    yv[q][ltl][pt] = y; ssq += (y[0] * y[0] + y[1] * y[1]) + (y[2] * y[2] + y[3] * y[3]);
                }
                ssq += __shfl_xor(ssq, 16); ssq += __shfl_xor(ssq, 32);
                if (fq == 0) SSP[lrow * 8 + 4 * q + hh] = ssq;
            }
            __syncthreads();
        }
#pragma unroll
        for (int ltl = 0; ltl < 2; ++ltl) {
            const int lrow = 32 * lh + 16 * ltl + fr;
            const f32x4 s0 = *(const LAS f32x4*)(SSP + lrow * 8), s1 = *(const LAS f32x4*)(SSP + lrow * 8 + 4);
            const float r = 1.0f / sqrtf(((s0[0] + s0[1]) + (s0[2] + s0[3]) + (s1[0] + s1[1]) + (s1[2] + s1[3])) * (1.0f / 512.0f) + EPS);
#pragma unroll
            for (int q = 0; q < 2; ++q) { const int h = g * HPG + 4 * q + hh;
#pragma unroll
                for (int pt = 0; pt < 4; ++pt) { const int pc = 16 * pt + 4 * fq; const f32x4 wn = *(const f32x4*)(inp(F, I_ssm_norm) + l * DSSM + 64 * h + pc); const f32x4 y = yv[q][ltl][pt];
                    u32x2 ow; ow.x = pkb(y[0] * r * wn[0], y[1] * r * wn[1]); ow.y = pkb(y[2] * r * wn[2], y[3] * r * wn[3]);
                    *(u32x2*)(wsp<bf16>(F, WS_YCAT) + (size_t)(t0 + lrow) * DM + 64 * h + pc) = ow; } }
        }
        __syncthreads();
    }
}

struct Args { const float* in[19]; float* out; unsigned char* ws; };
__global__ void __launch_bounds__(NWAVES * 64, 2) fwd_kernel(Args args) {
    extern __shared__ __attribute__((aligned(16))) unsigned char lds[];
    Frame F;
    F.lds = (LAS unsigned char*)lds;
    F.MISC = (volatile LAS unsigned*)(F.lds + MISC_OFF);
    F.G = gridDim.x; { const int bx = blockIdx.x; F.vcu = (F.G % 8 == 0) ? (bx % 8) * (F.G / 8) + bx / 8 : bx; }
    F.ws = args.ws; F.X = args.out;
    for (int u = threadIdx.x; u < (LDS_BYTES - LDSCTL_OFF) / 4; u += NWAVES * 64) ((LAS unsigned*)(F.lds + LDSCTL_OFF))[u] = 0u;
    __syncthreads();
    if (threadIdx.x == 0) { LAS unsigned* t = (LAS unsigned*)(F.lds + LDSCTL_OFF);
#pragma unroll
        for (int k = 0; k < I_N; ++k) { const unsigned long long p = (unsigned long long)args.in[k]; t[2 * k] = (unsigned)p; t[2 * k + 1] = (unsigned)(p >> 32); } }
    __syncthreads();
    XcdBarrier bar = xcd_barrier_post((unsigned*)(args.ws + WS_CTL) + CW_BAR, F.MISC + 8);
#define GRID_BAR() do { XcdBarrier b_ = bar; GAS unsigned* p_ = (GAS unsigned*)bar.bar; asm volatile("" : "+s"(p_), "+s"(b_.x)); b_.bar = (unsigned*)p_; xcd_barrier(b_); } while (0)

    p0_prologue(F);
    GRID_BAR();
    mod_reduce_phase(F);
    GRID_BAR();
    thin_phase<true, false, 2>(F, 0);
    for (int s = 0; s < 3 * DEPTH; ++s) {
        const int l = s / 3, sub = s % 3;
        if (s > 0) thin_phase<false, false, 4>(F, s);
        GRID_BAR();
        if (sub != 1) {
            const int lf = l * 2 + (sub == 2 ? 1 : 0);
            pg8::Gemm g{wsp<bf16>(F, WS_HB), wsp<bf16>(F, WS_WGU) + (size_t)lf * NGU * DM, M, NGU, DM}; pg8::StaticOrder S; S.init(M, NGU, F.G, (int)blockIdx.x);
            pg8::EpiSwiGLU E{wsp<bf16>(F, WS_ACT), DFF};
            pg8::gemm_phase<pg8::EpiSwiGLU, pg8::StaticOrder, true, true>(F.lds, g, S, E);
            if (F.G == 256 && blockIdx.x >= 128 && l + 1 < DEPTH) {
                const int tid_ = fresh_tid(), wv_ = __builtin_amdgcn_readfirstlane(tid_ >> 6), ph_ = (sub == 2 ? 1 : 0), slot_ = ph_ * 128 + ((int)blockIdx.x - 128);
                convert_layer(F, l + 1, slot_ * NWAVES + wv_, 2 * 128 * NWAVES, slot_ * NTHR + tid_, 2 * 128 * NTHR, (LAS unsigned*)(F.lds) + wv_ * (32 * 65), tid_ & 63);
            }
            GRID_BAR();
        } else {
            {   pg8::Gemm g{wsp<bf16>(F, WS_HB), wsp<bf16>(F, WS_WIN) + (size_t)l * DINP * DM, M, DINP, DM}; pg8::StaticOrder S; S.init(M, DINP, F.G, (int)blockIdx.x);
                pg8::EpiProj E{wsp<bf16>(F, WS_ACT), DINB, wsp<float>(F, WS_DTF), DINB / 256};
                pg8::gemm_phase<pg8::EpiProj, pg8::StaticOrder, true, true>(F.lds, g, S, E); }
            GRID_BAR();
            ssd_states_phase(F, l);
            GRID_BAR();
            attn_scan_phase(F, l, (char*)lds);
            GRID_BAR();
            ssd_out_phase(F, l);
            GRID_BAR();
        }
        {   const bool mix = (sub == 1); const int lf = l * 2 + (sub == 2 ? 1 : 0);
            pg8::Gemm g{mix ? wsp<bf16>(F, WS_YCAT) : wsp<bf16>(F, WS_ACT), mix ? wsp<bf16>(F, WS_WOUT) + (size_t)l * DM * DM : wsp<bf16>(F, WS_WDN) + (size_t)lf * DM * DFF, M, DM, mix ? DM : DFF}; pg8::StaticOrder S; S.init(M, DM, F.G, (int)blockIdx.x);
            pg8::EpiProj E{wsp<bf16>(F, WS_Y), DM, nullptr, 1 << 30};
            pg8::gemm_phase<pg8::EpiProj, pg8::StaticOrder, true, true>(F.lds, g, S, E); }
        GRID_BAR();
    }
    thin_phase<false, true, 4>(F, 3 * DEPTH);
}

extern "C" void kernel_launch(void* const* d_in, const int* in_sizes, int n_in, void* d_out, int out_size, void* d_ws, size_t ws_size, hipStream_t stream) {
    static int grid = 0;
    if (grid == 0) {
        if (n_in != 19 || in_sizes[0] != M * DM || out_size != M * DM || ws_size < WS_END) { fprintf(stderr, "kernel_launch: unexpected shapes (n_in %d, in0 %d, out %d, ws %zu < %zu)\n", n_in, n_in > 0 ? in_sizes[0] : -1, out_size, ws_size, (size_t)WS_END); grid = -1; return; }
        int dev = 0, cus = 0, per_cu = 0;
        if (hipGetDevice(&dev) != hipSuccess || hipDeviceGetAttribute(&cus, hipDeviceAttributeMultiprocessorCount, dev) != hipSuccess) { grid = -1; return; }
        if (hipFuncSetAttribute((const void*)fwd_kernel, hipFuncAttributeMaxDynamicSharedMemorySize, LDS_BYTES) != hipSuccess) { fprintf(stderr, "kernel_launch: hipFuncSetAttribute failed\n"); grid = -1; return; }
        if (hipOccupancyMaxActiveBlocksPerMultiprocessor(&per_cu, (const void*)fwd_kernel, NWAVES * 64, LDS_BYTES) != hipSuccess || per_cu < 1) { fprintf(stderr, "kernel_launch: occupancy query says %d\n", per_cu); }
        (void)hipGetLastError();
        grid = cus;
    }
    if (grid < 0) return;
    if (hipMemsetAsync((char*)d_ws + WS_CTL, 0, CTL_ZERO_BYTES, stream) != hipSuccess) return;
    Args a{};
    for (int i = 0; i < 19; ++i) a.in[i] = (const float*)d_in[i];
    a.out = (float*)d_out; a.ws = (unsigned char*)d_ws;
    hipLaunchKernelGGL(fwd_kernel, dim3(grid), dim3(NWAVES * 64), LDS_BYTES, stream, a);
}
```

```cpp
#include <hip/hip_runtime.h>
#include <hip/hip_bf16.h>
#include <cstdio>
#include <cstdint>
namespace pg8 {
#define PG8_LAS __attribute__((address_space(3)))
typedef unsigned short bf16_t;
typedef short bf16x8 __attribute__((ext_vector_type(8)));
typedef float f32x4 __attribute__((ext_vector_type(4)));
typedef unsigned u32x4 __attribute__((ext_vector_type(4)));
constexpr int BM = 256, BK = 64, HALF = 128, HTB = HALF * BK * 2  , STAGE_BYTES = 8 * HTB, NXCD = 8, WGM = 8;

__host__ __device__ __forceinline__ int lds_byte(int r, int c) { const int st = (r >> 4) * 2 + (c >> 5), rr = r & 15, cc = c & 31, ob = rr * 64 + cc * 2; return st * 1024 + (ob ^ (((ob >> 9) & 1) << 5)); }
__host__ __device__ __forceinline__ void stage_rc(int b, int& R, int& C) { const int st = b / 1024, sb = b % 1024, swz = sb ^ (((sb >> 9) & 1) << 5); R = (st >> 1) * 16 + swz / 64; C = (st & 1) * 32 + (swz % 64) / 2; }
__host__ __device__ __forceinline__ int perm32(int rho) { const int n = rho >> 4, i = rho & 15; return 8 * (i >> 2) + 4 * n + (i & 3); }

struct Unit { int pm, pn; };
struct Gemm { const bf16_t* A; const bf16_t* Bt; int M, N, K; };

struct StaticOrder {
    int nM, nN, nwg, G, c;
    __host__ __device__ void init(int M, int N, int G_, int c_) { nM = M / BM; nN = N / BM; nwg = nM * nN; G = G_; c = c_; }
    __host__ __device__ bool next(int i, Unit& u) const {
        const long L = (long)i * G + c; if (L >= nwg) return false;
        int wgid = (int)L; { const int q = nwg / NXCD, r = nwg % NXCD, xcd = wgid % NXCD, off = wgid / NXCD; wgid = (xcd < r ? xcd * (q + 1) : r * (q + 1) + (xcd - r) * q) + off; }
        const int nig = WGM * nN, gid = wgid / nig, fm = gid * WGM, gsz = (nM - fm) < WGM ? (nM - fm) : WGM;
        u.pm = fm + ((wgid % nig) % gsz); u.pn = (wgid % nig) / gsz; return true;
    }
    __device__ __forceinline__ void a_ready(const Unit&) const {}
    __device__ __forceinline__ void done(const Unit&) const {}
};

__device__ __forceinline__ unsigned cvt_pk_bf16(float lo, float hi) { unsigned r; asm volatile("v_cvt_pk_bf16_f32 %0, %1, %2" : "=v"(r) : "v"(lo), "v"(hi)); return r; }
typedef float f32x2 __attribute__((ext_vector_type(2)));
typedef __bf16 bf16x2_t __attribute__((ext_vector_type(2)));
__device__ __forceinline__ unsigned pk_bf16(float lo, float hi) { f32x2 v = {lo, hi}; bf16x2_t b = __builtin_convertvector(v, bf16x2_t); return __builtin_bit_cast(unsigned, b); }
__device__ __forceinline__ float silu_f(float g) { return g * __builtin_amdgcn_rcpf(1.0f + __expf(-g)); }

struct EpiF32 {
    static constexpr bool PERM = false, AFTER_DRAIN = false;
    float* C; int ldc;
    __device__ __forceinline__ void operator()(const f32x4 (&acc)[2][2][4][2], const Unit& u, int wr, int wc, int fr, int fq) const {
        const int row0 = u.pm * BM + wr * 64 + fr, col0 = u.pn * BM + wc * 32 + 4 * fq;
#pragma unroll
        for (int ai = 0; ai < 2; ++ai)
#pragma unroll
            for (int m = 0; m < 4; ++m) { float* rowp = C + (size_t)(row0 + ai * HALF + m * 16) * ldc + col0;
#pragma unroll
                for (int bj = 0; bj < 2; ++bj)
#pragma unroll
                    for (int n = 0; n < 2; ++n) *(f32x4*)(rowp + bj * HALF + n * 16) = acc[ai][bj][m][n]; }
    }
};
struct EpiSwiGLU {
    static constexpr bool PERM = true, AFTER_DRAIN = false;
    bf16_t* O; int ldc;
    __device__ __forceinline__ void operator()(const f32x4 (&acc)[2][2][4][2], const Unit& u, int wr, int wc, int fr, int fq) const {
        const int row0 = u.pm * BM + wr * 64 + fr, col0 = u.pn * HALF + wc * 32 + 8 * fq;
#pragma unroll
        for (int ai = 0; ai < 2; ++ai)
#pragma unroll
            for (int m = 0; m < 4; ++m) { bf16_t* rowp = O + (size_t)(row0 + ai * HALF + m * 16) * ldc + col0;
                const f32x4 g0 = acc[ai][0][m][0], g1 = acc[ai][0][m][1], u0 = acc[ai][1][m][0], u1 = acc[ai][1][m][1];
                u32x4 w;
                w.x = pk_bf16(silu_f(g0[0]) * u0[0], silu_f(g0[1]) * u0[1]); w.y = pk_bf16(silu_f(g0[2]) * u0[2], silu_f(g0[3]) * u0[3]);
                w.z = pk_bf16(silu_f(g1[0]) * u1[0], silu_f(g1[1]) * u1[1]); w.w = pk_bf16(silu_f(g1[2]) * u1[2], silu_f(g1[3]) * u1[3]);
                *(u32x4*)rowp = w; }
    }
};
struct EpiProj {
    static constexpr bool PERM = true, AFTER_DRAIN = false;
    bf16_t* O; int ldc; float* dtf; int nbf;
    __device__ __forceinline__ void operator()(const f32x4 (&acc)[2][2][4][2], const Unit& u, int wr, int wc, int fr, int fq) const {
        const int row0 = u.pm * BM + wr * 64 + fr;
        if (u.pn < nbf) {
            const int col0 = u.pn * BM + wc * 32 + 8 * fq;
#pragma unroll
            for (int ai = 0; ai < 2; ++ai)
#pragma unroll
                for (int m = 0; m < 4; ++m) { bf16_t* rowp = O + (size_t)(row0 + ai * HALF + m * 16) * ldc + col0;
#pragma unroll
                    for (int bj = 0; bj < 2; ++bj) { const f32x4 v0 = acc[ai][bj][m][0], v1 = acc[ai][bj][m][1];
                        u32x4 w; w.x = pk_bf16(v0[0], v0[1]); w.y = pk_bf16(v0[2], v0[3]); w.z = pk_bf16(v1[0], v1[1]); w.w = pk_bf16(v1[2], v1[3]);
                        *(u32x4*)(rowp + bj * HALF) = w; } }
        } else if (wc == 0) {
#pragma unroll
            for (int ai = 0; ai < 2; ++ai)
#pragma unroll
                for (int m = 0; m < 4; ++m) { float* rp = dtf + (size_t)(row0 + ai * HALF + m * 16) * 32 + 8 * fq;
                    *(f32x4*)rp = acc[ai][0][m][0]; *(f32x4*)(rp + 4) = acc[ai][0][m][1]; }
        }
    }
};
template <class Epi, class Sched, bool ALIGN_EPI = false, bool SP2 = false>
__device__ __forceinline__ void gemm_phase(PG8_LAS unsigned char* lds, const Gemm g, const Sched& S, const Epi& E) {
    int tid_ = threadIdx.x; asm volatile("" : "+v"(tid_)); const int tid = tid_, wid = __builtin_amdgcn_readfirstlane(tid >> 6), lane = tid & 63, wr = wid >> 2, wc = wid & 3, fr = lane & 15, fq = lane >> 4;
    const int K = g.K, nt = K / BK;
    unsigned voffA[2], voffB[2];
#pragma unroll
    for (int i = 0; i < 2; ++i) { int R, C; stage_rc(tid * 16 + i * 8192, R, C); const int Rb = Epi::PERM ? ((R & ~31) + perm32(R & 31)) : R;
        voffA[i] = (unsigned)(R * K + C) * 2u; voffB[i] = (unsigned)(Rb * K + C) * 2u; }
    const size_t kstep = (size_t)(BK * 2);
    const size_t hstep = (size_t)HALF * K * 2;
    const size_t tstep = 2 * hstep;
    const unsigned ldsw = (unsigned)wid * 1024u;
    const int aoff = lds_byte(wr * 64 + fr, fq * 8), boff = lds_byte(wc * 32 + fr, fq * 8);
#define PG8_SA(b, h) (((b) * 2 + (h)) * HTB)
#define PG8_SB(b, h) ((4 + (b) * 2 + (h)) * HTB)
#define PG8_STAGE(bufoff, gbase, voff) do { _Pragma("unroll") for (int _i = 0; _i < 2; ++_i) \
        __builtin_amdgcn_global_load_lds((const unsigned*)((const char*)(gbase) + (voff)[_i]), (PG8_LAS unsigned*)(lds + (bufoff) + ldsw + _i * 8192), 16, 0, 0); } while (0)
#define PG8_LDA(dst, b, h) do { _Pragma("unroll") for (int m = 0; m < 4; ++m) _Pragma("unroll") for (int k = 0; k < 2; ++k) dst[m][k] = *(const PG8_LAS bf16x8*)(lds + PG8_SA(b, h) + aoff + m * 2048 + k * 1024); } while (0)
#define PG8_LDB(dst, b, h) do { _Pragma("unroll") for (int n = 0; n < 2; ++n) _Pragma("unroll") for (int k = 0; k < 2; ++k) dst[n][k] = *(const PG8_LAS bf16x8*)(lds + PG8_SB(b, h) + boff + n * 2048 + k * 1024); } while (0)
#define PG8_MMA(ai, bj, At, Bt) do { __builtin_amdgcn_s_setprio(1); _Pragma("unroll") for (int m = 0; m < 4; ++m) _Pragma("unroll") for (int n = 0; n < 2; ++n) _Pragma("unroll") for (int k = 0; k < 2; ++k) \
        acc[ai][bj][m][n] = __builtin_amdgcn_mfma_f32_16x16x32_bf16(Bt[n][k], At[m][k], acc[ai][bj][m][n], 0, 0, 0); __builtin_amdgcn_s_setprio(0); } while (0)
#define PG8_WAIT_V(n) asm volatile("s_waitcnt vmcnt(" #n ")" ::: "memory")
#define PG8_WAIT_L(n) asm volatile("s_waitcnt lgkmcnt(" #n ")" ::: "memory")
#define PG8_BAR __builtin_amdgcn_s_barrier()
#define PG8_SCHED __builtin_amdgcn_sched_barrier(0)
    Unit cur, nxt; int ui = 0;
    if (!S.next(0, cur)) return;
    f32x4 acc[2][2][4][2];
#pragma unroll
    for (int a = 0; a < 2; ++a)
#pragma unroll
        for (int b = 0; b < 2; ++b)
#pragma unroll
            for (int m = 0; m < 4; ++m)
#pragma unroll
                for (int n = 0; n < 2; ++n) acc[a][b][m][n] = (f32x4){0.f, 0.f, 0.f, 0.f};
    bf16x8 At[4][2], B0[2][2], B1[2][2];
    const char* cA = (const char*)g.A + (size_t)cur.pm * tstep; const char* cB = (const char*)g.Bt + (size_t)cur.pn * tstep;
    S.a_ready(cur);
    if constexpr (SP2) {
        PG8_STAGE(PG8_SB(0, 0), cB, voffB); PG8_STAGE(PG8_SB(0, 1), cB + hstep, voffB); PG8_STAGE(PG8_SA(0, 0), cA, voffA); PG8_STAGE(PG8_SA(0, 1), cA + hstep, voffA);
        if (wr == 1) PG8_BAR;
        PG8_WAIT_V(2); PG8_BAR;
        PG8_STAGE(PG8_SB(1, 0), cB + kstep, voffB); PG8_STAGE(PG8_SA(1, 0), cA + kstep, voffA); PG8_STAGE(PG8_SB(1, 1), cB + hstep + kstep, voffB);
        PG8_WAIT_V(6); PG8_BAR;
    } else {
        PG8_STAGE(PG8_SB(0, 0), cB, voffB); PG8_STAGE(PG8_SA(0, 0), cA, voffA); PG8_STAGE(PG8_SB(0, 1), cB + hstep, voffB); PG8_STAGE(PG8_SA(0, 1), cA + hstep, voffA);
        if (wr == 1) PG8_BAR;
        PG8_WAIT_V(4); PG8_BAR;
        PG8_STAGE(PG8_SB(1, 0), cB + kstep, voffB); PG8_STAGE(PG8_SA(1, 0), cA + kstep, voffA); PG8_STAGE(PG8_SB(1, 1), cB + hstep + kstep, voffB);
        PG8_WAIT_V(6); PG8_BAR;
    }
    for (;;) {
        const bool has_next = S.next(ui + 1, nxt);
        const char* nA = has_next ? (const char*)g.A + (size_t)nxt.pm * tstep : cA; const char* nB = has_next ? (const char*)g.Bt + (size_t)nxt.pn * tstep : cB;
        for (int t = 0; t < nt; t += 2) {
            const bool last = (t == nt - 2);
            const char* a1 = cA + (size_t)(t + 1) * kstep;
            const char* a2 = last ? nA : cA + (size_t)(t + 2) * kstep; const char* b2 = last ? nB : cB + (size_t)(t + 2) * kstep;
            const char* a3 = a2 + kstep; const char* b3 = b2 + kstep;
            if (last && has_next) S.a_ready(nxt);
            if constexpr (SP2) {
            PG8_LDB(B0, 0, 0); PG8_LDB(B1, 0, 1); PG8_SCHED; PG8_LDA(At, 0, 0); PG8_STAGE(PG8_SA(1, 1), a1 + hstep, voffA);
            PG8_WAIT_V(8); PG8_WAIT_L(0); PG8_BAR; PG8_MMA(0, 0, At, B0); PG8_MMA(0, 1, At, B1); PG8_BAR; PG8_SCHED;
            PG8_LDA(At, 0, 1); PG8_STAGE(PG8_SB(0, 0), b2, voffB); PG8_STAGE(PG8_SB(0, 1), b2 + hstep, voffB); PG8_STAGE(PG8_SA(0, 0), a2, voffA);
            PG8_WAIT_V(8); PG8_WAIT_L(0); PG8_BAR; PG8_MMA(1, 0, At, B0); PG8_MMA(1, 1, At, B1); PG8_BAR; PG8_SCHED;
            PG8_LDB(B0, 1, 0); PG8_LDB(B1, 1, 1); PG8_SCHED; PG8_LDA(At, 1, 0); PG8_STAGE(PG8_SA(0, 1), a2 + hstep, voffA);
            PG8_WAIT_V(8); PG8_WAIT_L(0); PG8_BAR; PG8_MMA(0, 0, At, B0); PG8_MMA(0, 1, At, B1); PG8_BAR; PG8_SCHED;
            PG8_LDA(At, 1, 1); PG8_STAGE(PG8_SB(1, 0), b3, voffB); PG8_STAGE(PG8_SB(1, 1), b3 + hstep, voffB); PG8_STAGE(PG8_SA(1, 0), a3, voffA);
            PG8_WAIT_V(8); PG8_WAIT_L(0); PG8_BAR; PG8_MMA(1, 0, At, B0); PG8_MMA(1, 1, At, B1); PG8_BAR; PG8_SCHED;
            } else {
            PG8_LDB(B0, 0, 0); PG8_SCHED; PG8_LDA(At, 0, 0); PG8_STAGE(PG8_SA(1, 1), a1 + hstep, voffA);
            PG8_WAIT_L(8); PG8_BAR; PG8_WAIT_L(0); PG8_MMA(0, 0, At, B0); PG8_BAR; PG8_SCHED;
            PG8_LDB(B1, 0, 1); PG8_STAGE(PG8_SB(0, 0), b2, voffB);
            PG8_BAR; PG8_WAIT_L(0); PG8_MMA(0, 1, At, B1); PG8_BAR;
            PG8_LDA(At, 0, 1); PG8_STAGE(PG8_SA(0, 0), a2, voffA);
            PG8_BAR; PG8_WAIT_L(0); PG8_MMA(1, 0, At, B0); PG8_BAR; PG8_SCHED;
            PG8_STAGE(PG8_SB(0, 1), b2 + hstep, voffB);
            PG8_WAIT_V(6); PG8_BAR; PG8_MMA(1, 1, At, B1); PG8_BAR;
            PG8_LDB(B0, 1, 0); PG8_SCHED; PG8_LDA(At, 1, 0); PG8_STAGE(PG8_SA(0, 1), a2 + hstep, voffA);
            PG8_WAIT_L(8); PG8_BAR; PG8_WAIT_L(0); PG8_MMA(0, 0, At, B0); PG8_BAR; PG8_SCHED;
            PG8_LDB(B1, 1, 1); PG8_STAGE(PG8_SB(1, 0), b3, voffB);
            PG8_BAR; PG8_WAIT_L(0); PG8_MMA(0, 1, At, B1); PG8_BAR;
            PG8_LDA(At, 1, 1); PG8_STAGE(PG8_SA(1, 0), a3, voffA);
            PG8_BAR; PG8_WAIT_L(0); PG8_MMA(1, 0, At, B0); PG8_BAR; PG8_SCHED;
            PG8_STAGE(PG8_SB(1, 1), b3 + hstep, voffB);
            PG8_WAIT_V(6); PG8_BAR; PG8_MMA(1, 1, At, B1); PG8_BAR;
            }
        }
        if constexpr (ALIGN_EPI) { if (wr == 0) PG8_BAR; }
        if constexpr (!Epi::AFTER_DRAIN) { E(acc, cur, wr, wc, fr, fq); S.done(cur); }
        if (!has_next) break;
#pragma unroll
        for (int a = 0; a < 2; ++a)
#pragma unroll
            for (int b = 0; b < 2; ++b)
#pragma unroll
                for (int m = 0; m < 4; ++m)
#pragma unroll
                    for (int n = 0; n < 2; ++n) acc[a][b][m][n] = (f32x4){0.f, 0.f, 0.f, 0.f};
        cur = nxt; cA = nA; cB = nB; ++ui;
        if constexpr (ALIGN_EPI) { if (wr == 1) PG8_BAR; }
    }
    PG8_WAIT_V(0);
    if constexpr (!ALIGN_EPI) { if (wr == 0) PG8_BAR; }
    PG8_BAR;
    if constexpr (Epi::AFTER_DRAIN) { E.fused(acc, cur, wr, wc, fr, fq, lds, wid, lane); S.done(cur); }
#undef PG8_SA
#undef PG8_SB
#undef PG8_STAGE
#undef PG8_LDA
#undef PG8_LDB
#undef PG8_MMA
#undef PG8_WAIT_V
#undef PG8_WAIT_L
#undef PG8_BAR
#undef PG8_SCHED
}
}

constexpr int NWAVES = 8, NTHR = NWAVES * 64;
constexpr int NB = 4, SEQ = 2048, DM = 2048, DEPTH = 4, M = NB * SEQ;
constexpr int CHUNK = 64, NCH = SEQ / CHUNK;
constexpr int DSSM = 1024, SP = 64, SH = 16, SG = 2, HPG = 8, SN = 128, CONVD = 1536;
constexpr int DATT = 1024, AHD = 128, AH = 8;
constexpr int DFF = 5632, NMOD = 9, MODW = NMOD * DM, NGU = 2 * DFF;
constexpr int DIN = 5656, DINB = 5632, DINP = 5888;
constexpr int PC_Z = 0, PC_X = 1024, PC_B = 2048, PC_C = 2304, PC_Q = 2560, PC_K = 3584, PC_V = 4608;
constexpr float EPS = 1e-6f;

constexpr size_t MiB = 1u << 20;
constexpr size_t WS_CTL = 0, CTL_ZERO_BYTES = 4 * MiB;
constexpr size_t WS_MOD = 1 * MiB;
constexpr size_t WS_WGU = 4 * MiB;
constexpr size_t WS_WDN = WS_WGU + (size_t)DEPTH * 2 * NGU * DM * 2;
constexpr size_t WS_WIN = WS_WDN + (size_t)DEPTH * 2 * DM * DFF * 2;
constexpr size_t WS_WOUT = WS_WIN + (size_t)DEPTH * DINP * DM * 2;
constexpr size_t WS_HB = WS_WOUT + (size_t)DEPTH * DM * DM * 2;
constexpr size_t WS_ACT = WS_HB + (size_t)M * DM * 2;
constexpr size_t WS_Y = WS_ACT + (size_t)M * DFF * 2;
constexpr size_t WS_DTF = WS_Y + (size_t)M * DM * 4;
constexpr size_t WS_XBC = WS_DTF + (size_t)M * 32 * 4;
constexpr size_t WS_DT = WS_XBC + (size_t)M * CONVD * 2;
constexpr size_t WS_ACS = WS_DT + (size_t)M * 16 * 4;
constexpr size_t WS_CUMF = WS_ACS + (size_t)M * 16 * 4;
constexpr size_t WS_ST = WS_CUMF + (size_t)NB * AH * SEQ * 4;
constexpr size_t WS_YCAT = WS_ST + (size_t)NB * NCH * SH * SP * SN * 4;
constexpr size_t WS_PART = WS_YCAT + (size_t)M * DM * 2;
constexpr size_t WS_XB = WS_PART + (size_t)8 * DEPTH * NB * MODW * 4;
constexpr size_t WS_END = WS_XB + (size_t)M * DM * 2;
constexpr int CW_BAR = 4096;

constexpr int RING_BYTES = 131072;
constexpr int LDSCTL_OFF = RING_BYTES, MISC_OFF = LDSCTL_OFF + 320;
constexpr int LDS_BYTES = 147456;

#define GAS __attribute__((address_space(1)))
#define LAS __attribute__((address_space(3)))
typedef unsigned short bf16;
typedef unsigned v4u __attribute__((ext_vector_type(4)));
typedef float f32x4 __attribute__((ext_vector_type(4)));
typedef short bf16x8 __attribute__((ext_vector_type(8)));
typedef GAS unsigned gu32;
typedef GAS unsigned long long gu64;
#define RLX_AGENT __ATOMIC_RELAXED, __HIP_MEMORY_SCOPE_AGENT
#define LDS_WAIT() asm volatile("s_waitcnt lgkmcnt(0)" ::: "memory")
#define VM_WAIT() asm volatile("s_waitcnt vmcnt(0)" ::: "memory")
__device__ __forceinline__ unsigned long long rt() { return __builtin_amdgcn_s_memrealtime(); }
__device__ __forceinline__ unsigned f2bf(float f) { unsigned u = __builtin_bit_cast(unsigned, f); return (u + 0x7fffu + ((u >> 16) & 1u)) >> 16; }
__device__ __forceinline__ unsigned pk2(float lo, float hi) { return f2bf(lo) | (f2bf(hi) << 16); }

#define XB_TMO      128
#define XB_XCNT(j)  (256  + 64 * (j))
#define XB_XSUB(j)  (1280 + 64 * (j))
#define XB_XGEN(j)  (2304 + 64 * (j))
#define XB_TOP      3328
#define XB_TOPGEN   3392
#define XCD_BAR_WORDS 3456
#define XB_SPIN_CAP (1u << 18)

__device__ __forceinline__ unsigned xb_ld(unsigned* p)              { return __hip_atomic_load(p, __ATOMIC_RELAXED, __HIP_MEMORY_SCOPE_AGENT); }
__device__ __forceinline__ unsigned xb_add(unsigned* p, unsigned v) { return __hip_atomic_fetch_add(p, v, __ATOMIC_RELAXED, __HIP_MEMORY_SCOPE_AGENT); }
__device__ __forceinline__ unsigned xb_xcc_id() { return (unsigned)__builtin_amdgcn_s_getreg((3 << 11) | 20) & 0xFu; }
#define XB_SPIN(cond, bar) do { unsigned _sp = 0; while (cond) { __builtin_amdgcn_s_sleep(1); \
    if ((++_sp & 255u) == 0u) { if (xb_ld(&(bar)[XB_TMO])) break; if (_sp > XB_SPIN_CAP) { atomicAdd(&(bar)[XB_TMO], 1u); break; } } } } while (0)

struct XcdBarrier {
    unsigned* bar; unsigned x;
    volatile LAS unsigned* st;
};

__device__ __forceinline__ XcdBarrier xcd_barrier_post(unsigned* bar, volatile LAS unsigned* st) {
    XcdBarrier b; b.bar = bar; b.x = xb_xcc_id(); b.st = st;
    if (threadIdx.x == 0) (void)xb_add(&bar[XB_XCNT(b.x)], 1u);
    return b;
}
__device__ __forceinline__ void xcd_barrier_complete(unsigned* bar, unsigned x, unsigned& nloc, unsigned& nx) {
    const unsigned G = gridDim.x * gridDim.y * gridDim.z;
    unsigned sum, cnt, mine, sp = 0u;
    for (;;) {
        sum = 0u; cnt = 0u; mine = 0u;
#pragma unroll
        for (unsigned j = 0; j < 16; ++j) { const unsigned c = xb_ld(&bar[XB_XCNT(j)]); sum += c; cnt += (c > 0u) ? 1u : 0u; mine = (j == x) ? c : mine; }
        if (sum == G) break;
        __builtin_amdgcn_s_sleep(1);
        if ((++sp & 255u) == 0u) { if (xb_ld(&bar[XB_TMO])) break; if (sp > XB_SPIN_CAP) { atomicAdd(&bar[XB_TMO], 1u); break; } }
    }
    nloc = mine > 0u ? mine : 1u; nx = cnt > 0u ? cnt : 1u;
}

__device__ __forceinline__ void xcd_barrier(const XcdBarrier& b) {
    asm volatile("s_waitcnt vmcnt(0)" ::: "memory");
    __syncthreads();
    if (threadIdx.x == 0) {
        unsigned* bar = b.bar;
        __builtin_amdgcn_s_waitcnt(0);
        unsigned nloc = b.st[0], nx = b.st[1];
        if (nloc == 0u) { xcd_barrier_complete(bar, b.x, nloc, nx); b.st[0] = nloc; b.st[1] = nx; }
        const unsigned old = xb_add(&bar[XB_XSUB(b.x)], 1u);
        const unsigned gen = old / nloc;
        if (old + 1u == (gen + 1u) * nloc) {
            __builtin_amdgcn_fence(__ATOMIC_RELEASE, "agent");
            asm volatile("s_waitcnt vmcnt(0)" ::: "memory");
            const unsigned og = xb_add(&bar[XB_TOP], 1u);
            const unsigned tg = og / nx;
            if (og + 1u == (tg + 1u) * nx) xb_add(&bar[XB_TOPGEN], 1u);
            else XB_SPIN(xb_ld(&bar[XB_TOPGEN]) == tg, bar);
            __builtin_amdgcn_fence(__ATOMIC_ACQUIRE, "agent");
            xb_add(&bar[XB_XGEN(b.x)], 1u);
            asm volatile("s_waitcnt vmcnt(0)" ::: "memory");
        } else {
            XB_SPIN(xb_ld(&bar[XB_XGEN(b.x)]) == gen, bar);
            __builtin_amdgcn_fence(__ATOMIC_ACQUIRE, "agent");
            asm volatile("s_waitcnt vmcnt(0)" ::: "memory");
        }
    }
    __syncthreads();
}
namespace fa {
constexpr int D = 128, LDK = 5632, LDO = 2048;
constexpr bool WSKIP = false; constexpr float THR = 8.f; constexpr float NEPS = 1e-6f;
template <class A, class Bt> struct same_t { static constexpr bool v = false; };
template <class A> struct same_t<A, A> { static constexpr bool v = true; };
constexpr float SCALE = 0.08838834764831845f;
constexpr int NW = 8, QBLK = 32, KVBLK = 64, QB = NW * QBLK;
constexpr int SHM_V = KVBLK * D * 2, SHM_K = KVBLK * D * 2;
constexpr int LDS_BYTES = 2 * SHM_V + 2 * SHM_K + NW * 64 * 4;
using bf16 = __hip_bfloat16;
typedef short bf16x8 __attribute__((ext_vector_type(8)));
typedef short s16x4 __attribute__((ext_vector_type(4)));
typedef float f32x16 __attribute__((ext_vector_type(16)));
typedef float f32x4 __attribute__((ext_vector_type(4)));
typedef unsigned u32x4 __attribute__((ext_vector_type(4)));
#define KSWZ(row, colB) ((row) * 256 + ((colB) ^ (((row) & 7) << 4)))
#define SBAR() __builtin_amdgcn_sched_barrier(0)
__device__ __forceinline__ int v_st(int k, int c) { const int kk = (k & ~0xC) | ((k & 4) << 1) | ((k & 8) >> 1); return ((kk >> 3) * 4 + (c >> 5)) * 512 + ((kk & 7) * 32 + (c & 31)) * 2; }
__device__ __forceinline__ int v_rd_base(int lane) { return ((lane & 3) << 3) | (((lane >> 2) & 3) << 6) | (((lane >> 4) & 1) << 5) | (((lane >> 5) & 1) << 8); }
constexpr int v_rd_off(int d0, int ks, int half) { return d0 * 512 + ks * 4096 + half * 2048; }
__device__ __forceinline__ int crow(int r, int hi) { return (r & 3) + 8 * (r >> 2) + 4 * hi; }
__device__ __forceinline__ unsigned cvtpk(float lo, float hi) {
    unsigned r; asm volatile("v_cvt_pk_bf16_f32 %0, %1, %2" : "=v"(r) : "v"(lo), "v"(hi)); return r;
}
__device__ __forceinline__ bf16x8 pack8(f32x4 a, f32x4 b) {
    u32x4 w = {cvtpk(a[0], a[1]), cvtpk(a[2], a[3]), cvtpk(b[0], b[1]), cvtpk(b[2], b[3])};
    return *reinterpret_cast<bf16x8*>(&w);
}
template <class T> __device__ __forceinline__ bf16x8 load8(const T* p) {
    if constexpr (same_t<T, float>::v) { return pack8(*(const f32x4*)p, *(const f32x4*)(p + 4)); }
    else { return *reinterpret_cast<const bf16x8*>(p); }
}
__device__ __forceinline__ void mask_tile(f32x16& p0, f32x16& p1, int dq, unsigned W) {
    const float NEG = -__builtin_inff();
#pragma unroll
    for (int r = 0; r < 16; ++r) {
        const int c = (r & 3) + 8 * (r >> 2);
        if ((unsigned)(dq - c) >= W) p0[r] = NEG;
        if ((unsigned)(dq - c - 32) >= W) p1[r] = NEG;
    }
}
__device__ __forceinline__ void partialSM(f32x16& p0, f32x16& p1, float& m_reg, float& mn, float& alpha) {
    float pmax = p0[0]; for (int r = 1; r < 16; ++r) pmax = fmaxf(pmax, p0[r]); for (int r = 0; r < 16; ++r) pmax = fmaxf(pmax, p1[r]);
    { auto rr = __builtin_amdgcn_permlane32_swap(__float_as_uint(pmax), __float_as_uint(pmax), false, false);
      pmax = fmaxf(__uint_as_float(rr[0]), __uint_as_float(rr[1])); }
    constexpr float C2 = 1.4426950408889634f * SCALE;
    if (__builtin_expect(__all((pmax - m_reg) * SCALE <= THR), 1)) { mn = m_reg; alpha = 1.f; }
    else { mn = fmaxf(m_reg, pmax); alpha = __builtin_amdgcn_exp2f((m_reg - mn) * C2); m_reg = mn; }
    const float mnL = -mn * C2;
    for (int r = 0; r < 16; ++r) p0[r] = fmaf(p0[r], C2, mnL); for (int r = 0; r < 16; ++r) p1[r] = fmaf(p1[r], C2, mnL);
    for (int r = 0; r < 16; ++r) p0[r] = __builtin_amdgcn_exp2f(p0[r]);
}
__device__ __forceinline__ void finishSM(f32x16& p0, f32x16& p1, float alpha, float& l_reg, bf16x8& pa0, bf16x8& pa1, bf16x8& pa2, bf16x8& pa3) {
    for (int r = 0; r < 16; ++r) p1[r] = __builtin_amdgcn_exp2f(p1[r]);
    float ps = 0; for (int r = 0; r < 16; ++r) ps += p0[r]; for (int r = 0; r < 16; ++r) ps += p1[r];
    { auto rr = __builtin_amdgcn_permlane32_swap(__float_as_uint(ps), __float_as_uint(ps), false, false);
      ps = __uint_as_float(rr[0]) + __uint_as_float(rr[1]); }
    l_reg = l_reg * alpha + ps;
#define PK4(P, B_, OUT) do { unsigned a0 = cvtpk(P[B_+0], P[B_+1]), a1 = cvtpk(P[B_+2], P[B_+3]);                          \
        unsigned b0 = cvtpk(P[B_+4], P[B_+5]), b1 = cvtpk(P[B_+6], P[B_+7]);                                             \
        auto r0 = __builtin_amdgcn_permlane32_swap(a0, b0, false, false); auto r1 = __builtin_amdgcn_permlane32_swap(a1, b1, false, false); \
        u32x4 w = {r0[0], r1[0], r0[1], r1[1]}; OUT = *reinterpret_cast<bf16x8*>(&w); } while (0)
    PK4(p0, 0, pa0); PK4(p0, 8, pa1); PK4(p1, 0, pa2); PK4(p1, 8, pa3);
#undef PK4
}
template <int KB, bool SK>
__device__ __forceinline__ void qkt(f32x16& p0, f32x16& p1, const char* K_lds, int r32, int hi, const bf16x8* qr, bool act) {
    if (SK && !act) { const float NEG = -__builtin_inff();
#pragma unroll
        for (int r = 0; r < 16; ++r) { p0[r] = NEG; p1[r] = NEG; } return; }
    p0 = f32x16{}; p1 = f32x16{};
    const char* kb[4];
#pragma unroll
    for (int dd = 0; dd < 4; ++dd) kb[dd] = K_lds + KB * SHM_K + KSWZ(r32, (dd * 16 + hi * 8) * 2);
#pragma unroll
    for (int d0 = 0; d0 < 8; ++d0) { const char* a = kb[d0 & 3] + (d0 >> 2) * 128;
        bf16x8 b0 = *reinterpret_cast<const bf16x8*>(a);
        bf16x8 b1 = *reinterpret_cast<const bf16x8*>(a + 32 * 256);
        p0 = __builtin_amdgcn_mfma_f32_32x32x16_bf16(b0, qr[d0], p0, 0, 0, 0);
        p1 = __builtin_amdgcn_mfma_f32_32x32x16_bf16(b1, qr[d0], p1, 0, 0, 0); }
}
template <int VB, bool SK>
__device__ __forceinline__ void pv_tile(f32x16* o, int vb0, bf16x8 pa0, bf16x8 pa1, bf16x8 pa2, bf16x8 pa3, bool act) {
    if (SK && !act) return;
#define TRRD(dst, off) asm volatile("ds_read_b64_tr_b16 %0, %1 offset:%2" : "=&v"(dst) : "v"(vb0), "i"(off) : "memory")
#define PV_D0(d0) do { s16x4 l0, l1, l2, l3, h0, h1, h2, h3; constexpr int b_ = VB * SHM_V + v_rd_off(d0, 0, 0);     \
        TRRD(l0, b_); TRRD(h0, b_ + 2048); TRRD(l1, b_ + 4096); TRRD(h1, b_ + 6144); TRRD(l2, b_ + 8192); TRRD(h2, b_ + 10240); TRRD(l3, b_ + 12288); TRRD(h3, b_ + 14336); \
        asm volatile("s_waitcnt lgkmcnt(0)" ::: "memory"); SBAR();                 \
        o[d0] = __builtin_amdgcn_mfma_f32_32x32x16_bf16(pa0, (bf16x8){l0[0], l0[1], l0[2], l0[3], h0[0], h0[1], h0[2], h0[3]}, o[d0], 0, 0, 0);   \
        o[d0] = __builtin_amdgcn_mfma_f32_32x32x16_bf16(pa1, (bf16x8){l1[0], l1[1], l1[2], l1[3], h1[0], h1[1], h1[2], h1[3]}, o[d0], 0, 0, 0);   \
        o[d0] = __builtin_amdgcn_mfma_f32_32x32x16_bf16(pa2, (bf16x8){l2[0], l2[1], l2[2], l2[3], h2[0], h2[1], h2[2], h2[3]}, o[d0], 0, 0, 0);   \
        o[d0] = __builtin_amdgcn_mfma_f32_32x32x16_bf16(pa3, (bf16x8){l3[0], l3[1], l3[2], l3[3], h3[0], h3[1], h3[2], h3[3]}, o[d0], 0, 0, 0); } while (0)
    PV_D0(0); PV_D0(1); PV_D0(2); PV_D0(3);
#undef PV_D0
#undef TRRD
}
template <class TIn, class TOut> struct BlockRef { const TIn* Q; const TIn* K; const TIn* V; TOut* O; const float* G; int P0; };
template <class TIn> struct Seam {
    bf16x8 qr[8];
    bf16x8 st_v0, st_v1, st_k0, st_k1; f32x4 sf0, sf1, sf2, sf3;
    f32x4 tq[16];
};
__device__ __forceinline__ int swa_jlo(int P0, int W) { const int lowk = P0 - W + 1; return lowk > 0 ? lowk / KVBLK : 0; }
#define ROW(p, k0, rr) ((p) + (size_t)((k0) + (rr)) * LDK + sc)
#define VMW() asm volatile("s_waitcnt vmcnt(0)" ::: "memory")
#define VMWN(n) asm volatile("s_waitcnt vmcnt(%0)" :: "i"(n) : "memory")
#define SLOAD_H(Kp, Vp, k0) do { S.st_v0 = load8<TIn>(ROW(Vp, k0, sr)); S.st_v1 = load8<TIn>(ROW(Vp, k0, 32 + sr));              \
                         S.st_k0 = load8<TIn>(ROW(Kp, k0, sr)); S.st_k1 = load8<TIn>(ROW(Kp, k0, 32 + sr)); } while (0)
#define SWRITE_HK(bf) do { *(bf16x8*)(K_lds + (bf) * SHM_K + kws) = S.st_k0; *(bf16x8*)(K_lds + (bf) * SHM_K + kws + 32 * 256) = S.st_k1; } while (0)
#define SWRITE_HV(bf) do { *(bf16x8*)(V_lds + (bf) * SHM_V + vst0) = S.st_v0; *(bf16x8*)(V_lds + (bf) * SHM_V + vst1) = S.st_v1; } while (0)
#define SWRITE_H(bf) do { SWRITE_HV(bf); SWRITE_HK(bf); } while (0)
#define SLOAD_F(p, k0) do { S.sf0 = *(const f32x4*)ROW(p, k0, sr); S.sf1 = *(const f32x4*)(ROW(p, k0, sr) + 4);                \
                            S.sf2 = *(const f32x4*)ROW(p, k0, 32 + sr); S.sf3 = *(const f32x4*)(ROW(p, k0, 32 + sr) + 4); } while (0)
#define SWRITE_KF(bf) do { *(bf16x8*)(K_lds + (bf) * SHM_K + kws) = pack8(S.sf0, S.sf1); *(bf16x8*)(K_lds + (bf) * SHM_K + kws + 32 * 256) = pack8(S.sf2, S.sf3); } while (0)
#define SWRITE_VF(bf) do { *(bf16x8*)(V_lds + (bf) * SHM_V + vst0) = pack8(S.sf0, S.sf1); *(bf16x8*)(V_lds + (bf) * SHM_V + vst1) = pack8(S.sf2, S.sf3); } while (0)
template <class TIn, class TOut>
__device__ __forceinline__ void causal_swa_prime(const BlockRef<TIn, TOut>& cur, int W, char* lds, Seam<TIn>& S) {
    constexpr bool F32 = same_t<TIn, float>::v;
    int tid_ = threadIdx.x; asm volatile("" : "+v"(tid_)); const int tid = tid_, wid = __builtin_amdgcn_readfirstlane(tid >> 6), lane = tid & 63, r32 = lane & 31, hi = lane >> 5;
    const int sr = tid >> 4, sc = (tid & 15) * 8, kws = KSWZ(sr, sc * 2); char* K_lds = lds + 2 * SHM_V;
    const int kb0 = swa_jlo(cur.P0, W) * KVBLK;
    for (int d0 = 0; d0 < 8; ++d0) S.qr[d0] = load8<TIn>(cur.Q + (size_t)(wid * QBLK + r32) * LDK + d0 * 16 + hi * 8);
    if constexpr (F32) { SLOAD_F((const float*)cur.K, kb0); VMW(); SWRITE_KF(0); SBAR(); SLOAD_F((const float*)cur.V, kb0); }
    else { SLOAD_H(cur.K, cur.V, kb0); VMW(); SWRITE_HK(0); }
    __syncthreads();
}
template <class TIn, class TOut>
__device__ __forceinline__ void causal_swa_block(const BlockRef<TIn, TOut>& cur, const BlockRef<TIn, TOut>& nxt, int skv, int W, char* lds, Seam<TIn>& S) {
    constexpr bool F32 = same_t<TIn, float>::v;
    int tid_ = threadIdx.x; asm volatile("" : "+v"(tid_)); const int tid = tid_, wid = __builtin_amdgcn_readfirstlane(tid >> 6), lane = tid & 63, r32 = lane & 31, hi = lane >> 5;
    const int j_lo = swa_jlo(cur.P0, W);
    int j_hi = (cur.P0 + QB - 1) / KVBLK + 1; if (j_hi > skv / KVBLK) j_hi = skv / KVBLK;
    const int NT = j_hi - j_lo;
    const int kbn = swa_jlo(nxt.P0, W) * KVBLK;
    const int qlo = cur.P0 + wid * QBLK, qm = qlo + r32 - 4 * hi;
    char* V_lds = lds; char* K_lds = lds + 2 * SHM_V;
    float* ws = (float*)(lds + 2 * SHM_V + 2 * SHM_K) + wid * 64; float* li_l = ws, * al_l = ws + 32;
    float m_reg = -1e30f, l_reg = 0; f32x16 o[4] = {};
    const int sr = tid >> 4, sc = (tid & 15) * 8, vst0 = v_st(sr, sc), vst1 = v_st(32 + sr, sc), kws = KSWZ(sr, sc * 2);
    const int vb0 = (int)(uintptr_t)V_lds + v_rd_base(lane);
    const TIn* Kh = cur.K; const TIn* Vh = cur.V;
#define RESC(a) do { if (__any((a) < 1.f)) { if (hi == 0) al_l[r32] = (a); asm volatile("s_waitcnt lgkmcnt(0)" ::: "memory");              \
                     for (int d_ = 0; d_ < 4; ++d_) for (int r = 0; r < 16; ++r) o[d_][r] *= al_l[crow(r, hi)]; } } while (0)
#define KBASE(t) ((j_lo + (t)) * KVBLK)
#define ACT(t) (KBASE(t) <= qlo + QBLK - 1 && KBASE(t) + KVBLK - 1 >= qlo - W + 1)
#define MASKT(P0_, P1_, t) do { const int kb_ = KBASE(t); if ((!SK || ACT(t)) && (kb_ + KVBLK - 1 > qlo || kb_ <= qlo + QBLK - 1 - W)) mask_tile(P0_, P1_, qm - kb_, (unsigned)W); } while (0)
    const float* cks = (const float*)(lds + LDS_BYTES); const float cq = cks[qlo + r32];
#define BIAS(P0_, P1_, t) do { const float* ck_ = cks + KBASE(t) + 4 * hi; \
        _Pragma("unroll") for (int g_ = 0; g_ < 4; ++g_) { const f32x4 c0_ = *(const f32x4*)(ck_ + 8 * g_), c1_ = *(const f32x4*)(ck_ + 32 + 8 * g_); \
            _Pragma("unroll") for (int e_ = 0; e_ < 4; ++e_) { P0_[4 * g_ + e_] += cq - c0_[e_]; P1_[4 * g_ + e_] += cq - c1_[e_]; } } } while (0)
    constexpr int NQL = F32 ? 16 : 8;
    constexpr bool SK = WSKIP && !F32;
#define SEAM_K0() do { VMWN(NQL); if constexpr (F32) { SWRITE_KF(0); SBAR(); SLOAD_F((const float*)nxt.V, kbn); } else { SWRITE_HK(0); } SBAR(); } while (0)
    f32x16 pA0, pA1, pB0, pB1; float mnA, mnB, alA, alB; bf16x8 pa0, pa1, pa2, pa3;
    if constexpr (F32) { VMW(); SWRITE_VF(0); SBAR(); } else { SWRITE_HV(0); SBAR(); }
    if (NT > 1) { if constexpr (F32) SLOAD_F((const float*)Kh, KBASE(1)); else SLOAD_H(Kh, Vh, KBASE(1)); }
    SBAR(); qkt<0, SK>(pA0, pA1, K_lds, r32, hi, S.qr, ACT(0));
    if constexpr (F32) { if (NT > 1) { VMW(); SWRITE_KF(1); SBAR(); SLOAD_F((const float*)Vh, KBASE(1)); } }
    BIAS(pA0, pA1, 0); MASKT(pA0, pA1, 0); partialSM(pA0, pA1, m_reg, mnA, alA);
    if (NT > 1) { VMW(); if constexpr (F32) { SWRITE_VF(1); SBAR(); if (NT > 2) SLOAD_F((const float*)Kh, KBASE(2)); } else SWRITE_H(1); }
    __syncthreads();
#define HALF_STEP(PX0, PX1, mnX, alX, PY0, PY1, alY, t, KB, VB, SB) do {                                                      \
        SBAR(); qkt<KB, SK>(PX0, PX1, K_lds, r32, hi, S.qr, ACT(t));                                             \
        finishSM(PY0, PY1, alY, l_reg, pa0, pa1, pa2, pa3); SBAR();                                                           \
        if ((t) + 1 < NT) { if constexpr (F32) { VMW(); SWRITE_KF(SB); SBAR(); SLOAD_F((const float*)Vh, KBASE((t) + 1)); }  \
                            else { SLOAD_H(Kh, Vh, KBASE((t) + 1)); } SBAR(); }                                               \
        pv_tile<VB, SK>(o, vb0, pa0, pa1, pa2, pa3, ACT((t) - 1)); BIAS(PX0, PX1, (t)); MASKT(PX0, PX1, (t)); partialSM(PX0, PX1, m_reg, mnX, alX);                                        \
        __syncthreads();                                                                                                      \
        if ((t) + 1 < NT) { VMW(); if constexpr (F32) { SWRITE_VF(SB); SBAR(); if ((t) + 2 < NT) SLOAD_F((const float*)Kh, KBASE((t) + 2)); } \
                            else { SWRITE_H(SB); } }                                                                          \
        RESC(alX); __syncthreads(); } while (0)
    for (int t = 1; t + 1 < NT; t += 2) {
        HALF_STEP(pB0, pB1, mnB, alB, pA0, pA1, alA, t, 1, 0, 0);
        HALF_STEP(pA0, pA1, mnA, alA, pB0, pB1, alB, t + 1, 0, 1, 1);
    }
    const bool even = (NT & 1) == 0;
    if (even) { SBAR(); qkt<1, SK>(pB0, pB1, K_lds, r32, hi, S.qr, ACT(NT - 1)); SBAR(); }
#define QROW(e) (nxt.Q + (size_t)(wid * QBLK + r32) * LDK + ((e) >> 1) * 16 + hi * 8 + ((e) & 1) * 4)
    if constexpr (F32) { SLOAD_F((const float*)nxt.K, kbn); SBAR();
#pragma unroll
        for (int e = 0; e < 8; ++e) S.tq[e] = *(const f32x4*)QROW(e); }
    else { SLOAD_H(nxt.K, nxt.V, kbn); SBAR();
#pragma unroll
        for (int d0 = 0; d0 < 8; ++d0) S.qr[d0] = load8<TIn>(nxt.Q + (size_t)(wid * QBLK + r32) * LDK + d0 * 16 + hi * 8); }
    SBAR();
    finishSM(pA0, pA1, alA, l_reg, pa0, pa1, pa2, pa3); SBAR();
    if constexpr (F32) {
#pragma unroll
        for (int e = 8; e < 16; ++e) S.tq[e] = *(const f32x4*)QROW(e); SBAR(); }
#undef QROW
    pv_tile<0, SK>(o, vb0, pa0, pa1, pa2, pa3, ACT(even ? NT - 2 : NT - 1));
    if (even) { BIAS(pB0, pB1, NT - 1); MASKT(pB0, pB1, NT - 1); partialSM(pB0, pB1, m_reg, mnB, alB); __syncthreads(); RESC(alB);
        finishSM(pB0, pB1, alB, l_reg, pa0, pa1, pa2, pa3); SBAR(); pv_tile<1, SK>(o, vb0, pa0, pa1, pa2, pa3, ACT(NT - 1)); }
    SBAR(); SEAM_K0();
    if (hi == 0) li_l[r32] = l_reg; asm volatile("s_waitcnt lgkmcnt(0)" ::: "memory");
    float rli[16];
#pragma unroll
    for (int r = 0; r < 16; ++r) rli[r] = __builtin_amdgcn_rcpf(li_l[crow(r, hi)]);
    TOut* Ow = cur.O + (size_t)(wid * QBLK) * LDO;
    const float gw0 = cur.G[r32], gw1 = cur.G[32 + r32], gw2 = cur.G[64 + r32], gw3 = cur.G[96 + r32];
#pragma unroll
    for (int r = 0; r < 16; ++r) { const int orow = crow(r, hi);
        float v0 = o[0][r] * rli[r], v1 = o[1][r] * rli[r], v2 = o[2][r] * rli[r], v3 = o[3][r] * rli[r];
        float ss = (v0 * v0 + v1 * v1) + (v2 * v2 + v3 * v3);
        ss += __shfl_xor(ss, 1); ss += __shfl_xor(ss, 2); ss += __shfl_xor(ss, 4); ss += __shfl_xor(ss, 8); ss += __shfl_xor(ss, 16);
        const float rn = 1.0f / sqrtf(ss * (1.0f / 128.0f) + NEPS);
        v0 *= rn * gw0; v1 *= rn * gw1; v2 *= rn * gw2; v3 *= rn * gw3;
        const float n0 = __shfl_xor(v0, 1), n1 = __shfl_xor(v1, 1), n2 = __shfl_xor(v2, 1), n3 = __shfl_xor(v3, 1);
        if ((r32 & 1) == 0) { TOut* op = Ow + (size_t)orow * LDO + r32;
            *(unsigned*)(op) = cvtpk(v0, n0); *(unsigned*)(op + 32) = cvtpk(v1, n1); *(unsigned*)(op + 64) = cvtpk(v2, n2); *(unsigned*)(op + 96) = cvtpk(v3, n3); } }
    if constexpr (F32) {
#pragma unroll
        for (int d0 = 0; d0 < 8; ++d0) S.qr[d0] = pack8(S.tq[2 * d0], S.tq[2 * d0 + 1]); }
    __syncthreads();
#undef RESC
#undef KBASE
#undef ACT
#undef MASKT
#undef BIAS
#undef SEAM_K0
#undef HALF_STEP
}
#undef ROW
#undef VMW
#undef VMWN
#undef SLOAD_H
#undef SWRITE_HK
#undef SWRITE_HV
#undef SWRITE_H
#undef SLOAD_F
#undef SWRITE_KF
#undef SWRITE_VF

#undef KSWZ
#undef SBAR
}

typedef unsigned u32x2 __attribute__((ext_vector_type(2)));
struct Frame {
    LAS unsigned char* lds;
    volatile LAS unsigned* MISC;
    unsigned char* ws;
    float* X;
    int vcu, G;
};
static_assert(19 * 8 <= 320, "pointer table fits below MISC");
enum { I_x, I_c, I_norm_pre, I_norm_post, I_w_mod, I_b_mod, I_w_gate, I_w_up, I_w_down, I_w_in, I_conv_w, I_conv_b, I_dt_bias, I_a_log, I_d_skip, I_ssm_norm, I_f_bias, I_attn_norm, I_w_out, I_N };
__device__ __forceinline__ const float* inp(const Frame& F, int k) {
    const LAS unsigned* t = (const LAS unsigned*)(F.lds + LDSCTL_OFF) + 2 * k;
    const unsigned lo = __builtin_amdgcn_readfirstlane(t[0]), hi = __builtin_amdgcn_readfirstlane(t[1]);
    return (const float*)(const GAS float*)(((unsigned long long)hi << 32) | lo);
}
template <class T> __device__ __forceinline__ T* wsp(const Frame& F, size_t off) { GAS unsigned char* p = (GAS unsigned char*)F.ws; asm volatile("" : "+s"(p)); return (T*)(GAS T*)(p + off); }

__device__ __forceinline__ float bf2f(unsigned short u) { return __uint_as_float((unsigned)u << 16); }
__device__ __forceinline__ float bflo(unsigned w) { return __uint_as_float(w << 16); }
__device__ __forceinline__ float bfhi(unsigned w) { return __uint_as_float(w & 0xffff0000u); }
__device__ __forceinline__ float wave_sum(float v) {
#pragma unroll
    for (int o = 1; o < 64; o <<= 1) v += __shfl_xor(v, o);
    return v;
}
__device__ __forceinline__ float wave_max(float v) {
#pragma unroll
    for (int o = 1; o < 64; o <<= 1) v = fmaxf(v, __shfl_xor(v, o));
    return v;
}
__device__ __forceinline__ float softplus_f(float x) { return fmaxf(x, 0.f) + log1pf(__expf(-fabsf(x))); }
__device__ __forceinline__ float silu_f(float g) { return g * __builtin_amdgcn_rcpf(1.0f + __expf(-g)); }
__device__ __forceinline__ unsigned pkb(float lo, float hi) { return pg8::pk_bf16(lo, hi); }
__device__ __forceinline__ float rl(float v, int l) { return __int_as_float(__builtin_amdgcn_readlane(__float_as_int(v), l)); }
__device__ __forceinline__ int fresh_tid() { int t = threadIdx.x; asm volatile("" : "+v"(t)); return t; }
#define PHASE_IDS const int tid = fresh_tid(), lane = tid & 63, wave = __builtin_amdgcn_readfirstlane(tid >> 6); (void)tid; (void)lane; (void)wave
#define MFMA16(a, b, c) __builtin_amdgcn_mfma_f32_16x16x32_bf16((a), (b), (c), 0, 0, 0)

struct CvItem { const float* src; bf16* dst; int N, K; };
constexpr int CV_IFF = (DM / 64) * (DFF / 64);
constexpr int CV_IOUT = (DM / 64) * (DM / 64);
constexpr int CV_ITEMS = 7 * CV_IFF + CV_IOUT;
__device__ __forceinline__ CvItem cv_decode(Frame& F, int L, int j) {
    CvItem d;
    if (j < 4 * CV_IFF) {
        const int up = j >= 2 * CV_IFF ? 1 : 0, r0 = j - up * 2 * CV_IFF, lf = 2 * L + r0 / CV_IFF, r = r0 % CV_IFF, kb = r / 88, nb = r % 88;
        d.N = DFF; d.K = DM; d.src = (up ? inp(F, I_w_up) : inp(F, I_w_gate)) + (size_t)lf * DM * DFF + (size_t)(64 * kb) * DFF + 64 * nb;
        d.dst = wsp<bf16>(F, WS_WGU) + (size_t)lf * NGU * DM + (size_t)((nb >> 1) * 256 + (nb & 1) * 64 + up * 128) * DM + 64 * kb;
    } else if (j < 6 * CV_IFF) {
        const int r0 = j - 4 * CV_IFF, lf = 2 * L + r0 / CV_IFF, r = r0 % CV_IFF, kb = r / 32, nb = r % 32;
        d.N = DM; d.K = DFF; d.src = inp(F, I_w_down) + (size_t)lf * DFF * DM + (size_t)(64 * kb) * DM + 64 * nb;
        d.dst = wsp<bf16>(F, WS_WDN) + (size_t)lf * DM * DFF + (size_t)(64 * nb) * DFF + 64 * kb;
    } else if (j < 7 * CV_IFF) {
        const int r = j - 6 * CV_IFF, kb = r / 88, nb = r % 88;
        d.N = DIN; d.K = DM; d.src = inp(F, I_w_in) + (size_t)L * DM * DIN + (size_t)(64 * kb) * DIN + 64 * nb + (64 * nb >= 2560 ? 16 : 0);
        d.dst = wsp<bf16>(F, WS_WIN) + (size_t)L * DINP * DM + (size_t)(64 * nb) * DM + 64 * kb;
    } else {
        const int r = j - 7 * CV_IFF, kb = r / 32, nb = r % 32;
        d.N = DM; d.K = DM; d.src = inp(F, I_w_out) + (size_t)L * DM * DM + (size_t)(64 * kb) * DM + 64 * nb;
        d.dst = wsp<bf16>(F, WS_WOUT) + (size_t)L * DM * DM + (size_t)(64 * nb) * DM + 64 * kb;
    }
    return d;
}
__device__ __forceinline__ void cv_load(const CvItem& d, f32x4 (&a)[8], f32x4 (&b)[8], int lane) {
    const int r = lane >> 4, q = lane & 15;
#pragma unroll
    for (int i = 0; i < 8; ++i) { const int kp = 4 * i + r; const float* p = d.src + (size_t)(2 * kp) * d.N + 4 * q; a[i] = *(const f32x4*)p; b[i] = *(const f32x4*)(p + d.N); }
}
__device__ __forceinline__ void cv_store(const CvItem& d, const f32x4 (&a)[8], const f32x4 (&b)[8], LAS unsigned* T, int lane) {
    const int r = lane >> 4, q = lane & 15;
#pragma unroll
    for (int i = 0; i < 8; ++i) { const int kp = 4 * i + r; LAS unsigned* t = T + kp * 65 + 4 * q;
        t[0] = pkb(a[i][0], b[i][0]); t[1] = pkb(a[i][1], b[i][1]); t[2] = pkb(a[i][2], b[i][2]); t[3] = pkb(a[i][3], b[i][3]); }
    LDS_WAIT(); asm volatile("" ::: "memory");
    const int c = lane & 7;
#pragma unroll
    for (int i = 0; i < 8; ++i) { const int n = 8 * i + (lane >> 3); const LAS unsigned* t = T + (4 * c) * 65 + n;
        v4u o; o.x = t[0]; o.y = t[65]; o.z = t[130]; o.w = t[195];
        *(v4u*)(d.dst + (size_t)n * d.K + 8 * c) = o; }
    LDS_WAIT(); asm volatile("" ::: "memory");
}
__device__ __forceinline__ void convert_range(Frame& F, int L, int jbeg, int jend, int q, int nq, LAS unsigned* T, int lane) {
    if (jbeg + q < jend) {
        f32x4 a0[8], b0[8], a1[8], b1[8];
        int j = jbeg + q; CvItem d0 = cv_decode(F, L, j), d1 = d0; cv_load(d0, a0, b0, lane);
        for (;;) {
            const int j1 = j + nq; const bool h1 = j1 < jend;
            if (h1) { d1 = cv_decode(F, L, j1); cv_load(d1, a1, b1, lane); }
            cv_store(d0, a0, b0, T, lane);
            if (!h1) break;
            j = j1 + nq; const bool h0 = j < jend;
            if (h0) { d0 = cv_decode(F, L, j); cv_load(d0, a0, b0, lane); }
            cv_store(d1, a1, b1, T, lane);
            if (!h0) break;
        }
    }
}
__device__ __forceinline__ void convert_tail(Frame& F, int L, int tq, int ntq) {
    for (int i = tq; i < 256 * 256; i += ntq) {
        const int kc = i & 255, j = i >> 8;
        const int src = j < 16 ? 2560 + j : (j < 24 ? 5648 + (j - 16) : -1);
        v4u o = {0u, 0u, 0u, 0u};
        if (src >= 0) { const float* p = inp(F, I_w_in) + (size_t)L * DM * DIN + (size_t)(8 * kc) * DIN + src;
            o.x = pkb(p[0], p[DIN]); o.y = pkb(p[2 * DIN], p[3 * DIN]); o.z = pkb(p[4 * DIN], p[5 * DIN]); o.w = pkb(p[6 * DIN], p[7 * DIN]); }
        *(v4u*)(wsp<bf16>(F, WS_WIN) + (size_t)L * DINP * DM + (size_t)(DINB + j) * DM + 8 * kc) = o;
    }
}
constexpr int CV_G1 = 5800, CV_B0 = 2 * CV_G1, CV_BGRP = 286;
__device__ __forceinline__ void p0_prologue(Frame& F) {
    PHASE_IDS;
    const int gw = F.vcu * NWAVES + wave, NGW = F.G * NWAVES;
    {
        LAS unsigned* T = (LAS unsigned*)(F.lds) + wave * (32 * 65);
        const int nl = (F.G == 256) ? 1 : DEPTH;
        for (int L = 0; L < nl; ++L) { convert_range(F, L, 0, CV_ITEMS, gw, NGW, T, lane); convert_tail(F, L, blockIdx.x * NTHR + tid, F.G * NTHR); }
    }
    {
        LAS float* cact = (LAS float*)(F.lds + 81920);
        for (int i = tid; i < NB * DM; i += NTHR) cact[i] = silu_f(inp(F, I_c)[i]);
        __syncthreads();
        const int gtid = blockIdx.x * NTHR + tid, NT = F.G * NTHR;
        constexpr int J4 = MODW / 4, KS = 7, KC = 296;
        for (int i = gtid; i < DEPTH * KS * J4; i += NT) {
            const int j4 = i % J4, ks = (i / J4) % KS, l = i / (J4 * KS);
            const int KL = (ks == KS - 1) ? DM - (KS - 1) * KC : KC;
            const float* wp = inp(F, I_w_mod) + ((size_t)l * DM + ks * KC) * MODW + 4 * j4;
            const LAS float* cp = cact + ks * KC;
            f32x4 acc[NB];
#pragma unroll
            for (int b = 0; b < NB; ++b) acc[b] = (f32x4){0.f, 0.f, 0.f, 0.f};
            for (int k = 0; k < KL; k += 8) {
                f32x4 w[8];
#pragma unroll
                for (int u = 0; u < 8; ++u) w[u] = *(const f32x4*)(wp + (size_t)(k + u) * MODW);
#pragma unroll
                for (int u = 0; u < 8; ++u)
#pragma unroll
                    for (int b = 0; b < NB; ++b) acc[b] += cp[b * DM + k + u] * w[u];
            }
#pragma unroll
            for (int b = 0; b < NB; ++b) *(f32x4*)(wsp<float>(F, WS_PART) + ((size_t)(ks * DEPTH + l) * NB + b) * MODW + 4 * j4) = acc[b];
        }
        __syncthreads();
    }
}

__device__ __forceinline__ void mod_reduce_phase(Frame& F) {
    PHASE_IDS;
    const int gtid = blockIdx.x * NTHR + tid, NT = F.G * NTHR;
    for (int i = gtid; i < DEPTH * NB * 3 * (DM / 4); i += NT) {
        const int c4 = i % (DM / 4), sub = (i / (DM / 4)) % 3, lb = i / (3 * DM / 4), l = lb / NB, b = lb % NB, k = 3 * l + sub;
        f32x4 m[3];
#pragma unroll
        for (int q = 0; q < 3; ++q) { const int col = (3 * sub + q) * DM + 4 * c4; f32x4 a = *(const f32x4*)(inp(F, I_b_mod) + (size_t)l * MODW + col);
#pragma unroll
            for (int ks = 0; ks < 7; ++ks) a += *(const f32x4*)(wsp<float>(F, WS_PART) + ((size_t)ks * DEPTH * NB + lb) * MODW + col);
            m[q] = a; }
        const f32x4 npre = *(const f32x4*)(inp(F, I_norm_pre) + (size_t)k * DM + 4 * c4), npost = *(const f32x4*)(inp(F, I_norm_post) + (size_t)k * DM + 4 * c4);
        float* mc = wsp<float>(F, WS_MOD);
        *(f32x4*)(mc + ((size_t)(k * NB + b) * 3 + 1) * DM + 4 * c4) = npre * (m[1] + 1.0f);
        *(f32x4*)(mc + ((size_t)(k * NB + b) * 3 + 2) * DM + 4 * c4) = m[0];
        *(f32x4*)(mc + ((size_t)((k + 1) * NB + b) * 3 + 0) * DM + 4 * c4) = (m[2] * (sub == 1 ? 1.0f : 0.5f)) * npost;
    }
}

template <bool FIRST, bool LAST, int NR>
__device__ __forceinline__ void thin_phase(Frame& F, int k) {
    PHASE_IDS;
    const int gw = F.vcu * NWAVES + wave, NGW = F.G * NWAVES;
    for (int rq = gw; rq < M / NR; rq += NGW) {
        const int row0 = NR * rq, b = row0 / SEQ;
        u32x2 xb[NR][8], yv[FIRST ? 1 : NR][8]; float ssx[NR], r[NR];
        if constexpr (FIRST) {
            f32x4 xf[NR][8];
#pragma unroll
            for (int t = 0; t < NR; ++t) { const f32x4* xr = (const f32x4*)(inp(F, I_x) + (size_t)(row0 + t) * DM) + lane;
#pragma unroll
                for (int j = 0; j < 8; ++j) xf[t][j] = xr[64 * j]; }
#pragma unroll
            for (int t = 0; t < NR; ++t) { ssx[t] = 0.f; u32x2* xo = (u32x2*)(wsp<bf16>(F, WS_XB) + (size_t)(row0 + t) * DM) + lane;
#pragma unroll
                for (int j = 0; j < 8; ++j) { u32x2 w; w.x = pkb(xf[t][j][0], xf[t][j][1]); w.y = pkb(xf[t][j][2], xf[t][j][3]); xb[t][j] = w; xo[64 * j] = w;
                    const float a0 = bflo(w.x), a1 = bfhi(w.x), a2 = bflo(w.y), a3 = bfhi(w.y); ssx[t] += (a0 * a0 + a1 * a1) + (a2 * a2 + a3 * a3); } }
        } else {
#pragma unroll
            for (int t = 0; t < NR; ++t) { const u32x2* xr = (const u32x2*)(wsp<bf16>(F, WS_XB) + (size_t)(row0 + t) * DM) + lane; const u32x2* yr = (const u32x2*)(wsp<bf16>(F, WS_Y) + (size_t)(row0 + t) * DM) + lane;
#pragma unroll
                for (int j = 0; j < 8; ++j) { xb[t][j] = xr[64 * j]; yv[t][j] = yr[64 * j]; } }
            asm volatile("" ::: "memory");
#pragma unroll
            for (int t = 0; t < NR; ++t) { float ss = 0.f;
#pragma unroll
                for (int j = 0; j < 8; ++j) { const float a0 = bflo(yv[t][j].x), a1 = bfhi(yv[t][j].x), a2 = bflo(yv[t][j].y), a3 = bfhi(yv[t][j].y); ss += (a0 * a0 + a1 * a1) + (a2 * a2 + a3 * a3); }
                r[t] = 1.0f / sqrtf(wave_sum(ss) * (1.0f / DM) + EPS); ssx[t] = 0.f; }
            const f32x4* gp = (const f32x4*)(wsp<float>(F, WS_MOD) + ((size_t)(k * NB + b) * 3 + 0) * DM) + lane;
#pragma unroll
            for (int j = 0; j < 8; ++j) {
                const f32x4 gv = gp[64 * j];
#pragma unroll
                for (int t = 0; t < NR; ++t) {
                    const f32x4 xo4 = (f32x4){bflo(xb[t][j].x), bfhi(xb[t][j].x), bflo(xb[t][j].y), bfhi(xb[t][j].y)};
                    const f32x4 yf = (f32x4){bflo(yv[t][j].x), bfhi(yv[t][j].x), bflo(yv[t][j].y), bfhi(yv[t][j].y)};
                    const f32x4 xn = xo4 + gv * (yf * r[t]);
                    if constexpr (LAST) { ((f32x4*)(F.X + (size_t)(row0 + t) * DM) + lane)[64 * j] = xn; }
                    else { u32x2 w; w.x = pkb(xn[0], xn[1]); w.y = pkb(xn[2], xn[3]); xb[t][j] = w; ((u32x2*)(wsp<bf16>(F, WS_XB) + (size_t)(row0 + t) * DM) + lane)[64 * j] = w;
                        const float a0 = bflo(w.x), a1 = bfhi(w.x), a2 = bflo(w.y), a3 = bfhi(w.y); ssx[t] += (a0 * a0 + a1 * a1) + (a2 * a2 + a3 * a3); }
                }
                asm volatile("" ::: "memory");
            }
        }
        if constexpr (!LAST) {
#pragma unroll
            for (int t = 0; t < NR; ++t) r[t] = 1.0f / sqrtf(wave_sum(ssx[t]) * (1.0f / DM) + EPS);
            const f32x4* bp = (const f32x4*)(wsp<float>(F, WS_MOD) + ((size_t)(k * NB + b) * 3 + 1) * DM) + lane; const f32x4* cp = bp + DM / 4;
#pragma unroll
            for (int j = 0; j < 8; ++j) {
                const f32x4 bv = bp[64 * j], cv = cp[64 * j];
#pragma unroll
                for (int t = 0; t < NR; ++t) {
                    const f32x4 xn = (f32x4){bflo(xb[t][j].x), bfhi(xb[t][j].x), bflo(xb[t][j].y), bfhi(xb[t][j].y)};
                    const f32x4 hv = (xn * r[t]) * bv + cv;
                    u32x2 w; w.x = pkb(hv[0], hv[1]); w.y = pkb(hv[2], hv[3]); ((u32x2*)(wsp<bf16>(F, WS_HB) + (size_t)(row0 + t) * DM) + lane)[64 * j] = w;
                }
                asm volatile("" ::: "memory");
            }
        }
        asm volatile("" ::: "memory");
    }
}

__device__ __forceinline__ void ssd_states_phase(Frame& F, int l) {
    PHASE_IDS;
    LAS bf16* BT = (LAS bf16*)F.lds;
    LAS bf16* XsTb = (LAS bf16*)(F.lds + 128 * 72 * 2);
    LAS float* WL = (LAS float*)(F.lds + 128 * 72 * 2 + 8 * 64 * 72 * 2);
    const int fr = lane & 15, fq = lane >> 4;
    for (int unit = blockIdx.x; unit < NB * NCH * SG; unit += F.G) {
        const int g = unit & 1, c = (unit >> 1) & 31, b = unit >> 6, t0 = b * SEQ + c * CHUNK, h = g * HPG + wave;
        {
            const float a = -__expf(inp(F, I_a_log)[l * SH + h]), bias = inp(F, I_dt_bias)[l * SH + h];
            const float dt = softplus_f(wsp<float>(F, WS_DTF)[(size_t)(t0 + lane) * 32 + h] + bias);
            float inc = dt * a;
#pragma unroll
            for (int o = 1; o < 64; o <<= 1) { const float t = __shfl_up(inc, o); if (lane >= o) inc += t; }
            wsp<float>(F, WS_DT)[(t0 + lane) * 16 + h] = dt; wsp<float>(F, WS_ACS)[(t0 + lane) * 16 + h] = inc;
            WL[wave * 64 + lane] = dt * __expf(__shfl(inc, 63) - inc);
        }
        __syncthreads();
        if (tid < 384) {
            const int cc = tid % 96, seg = tid / 96;
            const int col = cc < 64 ? 512 * g + 8 * cc : (cc < 80 ? 1024 + 128 * g + 8 * (cc - 64) : 1280 + 128 * g + 8 * (cc - 80));
            float w[4][8], bs[8];
#pragma unroll
            for (int k = 0; k < 4; ++k) { const float* wp = inp(F, I_conv_w) + (size_t)(l * 4 + k) * CONVD + col; const f32x4 a0 = *(const f32x4*)wp, a1 = *(const f32x4*)(wp + 4);
                w[k][0] = a0[0]; w[k][1] = a0[1]; w[k][2] = a0[2]; w[k][3] = a0[3]; w[k][4] = a1[0]; w[k][5] = a1[1]; w[k][6] = a1[2]; w[k][7] = a1[3]; }
            { const float* bp = inp(F, I_conv_b) + l * CONVD + col; const f32x4 a0 = *(const f32x4*)bp, a1 = *(const f32x4*)(bp + 4);
              bs[0] = a0[0]; bs[1] = a0[1]; bs[2] = a0[2]; bs[3] = a0[3]; bs[4] = a1[0]; bs[5] = a1[1]; bs[6] = a1[2]; bs[7] = a1[3]; }
            const int lr0 = 16 * seg, tq0 = c * CHUNK + lr0;
            const bf16* src = wsp<bf16>(F, WS_ACT) + (size_t)(t0 + lr0) * DINB + PC_X + col;
            v4u win[19];
#pragma unroll
            for (int r = 0; r < 19; ++r) win[r] = (tq0 + r - 3 >= 0) ? *(const v4u*)(src + (long)(r - 3) * DINB) : (v4u){0u, 0u, 0u, 0u};
            bf16* dst = wsp<bf16>(F, WS_XBC) + (size_t)(t0 + lr0) * CONVD + col;
#pragma unroll
            for (int r = 0; r < 16; ++r) {
                float acc[8];
#pragma unroll
                for (int e = 0; e < 8; ++e) acc[e] = bs[e];
#pragma unroll
                for (int k = 0; k < 4; ++k) { const v4u u = win[r + k];
                    acc[0] += w[k][0] * bflo(u.x); acc[1] += w[k][1] * bfhi(u.x); acc[2] += w[k][2] * bflo(u.y); acc[3] += w[k][3] * bfhi(u.y);
                    acc[4] += w[k][4] * bflo(u.z); acc[5] += w[k][5] * bfhi(u.z); acc[6] += w[k][6] * bflo(u.w); acc[7] += w[k][7] * bfhi(u.w); }
#pragma unroll
                for (int e = 0; e < 8; ++e) acc[e] = silu_f(acc[e]);
                v4u o; o.x = pkb(acc[0], acc[1]); o.y = pkb(acc[2], acc[3]); o.z = pkb(acc[4], acc[5]); o.w = pkb(acc[6], acc[7]);
                *(v4u*)(dst + (size_t)r * CONVD) = o;
                const int lrow = lr0 + r;
                if (cc < 64) {
                    const float sc_ = WL[(cc >> 3) * 64 + lrow]; LAS bf16* d = XsTb + (cc >> 3) * (64 * 72) + (8 * (cc & 7)) * 72 + lrow;
                    const unsigned w0 = pkb(acc[0] * sc_, acc[1] * sc_), w1 = pkb(acc[2] * sc_, acc[3] * sc_), w2 = pkb(acc[4] * sc_, acc[5] * sc_), w3 = pkb(acc[6] * sc_, acc[7] * sc_);
                    d[0] = (bf16)w0; d[72] = (bf16)(w0 >> 16); d[144] = (bf16)w1; d[216] = (bf16)(w1 >> 16); d[288] = (bf16)w2; d[360] = (bf16)(w2 >> 16); d[432] = (bf16)w3; d[504] = (bf16)(w3 >> 16);
                } else if (cc < 80) {
                    LAS bf16* d = BT + (8 * (cc - 64)) * 72 + lrow;
                    d[0] = (bf16)o.x; d[72] = (bf16)(o.x >> 16); d[144] = (bf16)o.y; d[216] = (bf16)(o.y >> 16); d[288] = (bf16)o.z; d[360] = (bf16)(o.z >> 16); d[432] = (bf16)o.w; d[504] = (bf16)(o.w >> 16);
                }
            }
        }
        __syncthreads();
        const LAS bf16* XsT = XsTb + wave * (64 * 72);
        bf16* stp = wsp<bf16>(F, WS_ST) + (size_t)((b * NCH + c) * SH + h) * (SP * SN);
#pragma unroll
        for (int nh = 0; nh < 2; ++nh) {
            f32x4 acc[4][4];
#pragma unroll
            for (int i = 0; i < 4; ++i)
#pragma unroll
                for (int j = 0; j < 4; ++j) acc[i][j] = (f32x4){0.f, 0.f, 0.f, 0.f};
#pragma unroll
            for (int ks = 0; ks < 2; ++ks) {
                bf16x8 xa[4], yb[4];
#pragma unroll
                for (int nt = 0; nt < 4; ++nt) xa[nt] = *(const LAS bf16x8*)(BT + (64 * nh + 16 * nt + fr) * 72 + 32 * ks + 8 * fq);
#pragma unroll
                for (int pt = 0; pt < 4; ++pt) yb[pt] = *(const LAS bf16x8*)(XsT + (16 * pt + fr) * 72 + 32 * ks + 8 * fq);
#pragma unroll
                for (int nt = 0; nt < 4; ++nt)
#pragma unroll
                    for (int pt = 0; pt < 4; ++pt) acc[nt][pt] = MFMA16(xa[nt], yb[pt], acc[nt][pt]);
            }
#pragma unroll
            for (int nt = 0; nt < 4; ++nt)
#pragma unroll
                for (int pt = 0; pt < 4; ++pt) { u32x2 wv; wv.x = pkb(acc[nt][pt][0], acc[nt][pt][1]); wv.y = pkb(acc[nt][pt][2], acc[nt][pt][3]);
                    *(u32x2*)(stp + (16 * pt + fr) * SN + 64 * nh + 16 * nt + 4 * fq) = wv; }
        }
        __syncthreads();
    }
}

__device__ __forceinline__ void scan_block(Frame& F, int sb, int tid) {
    const int i = sb * NTHR + tid, e4 = i & 2047, h = (i >> 11) & 15, b = i >> 15;
    u32x2* p0 = (u32x2*)(wsp<bf16>(F, WS_ST) + (size_t)(b * NCH * SH + h) * (SP * SN)) + e4;
    const float* ap = wsp<float>(F, WS_ACS) + (size_t)(b * SEQ + 63) * 16 + h;
    u32x2 st[NCH]; float dec[NCH];
#pragma unroll
    for (int c = 0; c < NCH; ++c) { st[c] = p0[(size_t)c * (SH * SP * SN / 4)]; dec[c] = ap[c * CHUNK * 16]; }
    f32x4 hs = (f32x4){0.f, 0.f, 0.f, 0.f};
#pragma unroll
    for (int c = 0; c < NCH; ++c) {
        u32x2 w; w.x = pkb(hs[0], hs[1]); w.y = pkb(hs[2], hs[3]); p0[(size_t)c * (SH * SP * SN / 4)] = w;
        const float d = __expf(dec[c]);
        hs = hs * d + (f32x4){bflo(st[c].x), bfhi(st[c].x), bflo(st[c].y), bfhi(st[c].y)};
    }
}
static_assert(fa::LDK == DINB && fa::LDO == DM && fa::D == AHD && fa::LDS_BYTES + SEQ * 4 + 64 <= RING_BYTES, "attention body geometry");
__device__ __forceinline__ void attn_block(Frame& F, int l, char* lds, int bh, int qb, int tid) {
    const int lane = tid & 63, wave = __builtin_amdgcn_readfirstlane(tid >> 6), b = bh / AH, h = bh % AH;
    float* cks = (float*)(lds + fa::LDS_BYTES); float* wtot = cks + SEQ;
    constexpr int W = 1 << 24;
    const int n = qb * 256 + 256;
    {   const float fb = inp(F, I_f_bias)[l * AH + h]; const float* fr_ = wsp<float>(F, WS_DTF) + (size_t)(b * SEQ) * 32 + 16 + h;
        float v[4]; float run = 0.f;
#pragma unroll
        for (int e = 0; e < 4; ++e) { const int t = 4 * tid + e; const float xx = (t < n) ? fr_[(size_t)t * 32] + fb : 0.f; run += (t < n) ? -softplus_f(-xx) : 0.f; v[e] = run; }
        float inc = run;
#pragma unroll
        for (int o = 1; o < 64; o <<= 1) { const float t = __shfl_up(inc, o); if (lane >= o) inc += t; }
        if (lane == 63) wtot[wave] = inc;
        __syncthreads();
        float pre = inc - run;
#pragma unroll
        for (int w2 = 0; w2 < 8; ++w2) pre += (w2 < wave) ? wtot[w2] : 0.f;
        if (4 * tid < n) *(f32x4*)(cks + 4 * tid) = (f32x4){(pre + v[0]) * 11.313708498984761f, (pre + v[1]) * 11.313708498984761f, (pre + v[2]) * 11.313708498984761f, (pre + v[3]) * 11.313708498984761f};
    }
    fa::BlockRef<fa::bf16, fa::bf16> cur;
    const bf16* proj = wsp<bf16>(F, WS_ACT);
    cur.Q = (const fa::bf16*)(proj + (size_t)(b * SEQ + qb * 256) * DINB + PC_Q + h * AHD);
    cur.K = (const fa::bf16*)(proj + (size_t)(b * SEQ) * DINB + PC_K + h * AHD);
    cur.V = (const fa::bf16*)(proj + (size_t)(b * SEQ) * DINB + PC_V + h * AHD);
    cur.O = (fa::bf16*)(wsp<bf16>(F, WS_YCAT) + (size_t)(b * SEQ + qb * 256) * DM + DSSM + h * AHD);
    cur.G = inp(F, I_attn_norm) + l * DATT + h * AHD; cur.P0 = qb * 256;
    fa::Seam<fa::bf16> S;
    fa::causal_swa_prime<fa::bf16, fa::bf16>(cur, W, lds, S);
    fa::causal_swa_block<fa::bf16, fa::bf16>(cur, cur, SEQ, W, lds, S);
}
__device__ __forceinline__ void attn_scan_phase(Frame& F, int l, char* lds) {
    PHASE_IDS;
    if (F.G == 256) {
        const int c = blockIdx.x, xcd = c & 7, slot = c >> 3, qb = slot & 7, grp = xcd + 8 * (slot >> 3);
        const int nscan = qb < 2 ? 2 : (qb < 6 ? 1 : 0), first = qb < 2 ? 2 * qb : qb + 2;
        for (int k = 0; k < nscan; ++k) scan_block(F, grp * 8 + first + k, tid);
        attn_block(F, l, lds, grp, qb, tid);
        if (l + 1 < DEPTH) {
            const int off0 = qb == 0 ? 0 : qb == 1 ? 62 : qb == 2 ? 114 : qb == 3 ? 165 : qb == 4 ? 205 : qb == 5 ? 235 : qb == 6 ? 256 : 276;
            const int off1 = qb == 0 ? 62 : qb == 1 ? 114 : qb == 2 ? 165 : qb == 3 ? 205 : qb == 4 ? 235 : qb == 5 ? 256 : qb == 6 ? 276 : 286;
            const int jb = CV_B0 + grp * CV_BGRP + off0; int je = CV_B0 + grp * CV_BGRP + off1; if (je > CV_ITEMS) je = CV_ITEMS;
            convert_range(F, l + 1, jb, je, wave, NWAVES, (LAS unsigned*)(F.lds) + wave * (32 * 65), lane);
        }
    } else {
        for (int sb = blockIdx.x; sb < 256; sb += F.G) scan_block(F, sb, tid);
        for (int item = blockIdx.x; item < NB * AH * (SEQ / 256); item += F.G) attn_block(F, l, lds, item >> 3, item & 7, tid);
    }
}

__device__ __forceinline__ void ssd_out_phase(Frame& F, int l) {
    PHASE_IDS;
    LAS bf16* Cn = (LAS bf16*)F.lds;
    LAS bf16* Bn = Cn + 64 * 136;
    LAS bf16* XTb = Bn + 64 * 136;
    LAS bf16* Swb = XTb + 4 * 64 * 72;
    LAS float* ACSh = (LAS float*)(Swb + 8 * 32 * 72);
    LAS float* DTh = ACSh + 256;
    LAS float* SSP = DTh + 256;
    const int fr = lane & 15, fq = lane >> 4, w = wave, hh = w >> 1, lh = w & 1;
    LAS bf16* XT = XTb + hh * (64 * 72); LAS bf16* Sw = Swb + w * (32 * 72);
    for (int unit = blockIdx.x; unit < NB * NCH * SG; unit += F.G) {
        const int g = unit & 1, c = (unit >> 1) & 31, b = unit >> 6, t0 = b * SEQ + c * CHUNK;
#pragma unroll
        for (int i = 0; i < 2; ++i) { const int idx = tid + NTHR * i, row = idx >> 4, ch = idx & 15; const bf16* src = wsp<bf16>(F, WS_XBC) + (size_t)(t0 + row) * CONVD + 128 * g + 8 * ch;
            *(LAS v4u*)(Bn + row * 136 + 8 * ch) = *(const v4u*)(src + (PC_B - PC_X));
            *(LAS v4u*)(Cn + row * 136 + 8 * ch) = *(const v4u*)(src + (PC_C - PC_X)); }
        f32x4 yv[2][2][4];
#pragma unroll
        for (int q = 0; q < 2; ++q) {
            const int h = g * HPG + 4 * q + hh;
            {   const bf16* src = wsp<bf16>(F, WS_XBC) + (size_t)(t0 + 32 * lh) * CONVD + 64 * h;
#pragma unroll
                for (int i = 0; i < 4; ++i) { const int ss_ = 8 * i + (lane >> 3), ch = lane & 7; const v4u v = *(const v4u*)(src + (size_t)ss_ * CONVD + 8 * ch);
                    LAS bf16* d = XT + (8 * ch) * 72 + 32 * lh + ss_;
                    d[0] = (bf16)v.x; d[72] = (bf16)(v.x >> 16); d[144] = (bf16)v.y; d[216] = (bf16)(v.y >> 16); d[288] = (bf16)v.z; d[360] = (bf16)(v.z >> 16); d[432] = (bf16)v.w; d[504] = (bf16)(v.w >> 16); }
                if (lh == 0) { ACSh[hh * 64 + lane] = wsp<float>(F, WS_ACS)[(t0 + lane) * 16 + h]; DTh[hh * 64 + lane] = wsp<float>(F, WS_DT)[(t0 + lane) * 16 + h]; } }
            __syncthreads();
            const LAS float* acsv = ACSh + hh * 64; const LAS float* dtv = DTh + hh * 64;
#pragma unroll
            for (int ltl = 0; ltl < 2; ++ltl) {
                const int lrow = 32 * lh + 16 * ltl + fr; const float al = acsv[lrow];
                bf16x8 yc[4];
#pragma unroll
                for (int ks = 0; ks < 4; ++ks) yc[ks] = *(const LAS bf16x8*)(Cn + lrow * 136 + 32 * ks + 8 * fq);
#pragma unroll
                for (int st = 0; st < 4; ++st) {
                    f32x4 a = (f32x4){0.f, 0.f, 0.f, 0.f};
#pragma unroll
                    for (int ks = 0; ks < 4; ++ks) { const bf16x8 xb = *(const LAS bf16x8*)(Bn + (16 * st + fr) * 136 + 32 * ks + 8 * fq); a = MFMA16(xb, yc[ks], a); }
                    float v[4];
#pragma unroll
                    for (int j = 0; j < 4; ++j) { const int s = 16 * st + 4 * fq + j; v[j] = (s <= lrow) ? a[j] * __expf(al - acsv[s]) * dtv[s] : 0.f; }
                    u32x2 pw; pw.x = pkb(v[0], v[1]); pw.y = pkb(v[2], v[3]);
                    *(LAS u32x2*)(Sw + (16 * ltl + fr) * 72 + 16 * st + 4 * fq) = pw;
                }
            }
            __syncthreads();
            const float dsk = inp(F, I_d_skip)[l * SH + h];
            const bf16* prev = wsp<bf16>(F, WS_ST) + (size_t)((b * NCH + c) * SH + h) * (SP * SN);
#pragma unroll
            for (int ltl = 0; ltl < 2; ++ltl) {
                const int lrow = 32 * lh + 16 * ltl + fr; const float eal = __expf(acsv[lrow]);
                bf16x8 ys[2], yc[4];
#pragma unroll
                for (int ks = 0; ks < 2; ++ks) ys[ks] = *(const LAS bf16x8*)(Sw + (16 * ltl + fr) * 72 + 32 * ks + 8 * fq);
#pragma unroll
                for (int ks = 0; ks < 4; ++ks) yc[ks] = *(const LAS bf16x8*)(Cn + lrow * 136 + 32 * ks + 8 * fq);
                float ssq = 0.f;
#pragma unroll
                for (int pt = 0; pt < 4; ++pt) {
                    f32x4 a = (f32x4){0.f, 0.f, 0.f, 0.f}, o = (f32x4){0.f, 0.f, 0.f, 0.f};
#pragma unroll
                    for (int ks = 0; ks < 2; ++ks) { const bf16x8 xx = *(const LAS bf16x8*)(XT + (16 * pt + fr) * 72 + 32 * ks + 8 * fq); a = MFMA16(xx, ys[ks], a); }
#pragma unroll
                    for (int ks = 0; ks < 4; ++ks) { const bf16x8 xp = *(const bf16x8*)(prev + (16 * pt + fr) * SN + 32 * ks + 8 * fq); o = MFMA16(xp, yc[ks], o); }
                    const int pc = 16 * pt + 4 * fq;
                    const u32x2 zz = *(const u32x2*)(wsp<bf16>(F, WS_ACT) + (size_t)(t0 + lrow) * DINB + PC_Z + 64 * h + pc);
                    f32x4 y;
                    y[0] = (a[0] + eal * o[0] + dsk * bf2f(XT[(pc + 0) * 72 + lrow])) * silu_f(bflo(zz.x));
                    y[1] = (a[1] + eal * o[1] + dsk * bf2f(XT[(pc + 1) * 72 + lrow])) * silu_f(bfhi(zz.x));
                    y[2] = (a[2] + eal * o[2] + dsk * bf2f(XT[(pc + 2) * 72 + lrow])) * silu_f(bflo(zz.y));
                    y[3] = (a[3] + eal * o[3] + dsk * bf2f(XT[(pc + 3) * 72 + lrow])) * silu_f(bfhi(zz.y));
                    yv[q][ltl][pt] = y; ssq += (y[0] * y[0] + y[1] * y[1]) + (y[2] * y[2] + y[3] * y[3]);
                }
                ssq += __shfl_xor(ssq, 16); ssq += __shfl_xor(ssq, 32);
                if (fq == 0) SSP[lrow * 8 + 4 * q + hh] = ssq;
            }
            __syncthreads();
        }
#pragma unroll
        for (int ltl = 0; ltl < 2; ++ltl) {
            const int lrow = 32 * lh + 16 * ltl + fr;
            const f32x4 s0 = *(const LAS f32x4*)(SSP + lrow * 8), s1 = *(const LAS f32x4*)(SSP + lrow * 8 + 4);
            const float r = 1.0f / sqrtf(((s0[0] + s0[1]) + (s0[2] + s0[3]) + (s1[0] + s1[1]) + (s1[2] + s1[3])) * (1.0f / 512.0f) + EPS);
#pragma unroll
            for (int q = 0; q < 2; ++q) { const int h = g * HPG + 4 * q + hh;
#pragma unroll
                for (int pt = 0; pt < 4; ++pt) { const int pc = 16 * pt + 4 * fq; const f32x4 wn = *(const f32x4*)(inp(F, I_ssm_norm) + l * DSSM + 64 * h + pc); const f32x4 y = yv[q][ltl][pt];
                    u32x2 ow; ow.x = pkb(y[0] * r * wn[0], y[1] * r * wn[1]); ow.y = pkb(y[2] * r * wn[2], y[3] * r * wn[3]);
                    *(u32x2*)(wsp<bf16>(F, WS_YCAT) + (size_t)(t0 + lrow) * DM + 64 * h + pc) = ow; } }
        }
        __syncthreads();
    }
}

struct Args { const float* in[19]; float* out; unsigned char* ws; };
__global__ void __launch_bounds__(NWAVES * 64, 2) fwd_kernel(Args args) {
    extern __shared__ __attribute__((aligned(16))) unsigned char lds[];
    Frame F;
    F.lds = (LAS unsigned char*)lds;
    F.MISC = (volatile LAS unsigned*)(F.lds + MISC_OFF);
    F.G = gridDim.x; { const int bx = blockIdx.x; F.vcu = (F.G % 8 == 0) ? (bx % 8) * (F.G / 8) + bx / 8 : bx; }
    F.ws = args.ws; F.X = args.out;
    for (int u = threadIdx.x; u < (LDS_BYTES - LDSCTL_OFF) / 4; u += NWAVES * 64) ((LAS unsigned*)(F.lds + LDSCTL_OFF))[u] = 0u;
    __syncthreads();
    if (threadIdx.x == 0) { LAS unsigned* t = (LAS unsigned*)(F.lds + LDSCTL_OFF);
#pragma unroll
        for (int k = 0; k < I_N; ++k) { const unsigned long long p = (unsigned long long)args.in[k]; t[2 * k] = (unsigned)p; t[2 * k + 1] = (unsigned)(p >> 32); } }
    __syncthreads();
    XcdBarrier bar = xcd_barrier_post((unsigned*)(args.ws + WS_CTL) + CW_BAR, F.MISC + 8);
#define GRID_BAR() do { XcdBarrier b_ = bar; GAS unsigned* p_ = (GAS unsigned*)bar.bar; asm volatile("" : "+s"(p_), "+s"(b_.x)); b_.bar = (unsigned*)p_; xcd_barrier(b_); } while (0)

    p0_prologue(F);
    GRID_BAR();
    mod_reduce_phase(F);
    GRID_BAR();
    thin_phase<true, false, 2>(F, 0);
    for (int s = 0; s < 3 * DEPTH; ++s) {
        const int l = s / 3, sub = s % 3;
        if (s > 0) thin_phase<false, false, 4>(F, s);
        GRID_BAR();
        if (sub != 1) {
            const int lf = l * 2 + (sub == 2 ? 1 : 0);
            pg8::Gemm g{wsp<bf16>(F, WS_HB), wsp<bf16>(F, WS_WGU) + (size_t)lf * NGU * DM, M, NGU, DM}; pg8::StaticOrder S; S.init(M, NGU, F.G, (int)blockIdx.x);
            pg8::EpiSwiGLU E{wsp<bf16>(F, WS_ACT), DFF};
            pg8::gemm_phase<pg8::EpiSwiGLU, pg8::StaticOrder, true, true>(F.lds, g, S, E);
            if (F.G == 256 && blockIdx.x >= 128 && l + 1 < DEPTH) {
                const int tid_ = fresh_tid(), wv_ = __builtin_amdgcn_readfirstlane(tid_ >> 6), ph_ = (sub == 2 ? 1 : 0), slot_ = (int)blockIdx.x - 128;
                convert_range(F, l + 1, ph_ * CV_G1, (ph_ + 1) * CV_G1, slot_ * NWAVES + wv_, 128 * NWAVES, (LAS unsigned*)(F.lds) + wv_ * (32 * 65), tid_ & 63);
                if (ph_ == 0) convert_tail(F, l + 1, slot_ * NTHR + tid_, 128 * NTHR);
            }
            GRID_BAR();
        } else {
            {   pg8::Gemm g{wsp<bf16>(F, WS_HB), wsp<bf16>(F, WS_WIN) + (size_t)l * DINP * DM, M, DINP, DM}; pg8::StaticOrder S; S.init(M, DINP, F.G, (int)blockIdx.x);
                pg8::EpiProj E{wsp<bf16>(F, WS_ACT), DINB, wsp<float>(F, WS_DTF), DINB / 256};
                pg8::gemm_phase<pg8::EpiProj, pg8::StaticOrder, true, true>(F.lds, g, S, E); }
            GRID_BAR();
            ssd_states_phase(F, l);
            GRID_BAR();
            attn_scan_phase(F, l, (char*)lds);
            GRID_BAR();
            ssd_out_phase(F, l);
            GRID_BAR();
        }
        {   const bool mix = (sub == 1); const int lf = l * 2 + (sub == 2 ? 1 : 0);
            pg8::Gemm g{mix ? wsp<bf16>(F, WS_YCAT) : wsp<bf16>(F, WS_ACT), mix ? wsp<bf16>(F, WS_WOUT) + (size_t)l * DM * DM : wsp<bf16>(F, WS_WDN) + (size_t)lf * DM * DFF, M, DM, mix ? DM : DFF}; pg8::StaticOrder S; S.init(M, DM, F.G, (int)blockIdx.x);
            pg8::EpiProj E{wsp<bf16>(F, WS_Y), DM, nullptr, 1 << 30};
            pg8::gemm_phase<pg8::EpiProj, pg8::StaticOrder, true, true>(F.lds, g, S, E); }
        GRID_BAR();
    }
    thin_phase<false, true, 2>(F, 3 * DEPTH);
}

extern "C" void kernel_launch(void* const* d_in, const int* in_sizes, int n_in, void* d_out, int out_size, void* d_ws, size_t ws_size, hipStream_t stream) {
    static int grid = 0;
    if (grid == 0) {
        if (n_in != 19 || in_sizes[0] != M * DM || out_size != M * DM || ws_size < WS_END) { fprintf(stderr, "kernel_launch: unexpected shapes (n_in %d, in0 %d, out %d, ws %zu < %zu)\n", n_in, n_in > 0 ? in_sizes[0] : -1, out_size, ws_size, (size_t)WS_END); grid = -1; return; }
        int dev = 0, cus = 0, per_cu = 0;
        if (hipGetDevice(&dev) != hipSuccess || hipDeviceGetAttribute(&cus, hipDeviceAttributeMultiprocessorCount, dev) != hipSuccess) { grid = -1; return; }
        if (hipFuncSetAttribute((const void*)fwd_kernel, hipFuncAttributeMaxDynamicSharedMemorySize, LDS_BYTES) != hipSuccess) { fprintf(stderr, "kernel_launch: hipFuncSetAttribute failed\n"); grid = -1; return; }
        if (hipOccupancyMaxActiveBlocksPerMultiprocessor(&per_cu, (const void*)fwd_kernel, NWAVES * 64, LDS_BYTES) != hipSuccess || per_cu < 1) { fprintf(stderr, "kernel_launch: occupancy query says %d\n", per_cu); }
        (void)hipGetLastError();
        grid = cus;
    }
    if (grid < 0) return;
    if (hipMemsetAsync((char*)d_ws + WS_CTL, 0, CTL_ZERO_BYTES, stream) != hipSuccess) return;
    Args a{};
    for (int i = 0; i < 19; ++i) a.in[i] = (const float*)d_in[i];
    a.out = (float*)d_out; a.ws = (unsigned char*)d_ws;
    hipLaunchKernelGGL(fwd_kernel, dim3(grid), dim3(NWAVES * 64), LDS_BYTES, stream, a);
}
```

```cpp
#include <hip/hip_runtime.h>
#include <hip/hip_bf16.h>
#include <cstdio>
#include <cstdint>
namespace pg8 {
#define PG8_LAS __attribute__((address_space(3)))
typedef unsigned short bf16_t;
typedef short bf16x8 __attribute__((ext_vector_type(8)));
typedef float f32x4 __attribute__((ext_vector_type(4)));
typedef unsigned u32x4 __attribute__((ext_vector_type(4)));
constexpr int BM = 256, BK = 64, HALF = 128, HTB = HALF * BK * 2  , STAGE_BYTES = 8 * HTB, NXCD = 8, WGM = 8;

__host__ __device__ __forceinline__ int lds_byte(int r, int c) { const int st = (r >> 4) * 2 + (c >> 5), rr = r & 15, cc = c & 31, ob = rr * 64 + cc * 2; return st * 1024 + (ob ^ (((ob >> 9) & 1) << 5)); }
__host__ __device__ __forceinline__ void stage_rc(int b, int& R, int& C) { const int st = b / 1024, sb = b % 1024, swz = sb ^ (((sb >> 9) & 1) << 5); R = (st >> 1) * 16 + swz / 64; C = (st & 1) * 32 + (swz % 64) / 2; }
__host__ __device__ __forceinline__ int perm32(int rho) { const int n = rho >> 4, i = rho & 15; return 8 * (i >> 2) + 4 * n + (i & 3); }

struct Unit { int pm, pn; };
struct Gemm { const bf16_t* A; const bf16_t* Bt; int M, N, K; };

struct StaticOrder {
    int nM, nN, nwg, G, c;
    __host__ __device__ void init(int M, int N, int G_, int c_) { nM = M / BM; nN = N / BM; nwg = nM * nN; G = G_; c = c_; }
    __host__ __device__ bool next(int i, Unit& u) const {
        const long L = (long)i * G + c; if (L >= nwg) return false;
        int wgid = (int)L; { const int q = nwg / NXCD, r = nwg % NXCD, xcd = wgid % NXCD, off = wgid / NXCD; wgid = (xcd < r ? xcd * (q + 1) : r * (q + 1) + (xcd - r) * q) + off; }
        const int nig = WGM * nN, gid = wgid / nig, fm = gid * WGM, gsz = (nM - fm) < WGM ? (nM - fm) : WGM;
        u.pm = fm + ((wgid % nig) % gsz); u.pn = (wgid % nig) / gsz; return true;
    }
    __device__ __forceinline__ void a_ready(const Unit&) const {}
    __device__ __forceinline__ void done(const Unit&) const {}
};

__device__ __forceinline__ unsigned cvt_pk_bf16(float lo, float hi) { unsigned r; asm volatile("v_cvt_pk_bf16_f32 %0, %1, %2" : "=v"(r) : "v"(lo), "v"(hi)); return r; }
typedef float f32x2 __attribute__((ext_vector_type(2)));
typedef __bf16 bf16x2_t __attribute__((ext_vector_type(2)));
__device__ __forceinline__ unsigned pk_bf16(float lo, float hi) { f32x2 v = {lo, hi}; bf16x2_t b = __builtin_convertvector(v, bf16x2_t); return __builtin_bit_cast(unsigned, b); }
__device__ __forceinline__ float silu_f(float g) { return g * __builtin_amdgcn_rcpf(1.0f + __expf(-g)); }

struct EpiF32 {
    static constexpr bool PERM = false, AFTER_DRAIN = false;
    float* C; int ldc;
    __device__ __forceinline__ void operator()(const f32x4 (&acc)[2][2][4][2], const Unit& u, int wr, int wc, int fr, int fq) const {
        const int row0 = u.pm * BM + wr * 64 + fr, col0 = u.pn * BM + wc * 32 + 4 * fq;
#pragma unroll
        for (int ai = 0; ai < 2; ++ai)
#pragma unroll
            for (int m = 0; m < 4; ++m) { float* rowp = C + (size_t)(row0 + ai * HALF + m * 16) * ldc + col0;
#pragma unroll
                for (int bj = 0; bj < 2; ++bj)
#pragma unroll
                    for (int n = 0; n < 2; ++n) *(f32x4*)(rowp + bj * HALF + n * 16) = acc[ai][bj][m][n]; }
    }
};
struct EpiSwiGLU {
    static constexpr bool PERM = true, AFTER_DRAIN = false;
    bf16_t* O; int ldc;
    __device__ __forceinline__ void operator()(const f32x4 (&acc)[2][2][4][2], const Unit& u, int wr, int wc, int fr, int fq) const {
        const int row0 = u.pm * BM + wr * 64 + fr, col0 = u.pn * HALF + wc * 32 + 8 * fq;
#pragma unroll
        for (int ai = 0; ai < 2; ++ai)
#pragma unroll
            for (int m = 0; m < 4; ++m) { bf16_t* rowp = O + (size_t)(row0 + ai * HALF + m * 16) * ldc + col0;
                const f32x4 g0 = acc[ai][0][m][0], g1 = acc[ai][0][m][1], u0 = acc[ai][1][m][0], u1 = acc[ai][1][m][1];
                u32x4 w;
                w.x = pk_bf16(silu_f(g0[0]) * u0[0], silu_f(g0[1]) * u0[1]); w.y = pk_bf16(silu_f(g0[2]) * u0[2], silu_f(g0[3]) * u0[3]);
                w.z = pk_bf16(silu_f(g1[0]) * u1[0], silu_f(g1[1]) * u1[1]); w.w = pk_bf16(silu_f(g1[2]) * u1[2], silu_f(g1[3]) * u1[3]);
                *(u32x4*)rowp = w; }
    }
};
struct EpiProj {
    static constexpr bool PERM = true, AFTER_DRAIN = false;
    bf16_t* O; int ldc; float* dtf; int nbf;
    __device__ __forceinline__ void operator()(const f32x4 (&acc)[2][2][4][2], const Unit& u, int wr, int wc, int fr, int fq) const {
        const int row0 = u.pm * BM + wr * 64 + fr;
        if (u.pn < nbf) {
            const int col0 = u.pn * BM + wc * 32 + 8 * fq;
#pragma unroll
            for (int ai = 0; ai < 2; ++ai)
#pragma unroll
                for (int m = 0; m < 4; ++m) { bf16_t* rowp = O + (size_t)(row0 + ai * HALF + m * 16) * ldc + col0;
#pragma unroll
                    for (int bj = 0; bj < 2; ++bj) { const f32x4 v0 = acc[ai][bj][m][0], v1 = acc[ai][bj][m][1];
                        u32x4 w; w.x = pk_bf16(v0[0], v0[1]); w.y = pk_bf16(v0[2], v0[3]); w.z = pk_bf16(v1[0], v1[1]); w.w = pk_bf16(v1[2], v1[3]);
                        *(u32x4*)(rowp + bj * HALF) = w; } }
        } else if (wc == 0) {
#pragma unroll
            for (int ai = 0; ai < 2; ++ai)
#pragma unroll
                for (int m = 0; m < 4; ++m) { float* rp = dtf + (size_t)(row0 + ai * HALF + m * 16) * 32 + 8 * fq;
                    *(f32x4*)rp = acc[ai][0][m][0]; *(f32x4*)(rp + 4) = acc[ai][0][m][1]; }
        }
    }
};
template <class Epi, class Sched, bool ALIGN_EPI = false, bool SP2 = false>
__device__ __forceinline__ void gemm_phase(PG8_LAS unsigned char* lds, const Gemm g, const Sched& S, const Epi& E) {
    int tid_ = threadIdx.x; asm volatile("" : "+v"(tid_)); const int tid = tid_, wid = __builtin_amdgcn_readfirstlane(tid >> 6), lane = tid & 63, wr = wid >> 2, wc = wid & 3, fr = lane & 15, fq = lane >> 4;
    const int K = g.K, nt = K / BK;
    unsigned voffA[2], voffB[2];
#pragma unroll
    for (int i = 0; i < 2; ++i) { int R, C; stage_rc(tid * 16 + i * 8192, R, C); const int Rb = Epi::PERM ? ((R & ~31) + perm32(R & 31)) : R;
        voffA[i] = (unsigned)(R * K + C) * 2u; voffB[i] = (unsigned)(Rb * K + C) * 2u; }
    const size_t kstep = (size_t)(BK * 2);
    const size_t hstep = (size_t)HALF * K * 2;
    const size_t tstep = 2 * hstep;
    const unsigned ldsw = (unsigned)wid * 1024u;
    const int aoff = lds_byte(wr * 64 + fr, fq * 8), boff = lds_byte(wc * 32 + fr, fq * 8);
#define PG8_SA(b, h) (((b) * 2 + (h)) * HTB)
#define PG8_SB(b, h) ((4 + (b) * 2 + (h)) * HTB)
#define PG8_STAGE(bufoff, gbase, voff) do { _Pragma("unroll") for (int _i = 0; _i < 2; ++_i) \
        __builtin_amdgcn_global_load_lds((const unsigned*)((const char*)(gbase) + (voff)[_i]), (PG8_LAS unsigned*)(lds + (bufoff) + ldsw + _i * 8192), 16, 0, 0); } while (0)
#define PG8_LDA(dst, b, h) do { _Pragma("unroll") for (int m = 0; m < 4; ++m) _Pragma("unroll") for (int k = 0; k < 2; ++k) dst[m][k] = *(const PG8_LAS bf16x8*)(lds + PG8_SA(b, h) + aoff + m * 2048 + k * 1024); } while (0)
#define PG8_LDB(dst, b, h) do { _Pragma("unroll") for (int n = 0; n < 2; ++n) _Pragma("unroll") for (int k = 0; k < 2; ++k) dst[n][k] = *(const PG8_LAS bf16x8*)(lds + PG8_SB(b, h) + boff + n * 2048 + k * 1024); } while (0)
#define PG8_MMA(ai, bj, At, Bt) do { __builtin_amdgcn_s_setprio(1); _Pragma("unroll") for (int m = 0; m < 4; ++m) _Pragma("unroll") for (int n = 0; n < 2; ++n) _Pragma("unroll") for (int k = 0; k < 2; ++k) \
        acc[ai][bj][m][n] = __builtin_amdgcn_mfma_f32_16x16x32_bf16(Bt[n][k], At[m][k], acc[ai][bj][m][n], 0, 0, 0); __builtin_amdgcn_s_setprio(0); } while (0)
#define PG8_WAIT_V(n) asm volatile("s_waitcnt vmcnt(" #n ")" ::: "memory")
#define PG8_WAIT_L(n) asm volatile("s_waitcnt lgkmcnt(" #n ")" ::: "memory")
#define PG8_BAR __builtin_amdgcn_s_barrier()
#define PG8_SCHED __builtin_amdgcn_sched_barrier(0)
    Unit cur, nxt; int ui = 0;
    if (!S.next(0, cur)) return;
    f32x4 acc[2][2][4][2];
#pragma unroll
    for (int a = 0; a < 2; ++a)
#pragma unroll
        for (int b = 0; b < 2; ++b)
#pragma unroll
            for (int m = 0; m < 4; ++m)
#pragma unroll
                for (int n = 0; n < 2; ++n) acc[a][b][m][n] = (f32x4){0.f, 0.f, 0.f, 0.f};
    bf16x8 At[4][2], B0[2][2], B1[2][2];
    const char* cA = (const char*)g.A + (size_t)cur.pm * tstep; const char* cB = (const char*)g.Bt + (size_t)cur.pn * tstep;
    S.a_ready(cur);
    if constexpr (SP2) {
        PG8_STAGE(PG8_SB(0, 0), cB, voffB); PG8_STAGE(PG8_SB(0, 1), cB + hstep, voffB); PG8_STAGE(PG8_SA(0, 0), cA, voffA); PG8_STAGE(PG8_SA(0, 1), cA + hstep, voffA);
        if (wr == 1) PG8_BAR;
        PG8_WAIT_V(2); PG8_BAR;
        PG8_STAGE(PG8_SB(1, 0), cB + kstep, voffB); PG8_STAGE(PG8_SA(1, 0), cA + kstep, voffA); PG8_STAGE(PG8_SB(1, 1), cB + hstep + kstep, voffB);
        PG8_WAIT_V(6); PG8_BAR;
    } else {
        PG8_STAGE(PG8_SB(0, 0), cB, voffB); PG8_STAGE(PG8_SA(0, 0), cA, voffA); PG8_STAGE(PG8_SB(0, 1), cB + hstep, voffB); PG8_STAGE(PG8_SA(0, 1), cA + hstep, voffA);
        if (wr == 1) PG8_BAR;
        PG8_WAIT_V(4); PG8_BAR;
        PG8_STAGE(PG8_SB(1, 0), cB + kstep, voffB); PG8_STAGE(PG8_SA(1, 0), cA + kstep, voffA); PG8_STAGE(PG8_SB(1, 1), cB + hstep + kstep, voffB);
        PG8_WAIT_V(6); PG8_BAR;
    }
    for (;;) {
        const bool has_next = S.next(ui + 1, nxt);
        const char* nA = has_next ? (const char*)g.A + (size_t)nxt.pm * tstep : cA; const char* nB = has_next ? (const char*)g.Bt + (size_t)nxt.pn * tstep : cB;
        for (int t = 0; t < nt; t += 2) {
            const bool last = (t == nt - 2);
            const char* a1 = cA + (size_t)(t + 1) * kstep;
            const char* a2 = last ? nA : cA + (size_t)(t + 2) * kstep; const char* b2 = last ? nB : cB + (size_t)(t + 2) * kstep;
            const char* a3 = a2 + kstep; const char* b3 = b2 + kstep;
            if (last && has_next) S.a_ready(nxt);
            if constexpr (SP2) {
            PG8_LDB(B0, 0, 0); PG8_LDB(B1, 0, 1); PG8_SCHED; PG8_LDA(At, 0, 0); PG8_STAGE(PG8_SA(1, 1), a1 + hstep, voffA);
            PG8_WAIT_V(8); PG8_WAIT_L(0); PG8_BAR; PG8_MMA(0, 0, At, B0); PG8_MMA(0, 1, At, B1); PG8_BAR; PG8_SCHED;
            PG8_LDA(At, 0, 1); PG8_STAGE(PG8_SB(0, 0), b2, voffB); PG8_STAGE(PG8_SB(0, 1), b2 + hstep, voffB); PG8_STAGE(PG8_SA(0, 0), a2, voffA);
            PG8_WAIT_V(8); PG8_WAIT_L(0); PG8_BAR; PG8_MMA(1, 0, At, B0); PG8_MMA(1, 1, At, B1); PG8_BAR; PG8_SCHED;
            PG8_LDB(B0, 1, 0); PG8_LDB(B1, 1, 1); PG8_SCHED; PG8_LDA(At, 1, 0); PG8_STAGE(PG8_SA(0, 1), a2 + hstep, voffA);
            PG8_WAIT_V(8); PG8_WAIT_L(0); PG8_BAR; PG8_MMA(0, 0, At, B0); PG8_MMA(0, 1, At, B1); PG8_BAR; PG8_SCHED;
            PG8_LDA(At, 1, 1); PG8_STAGE(PG8_SB(1, 0), b3, voffB); PG8_STAGE(PG8_SB(1, 1), b3 + hstep, voffB); PG8_STAGE(PG8_SA(1, 0), a3, voffA);
            PG8_WAIT_V(8); PG8_WAIT_L(0); PG8_BAR; PG8_MMA(1, 0, At, B0); PG8_MMA(1, 1, At, B1); PG8_BAR; PG8_SCHED;
            } else {
            PG8_LDB(B0, 0, 0); PG8_SCHED; PG8_LDA(At, 0, 0); PG8_STAGE(PG8_SA(1, 1), a1 + hstep, voffA);
            PG8_WAIT_L(8); PG8_BAR; PG8_WAIT_L(0); PG8_MMA(0, 0, At, B0); PG8_BAR; PG8_SCHED;
            PG8_LDB(B1, 0, 1); PG8_STAGE(PG8_SB(0, 0), b2, voffB);
            PG8_BAR; PG8_WAIT_L(0); PG8_MMA(0, 1, At, B1); PG8_BAR;
            PG8_LDA(At, 0, 1); PG8_STAGE(PG8_SA(0, 0), a2, voffA);
            PG8_BAR; PG8_WAIT_L(0); PG8_MMA(1, 0, At, B0); PG8_BAR; PG8_SCHED;
            PG8_STAGE(PG8_SB(0, 1), b2 + hstep, voffB);
            PG8_WAIT_V(6); PG8_BAR; PG8_MMA(1, 1, At, B1); PG8_BAR;
            PG8_LDB(B0, 1, 0); PG8_SCHED; PG8_LDA(At, 1, 0); PG8_STAGE(PG8_SA(0, 1), a2 + hstep, voffA);
            PG8_WAIT_L(8); PG8_BAR; PG8_WAIT_L(0); PG8_MMA(0, 0, At, B0); PG8_BAR; PG8_SCHED;
            PG8_LDB(B1, 1, 1); PG8_STAGE(PG8_SB(1, 0), b3, voffB);
            PG8_BAR; PG8_WAIT_L(0); PG8_MMA(0, 1, At, B1); PG8_BAR;
            PG8_LDA(At, 1, 1); PG8_STAGE(PG8_SA(1, 0), a3, voffA);
            PG8_BAR; PG8_WAIT_L(0); PG8_MMA(1, 0, At, B0); PG8_BAR; PG8_SCHED;
            PG8_STAGE(PG8_SB(1, 1), b3 + hstep, voffB);
            PG8_WAIT_V(6); PG8_BAR; PG8_MMA(1, 1, At, B1); PG8_BAR;
            }
        }
        if constexpr (ALIGN_EPI) { if (wr == 0) PG8_BAR; }
        if constexpr (!Epi::AFTER_DRAIN) { E(acc, cur, wr, wc, fr, fq); S.done(cur); }
        if (!has_next) break;
#pragma unroll
        for (int a = 0; a < 2; ++a)
#pragma unroll
            for (int b = 0; b < 2; ++b)
#pragma unroll
                for (int m = 0; m < 4; ++m)
#pragma unroll
                    for (int n = 0; n < 2; ++n) acc[a][b][m][n] = (f32x4){0.f, 0.f, 0.f, 0.f};
        cur = nxt; cA = nA; cB = nB; ++ui;
        if constexpr (ALIGN_EPI) { if (wr == 1) PG8_BAR; }
    }
    PG8_WAIT_V(0);
    if constexpr (!ALIGN_EPI) { if (wr == 0) PG8_BAR; }
    PG8_BAR;
    if constexpr (Epi::AFTER_DRAIN) { E.fused(acc, cur, wr, wc, fr, fq, lds, wid, lane); S.done(cur); }
#undef PG8_SA
#undef PG8_SB
#undef PG8_STAGE
#undef PG8_LDA
#undef PG8_LDB
#undef PG8_MMA
#undef PG8_WAIT_V
#undef PG8_WAIT_L
#undef PG8_BAR
#undef PG8_SCHED
}
}

constexpr int NWAVES = 8, NTHR = NWAVES * 64;
constexpr int NB = 4, SEQ = 2048, DM = 2048, DEPTH = 4, M = NB * SEQ;
constexpr int CHUNK = 64, NCH = SEQ / CHUNK;
constexpr int DSSM = 1024, SP = 64, SH = 16, SG = 2, HPG = 8, SN = 128, CONVD = 1536;
constexpr int DATT = 1024, AHD = 128, AH = 8;
constexpr int DFF = 5632, NMOD = 9, MODW = NMOD * DM, NGU = 2 * DFF;
constexpr int DIN = 5656, DINB = 5632, DINP = 5888;
constexpr int PC_Z = 0, PC_X = 1024, PC_B = 2048, PC_C = 2304, PC_Q = 2560, PC_K = 3584, PC_V = 4608;
constexpr float EPS = 1e-6f;

constexpr size_t MiB = 1u << 20;
constexpr size_t WS_CTL = 0, CTL_ZERO_BYTES = 4 * MiB;
constexpr size_t WS_MOD = 1 * MiB;
constexpr size_t WS_WGU = 4 * MiB;
constexpr size_t WS_WDN = WS_WGU + (size_t)DEPTH * 2 * NGU * DM * 2;
constexpr size_t WS_WIN = WS_WDN + (size_t)DEPTH * 2 * DM * DFF * 2;
constexpr size_t WS_WOUT = WS_WIN + (size_t)DEPTH * DINP * DM * 2;
constexpr size_t WS_HB = WS_WOUT + (size_t)DEPTH * DM * DM * 2;
constexpr size_t WS_ACT = WS_HB + (size_t)M * DM * 2;
constexpr size_t WS_Y = WS_ACT + (size_t)M * DFF * 2;
constexpr size_t WS_DTF = WS_Y + (size_t)M * DM * 4;
constexpr size_t WS_XBC = WS_DTF + (size_t)M * 32 * 4;
constexpr size_t WS_DT = WS_XBC + (size_t)M * CONVD * 2;
constexpr size_t WS_ACS = WS_DT + (size_t)M * 16 * 4;
constexpr size_t WS_CUMF = WS_ACS + (size_t)M * 16 * 4;
constexpr size_t WS_ST = WS_CUMF + (size_t)NB * AH * SEQ * 4;
constexpr size_t WS_YCAT = WS_ST + (size_t)NB * NCH * SH * SP * SN * 4;
constexpr size_t WS_PART = WS_YCAT + (size_t)M * DM * 2;
constexpr size_t WS_XB = WS_PART + (size_t)8 * DEPTH * NB * MODW * 4;
constexpr size_t WS_END = WS_XB + (size_t)M * DM * 2;
constexpr int CW_BAR = 4096;

constexpr int RING_BYTES = 131072;
constexpr int LDSCTL_OFF = RING_BYTES, MISC_OFF = LDSCTL_OFF + 320;
constexpr int LDS_BYTES = 147456;

#define GAS __attribute__((address_space(1)))
#define LAS __attribute__((address_space(3)))
typedef unsigned short bf16;
typedef unsigned v4u __attribute__((ext_vector_type(4)));
typedef float f32x4 __attribute__((ext_vector_type(4)));
typedef short bf16x8 __attribute__((ext_vector_type(8)));
typedef GAS unsigned gu32;
typedef GAS unsigned long long gu64;
#define RLX_AGENT __ATOMIC_RELAXED, __HIP_MEMORY_SCOPE_AGENT
#define LDS_WAIT() asm volatile("s_waitcnt lgkmcnt(0)" ::: "memory")
#define VM_WAIT() asm volatile("s_waitcnt vmcnt(0)" ::: "memory")
__device__ __forceinline__ unsigned long long rt() { return __builtin_amdgcn_s_memrealtime(); }
__device__ __forceinline__ unsigned f2bf(float f) { unsigned u = __builtin_bit_cast(unsigned, f); return (u + 0x7fffu + ((u >> 16) & 1u)) >> 16; }
__device__ __forceinline__ unsigned pk2(float lo, float hi) { return f2bf(lo) | (f2bf(hi) << 16); }

#define XB_TMO      128
#define XB_XCNT(j)  (256  + 64 * (j))
#define XB_XSUB(j)  (1280 + 64 * (j))
#define XB_XGEN(j)  (2304 + 64 * (j))
#define XB_TOP      3328
#define XB_TOPGEN   3392
#define XCD_BAR_WORDS 3456
#define XB_SPIN_CAP (1u << 18)

__device__ __forceinline__ unsigned xb_ld(unsigned* p)              { return __hip_atomic_load(p, __ATOMIC_RELAXED, __HIP_MEMORY_SCOPE_AGENT); }
__device__ __forceinline__ unsigned xb_add(unsigned* p, unsigned v) { return __hip_atomic_fetch_add(p, v, __ATOMIC_RELAXED, __HIP_MEMORY_SCOPE_AGENT); }
__device__ __forceinline__ unsigned xb_xcc_id() { return (unsigned)__builtin_amdgcn_s_getreg((3 << 11) | 20) & 0xFu; }
#define XB_SPIN(cond, bar) do { unsigned _sp = 0; while (cond) { __builtin_amdgcn_s_sleep(1); \
    if ((++_sp & 255u) == 0u) { if (xb_ld(&(bar)[XB_TMO])) break; if (_sp > XB_SPIN_CAP) { atomicAdd(&(bar)[XB_TMO], 1u); break; } } } } while (0)

struct XcdBarrier {
    unsigned* bar; unsigned x;
    volatile LAS unsigned* st;
};

__device__ __forceinline__ XcdBarrier xcd_barrier_post(unsigned* bar, volatile LAS unsigned* st) {
    XcdBarrier b; b.bar = bar; b.x = xb_xcc_id(); b.st = st;
    if (threadIdx.x == 0) (void)xb_add(&bar[XB_XCNT(b.x)], 1u);
    return b;
}
__device__ __forceinline__ void xcd_barrier_complete(unsigned* bar, unsigned x, unsigned& nloc, unsigned& nx) {
    const unsigned G = gridDim.x * gridDim.y * gridDim.z;
    unsigned sum, cnt, mine, sp = 0u;
    for (;;) {
        sum = 0u; cnt = 0u; mine = 0u;
#pragma unroll
        for (unsigned j = 0; j < 16; ++j) { const unsigned c = xb_ld(&bar[XB_XCNT(j)]); sum += c; cnt += (c > 0u) ? 1u : 0u; mine = (j == x) ? c : mine; }
        if (sum == G) break;
        __builtin_amdgcn_s_sleep(1);
        if ((++sp & 255u) == 0u) { if (xb_ld(&bar[XB_TMO])) break; if (sp > XB_SPIN_CAP) { atomicAdd(&bar[XB_TMO], 1u); break; } }
    }
    nloc = mine > 0u ? mine : 1u; nx = cnt > 0u ? cnt : 1u;
}

__device__ __forceinline__ void xcd_barrier(const XcdBarrier& b) {
    asm volatile("s_waitcnt vmcnt(0)" ::: "memory");
    __syncthreads();
    if (threadIdx.x == 0) {
        unsigned* bar = b.bar;
        __builtin_amdgcn_s_waitcnt(0);
        unsigned nloc = b.st[0], nx = b.st[1];
        if (nloc == 0u) { xcd_barrier_complete(bar, b.x, nloc, nx); b.st[0] = nloc; b.st[1] = nx; }
        const unsigned old = xb_add(&bar[XB_XSUB(b.x)], 1u);
        const unsigned gen = old / nloc;
        if (old + 1u == (gen + 1u) * nloc) {
            __builtin_amdgcn_fence(__ATOMIC_RELEASE, "agent");
            asm volatile("s_waitcnt vmcnt(0)" ::: "memory");
            const unsigned og = xb_add(&bar[XB_TOP], 1u);
            const unsigned tg = og / nx;
            if (og + 1u == (tg + 1u) * nx) xb_add(&bar[XB_TOPGEN], 1u);
            else XB_SPIN(xb_ld(&bar[XB_TOPGEN]) == tg, bar);
            __builtin_amdgcn_fence(__ATOMIC_ACQUIRE, "agent");
            xb_add(&bar[XB_XGEN(b.x)], 1u);
            asm volatile("s_waitcnt vmcnt(0)" ::: "memory");
        } else {
            XB_SPIN(xb_ld(&bar[XB_XGEN(b.x)]) == gen, bar);
            __builtin_amdgcn_fence(__ATOMIC_ACQUIRE, "agent");
            asm volatile("s_waitcnt vmcnt(0)" ::: "memory");
        }
    }
    __syncthreads();
}
namespace fa {
constexpr int D = 128, LDK = 5632, LDO = 2048;
constexpr bool WSKIP = false; constexpr float THR = 8.f; constexpr float NEPS = 1e-6f;
template <class A, class Bt> struct same_t { static constexpr bool v = false; };
template <class A> struct same_t<A, A> { static constexpr bool v = true; };
constexpr float SCALE = 0.08838834764831845f;
constexpr int NW = 8, QBLK = 32, KVBLK = 64, QB = NW * QBLK;
constexpr int SHM_V = KVBLK * D * 2, SHM_K = KVBLK * D * 2;
constexpr int LDS_BYTES = 2 * SHM_V + 2 * SHM_K + NW * 64 * 4;
using bf16 = __hip_bfloat16;
typedef short bf16x8 __attribute__((ext_vector_type(8)));
typedef short s16x4 __attribute__((ext_vector_type(4)));
typedef float f32x16 __attribute__((ext_vector_type(16)));
typedef float f32x4 __attribute__((ext_vector_type(4)));
typedef unsigned u32x4 __attribute__((ext_vector_type(4)));
#define KSWZ(row, colB) ((row) * 256 + ((colB) ^ (((row) & 7) << 4)))
#define SBAR() __builtin_amdgcn_sched_barrier(0)
__device__ __forceinline__ int v_st(int k, int c) { const int kk = (k & ~0xC) | ((k & 4) << 1) | ((k & 8) >> 1); return ((kk >> 3) * 4 + (c >> 5)) * 512 + ((kk & 7) * 32 + (c & 31)) * 2; }
__device__ __forceinline__ int v_rd_base(int lane) { return ((lane & 3) << 3) | (((lane >> 2) & 3) << 6) | (((lane >> 4) & 1) << 5) | (((lane >> 5) & 1) << 8); }
constexpr int v_rd_off(int d0, int ks, int half) { return d0 * 512 + ks * 4096 + half * 2048; }
__device__ __forceinline__ int crow(int r, int hi) { return (r & 3) + 8 * (r >> 2) + 4 * hi; }
__device__ __forceinline__ unsigned cvtpk(float lo, float hi) {
    unsigned r; asm volatile("v_cvt_pk_bf16_f32 %0, %1, %2" : "=v"(r) : "v"(lo), "v"(hi)); return r;
}
__device__ __forceinline__ bf16x8 pack8(f32x4 a, f32x4 b) {
    u32x4 w = {cvtpk(a[0], a[1]), cvtpk(a[2], a[3]), cvtpk(b[0], b[1]), cvtpk(b[2], b[3])};
    return *reinterpret_cast<bf16x8*>(&w);
}
template <class T> __device__ __forceinline__ bf16x8 load8(const T* p) {
    if constexpr (same_t<T, float>::v) { return pack8(*(const f32x4*)p, *(const f32x4*)(p + 4)); }
    else { return *reinterpret_cast<const bf16x8*>(p); }
}
__device__ __forceinline__ void mask_tile(f32x16& p0, f32x16& p1, int dq, unsigned W) {
    const float NEG = -__builtin_inff();
#pragma unroll
    for (int r = 0; r < 16; ++r) {
        const int c = (r & 3) + 8 * (r >> 2);
        if ((unsigned)(dq - c) >= W) p0[r] = NEG;
        if ((unsigned)(dq - c - 32) >= W) p1[r] = NEG;
    }
}
__device__ __forceinline__ void partialSM(f32x16& p0, f32x16& p1, float& m_reg, float& mn, float& alpha) {
    float pmax = p0[0]; for (int r = 1; r < 16; ++r) pmax = fmaxf(pmax, p0[r]); for (int r = 0; r < 16; ++r) pmax = fmaxf(pmax, p1[r]);
    { auto rr = __builtin_amdgcn_permlane32_swap(__float_as_uint(pmax), __float_as_uint(pmax), false, false);
      pmax = fmaxf(__uint_as_float(rr[0]), __uint_as_float(rr[1])); }
    constexpr float C2 = 1.4426950408889634f * SCALE;
    if (__builtin_expect(__all((pmax - m_reg) * SCALE <= THR), 1)) { mn = m_reg; alpha = 1.f; }
    else { mn = fmaxf(m_reg, pmax); alpha = __builtin_amdgcn_exp2f((m_reg - mn) * C2); m_reg = mn; }
    const float mnL = -mn * C2;
    for (int r = 0; r < 16; ++r) p0[r] = fmaf(p0[r], C2, mnL); for (int r = 0; r < 16; ++r) p1[r] = fmaf(p1[r], C2, mnL);
    for (int r = 0; r < 16; ++r) p0[r] = __builtin_amdgcn_exp2f(p0[r]);
}
__device__ __forceinline__ void finishSM(f32x16& p0, f32x16& p1, float alpha, float& l_reg, bf16x8& pa0, bf16x8& pa1, bf16x8& pa2, bf16x8& pa3) {
    for (int r = 0; r < 16; ++r) p1[r] = __builtin_amdgcn_exp2f(p1[r]);
    float ps = 0; for (int r = 0; r < 16; ++r) ps += p0[r]; for (int r = 0; r < 16; ++r) ps += p1[r];
    { auto rr = __builtin_amdgcn_permlane32_swap(__float_as_uint(ps), __float_as_uint(ps), false, false);
      ps = __uint_as_float(rr[0]) + __uint_as_float(rr[1]); }
    l_reg = l_reg * alpha + ps;
#define PK4(P, B_, OUT) do { unsigned a0 = cvtpk(P[B_+0], P[B_+1]), a1 = cvtpk(P[B_+2], P[B_+3]);                          \
        unsigned b0 = cvtpk(P[B_+4], P[B_+5]), b1 = cvtpk(P[B_+6], P[B_+7]);                                             \
        auto r0 = __builtin_amdgcn_permlane32_swap(a0, b0, false, false); auto r1 = __builtin_amdgcn_permlane32_swap(a1, b1, false, false); \
        u32x4 w = {r0[0], r1[0], r0[1], r1[1]}; OUT = *reinterpret_cast<bf16x8*>(&w); } while (0)
    PK4(p0, 0, pa0); PK4(p0, 8, pa1); PK4(p1, 0, pa2); PK4(p1, 8, pa3);
#undef PK4
}
template <int KB, bool SK>
__device__ __forceinline__ void qkt(f32x16& p0, f32x16& p1, const char* K_lds, int r32, int hi, const bf16x8* qr, bool act) {
    if (SK && !act) { const float NEG = -__builtin_inff();
#pragma unroll
        for (int r = 0; r < 16; ++r) { p0[r] = NEG; p1[r] = NEG; } return; }
    p0 = f32x16{}; p1 = f32x16{};
    const char* kb[4];
#pragma unroll
    for (int dd = 0; dd < 4; ++dd) kb[dd] = K_lds + KB * SHM_K + KSWZ(r32, (dd * 16 + hi * 8) * 2);
#pragma unroll
    for (int d0 = 0; d0 < 8; ++d0) { const char* a = kb[d0 & 3] + (d0 >> 2) * 128;
        bf16x8 b0 = *reinterpret_cast<const bf16x8*>(a);
        bf16x8 b1 = *reinterpret_cast<const bf16x8*>(a + 32 * 256);
        p0 = __builtin_amdgcn_mfma_f32_32x32x16_bf16(b0, qr[d0], p0, 0, 0, 0);
        p1 = __builtin_amdgcn_mfma_f32_32x32x16_bf16(b1, qr[d0], p1, 0, 0, 0); }
}
template <int VB, bool SK>
__device__ __forceinline__ void pv_tile(f32x16* o, int vb0, bf16x8 pa0, bf16x8 pa1, bf16x8 pa2, bf16x8 pa3, bool act) {
    if (SK && !act) return;
#define TRRD(dst, off) asm volatile("ds_read_b64_tr_b16 %0, %1 offset:%2" : "=&v"(dst) : "v"(vb0), "i"(off) : "memory")
#define PV_D0(d0) do { s16x4 l0, l1, l2, l3, h0, h1, h2, h3; constexpr int b_ = VB * SHM_V + v_rd_off(d0, 0, 0);     \
        TRRD(l0, b_); TRRD(h0, b_ + 2048); TRRD(l1, b_ + 4096); TRRD(h1, b_ + 6144); TRRD(l2, b_ + 8192); TRRD(h2, b_ + 10240); TRRD(l3, b_ + 12288); TRRD(h3, b_ + 14336); \
        asm volatile("s_waitcnt lgkmcnt(0)" ::: "memory"); SBAR();                 \
        o[d0] = __builtin_amdgcn_mfma_f32_32x32x16_bf16(pa0, (bf16x8){l0[0], l0[1], l0[2], l0[3], h0[0], h0[1], h0[2], h0[3]}, o[d0], 0, 0, 0);   \
        o[d0] = __builtin_amdgcn_mfma_f32_32x32x16_bf16(pa1, (bf16x8){l1[0], l1[1], l1[2], l1[3], h1[0], h1[1], h1[2], h1[3]}, o[d0], 0, 0, 0);   \
        o[d0] = __builtin_amdgcn_mfma_f32_32x32x16_bf16(pa2, (bf16x8){l2[0], l2[1], l2[2], l2[3], h2[0], h2[1], h2[2], h2[3]}, o[d0], 0, 0, 0);   \
        o[d0] = __builtin_amdgcn_mfma_f32_32x32x16_bf16(pa3, (bf16x8){l3[0], l3[1], l3[2], l3[3], h3[0], h3[1], h3[2], h3[3]}, o[d0], 0, 0, 0); } while (0)
    PV_D0(0); PV_D0(1); PV_D0(2); PV_D0(3);
#undef PV_D0
#undef TRRD
}
template <class TIn, class TOut> struct BlockRef { const TIn* Q; const TIn* K; const TIn* V; TOut* O; const float* G; int P0; };
template <class TIn> struct Seam {
    bf16x8 qr[8];
    bf16x8 st_v0, st_v1, st_k0, st_k1; f32x4 sf0, sf1, sf2, sf3;
    f32x4 tq[16];
};
__device__ __forceinline__ int swa_jlo(int P0, int W) { const int lowk = P0 - W + 1; return lowk > 0 ? lowk / KVBLK : 0; }
#define ROW(p, k0, rr) ((p) + (size_t)((k0) + (rr)) * LDK + sc)
#define VMW() asm volatile("s_waitcnt vmcnt(0)" ::: "memory")
#define VMWN(n) asm volatile("s_waitcnt vmcnt(%0)" :: "i"(n) : "memory")
#define SLOAD_H(Kp, Vp, k0) do { S.st_v0 = load8<TIn>(ROW(Vp, k0, sr)); S.st_v1 = load8<TIn>(ROW(Vp, k0, 32 + sr));              \
                         S.st_k0 = load8<TIn>(ROW(Kp, k0, sr)); S.st_k1 = load8<TIn>(ROW(Kp, k0, 32 + sr)); } while (0)
#define SWRITE_HK(bf) do { *(bf16x8*)(K_lds + (bf) * SHM_K + kws) = S.st_k0; *(bf16x8*)(K_lds + (bf) * SHM_K + kws + 32 * 256) = S.st_k1; } while (0)
#define SWRITE_HV(bf) do { *(bf16x8*)(V_lds + (bf) * SHM_V + vst0) = S.st_v0; *(bf16x8*)(V_lds + (bf) * SHM_V + vst1) = S.st_v1; } while (0)
#define SWRITE_H(bf) do { SWRITE_HV(bf); SWRITE_HK(bf); } while (0)
#define SLOAD_F(p, k0) do { S.sf0 = *(const f32x4*)ROW(p, k0, sr); S.sf1 = *(const f32x4*)(ROW(p, k0, sr) + 4);                \
                            S.sf2 = *(const f32x4*)ROW(p, k0, 32 + sr); S.sf3 = *(const f32x4*)(ROW(p, k0, 32 + sr) + 4); } while (0)
#define SWRITE_KF(bf) do { *(bf16x8*)(K_lds + (bf) * SHM_K + kws) = pack8(S.sf0, S.sf1); *(bf16x8*)(K_lds + (bf) * SHM_K + kws + 32 * 256) = pack8(S.sf2, S.sf3); } while (0)
#define SWRITE_VF(bf) do { *(bf16x8*)(V_lds + (bf) * SHM_V + vst0) = pack8(S.sf0, S.sf1); *(bf16x8*)(V_lds + (bf) * SHM_V + vst1) = pack8(S.sf2, S.sf3); } while (0)
template <class TIn, class TOut>
__device__ __forceinline__ void causal_swa_prime(const BlockRef<TIn, TOut>& cur, int W, char* lds, Seam<TIn>& S) {
    constexpr bool F32 = same_t<TIn, float>::v;
    int tid_ = threadIdx.x; asm volatile("" : "+v"(tid_)); const int tid = tid_, wid = __builtin_amdgcn_readfirstlane(tid >> 6), lane = tid & 63, r32 = lane & 31, hi = lane >> 5;
    const int sr = tid >> 4, sc = (tid & 15) * 8, kws = KSWZ(sr, sc * 2); char* K_lds = lds + 2 * SHM_V;
    const int kb0 = swa_jlo(cur.P0, W) * KVBLK;
    for (int d0 = 0; d0 < 8; ++d0) S.qr[d0] = load8<TIn>(cur.Q + (size_t)(wid * QBLK + r32) * LDK + d0 * 16 + hi * 8);
    if constexpr (F32) { SLOAD_F((const float*)cur.K, kb0); VMW(); SWRITE_KF(0); SBAR(); SLOAD_F((const float*)cur.V, kb0); }
    else { SLOAD_H(cur.K, cur.V, kb0); VMW(); SWRITE_HK(0); }
    __syncthreads();
}
template <class TIn, class TOut>
__device__ __forceinline__ void causal_swa_block(const BlockRef<TIn, TOut>& cur, const BlockRef<TIn, TOut>& nxt, int skv, int W, char* lds, Seam<TIn>& S) {
    constexpr bool F32 = same_t<TIn, float>::v;
    int tid_ = threadIdx.x; asm volatile("" : "+v"(tid_)); const int tid = tid_, wid = __builtin_amdgcn_readfirstlane(tid >> 6), lane = tid & 63, r32 = lane & 31, hi = lane >> 5;
    const int j_lo = swa_jlo(cur.P0, W);
    int j_hi = (cur.P0 + QB - 1) / KVBLK + 1; if (j_hi > skv / KVBLK) j_hi = skv / KVBLK;
    const int NT = j_hi - j_lo;
    const int kbn = swa_jlo(nxt.P0, W) * KVBLK;
    const int qlo = cur.P0 + wid * QBLK, qm = qlo + r32 - 4 * hi;
    char* V_lds = lds; char* K_lds = lds + 2 * SHM_V;
    float* ws = (float*)(lds + 2 * SHM_V + 2 * SHM_K) + wid * 64; float* li_l = ws, * al_l = ws + 32;
    float m_reg = -1e30f, l_reg = 0; f32x16 o[4] = {};
    const int sr = tid >> 4, sc = (tid & 15) * 8, vst0 = v_st(sr, sc), vst1 = v_st(32 + sr, sc), kws = KSWZ(sr, sc * 2);
    const int vb0 = (int)(uintptr_t)V_lds + v_rd_base(lane);
    const TIn* Kh = cur.K; const TIn* Vh = cur.V;
#define RESC(a) do { if (__any((a) < 1.f)) { if (hi == 0) al_l[r32] = (a); asm volatile("s_waitcnt lgkmcnt(0)" ::: "memory");              \
                     for (int d_ = 0; d_ < 4; ++d_) for (int r = 0; r < 16; ++r) o[d_][r] *= al_l[crow(r, hi)]; } } while (0)
#define KBASE(t) ((j_lo + (t)) * KVBLK)
#define ACT(t) (KBASE(t) <= qlo + QBLK - 1 && KBASE(t) + KVBLK - 1 >= qlo - W + 1)
#define MASKT(P0_, P1_, t) do { const int kb_ = KBASE(t); if ((!SK || ACT(t)) && (kb_ + KVBLK - 1 > qlo || kb_ <= qlo + QBLK - 1 - W)) mask_tile(P0_, P1_, qm - kb_, (unsigned)W); } while (0)
    const float* cks = (const float*)(lds + LDS_BYTES); const float cq = cks[qlo + r32];
#define BIAS(P0_, P1_, t) do { const float* ck_ = cks + KBASE(t) + 4 * hi; \
        _Pragma("unroll") for (int g_ = 0; g_ < 4; ++g_) { const f32x4 c0_ = *(const f32x4*)(ck_ + 8 * g_), c1_ = *(const f32x4*)(ck_ + 32 + 8 * g_); \
            _Pragma("unroll") for (int e_ = 0; e_ < 4; ++e_) { P0_[4 * g_ + e_] += cq - c0_[e_]; P1_[4 * g_ + e_] += cq - c1_[e_]; } } } while (0)
    constexpr int NQL = F32 ? 16 : 8;
    constexpr bool SK = WSKIP && !F32;
#define SEAM_K0() do { VMWN(NQL); if constexpr (F32) { SWRITE_KF(0); SBAR(); SLOAD_F((const float*)nxt.V, kbn); } else { SWRITE_HK(0); } SBAR(); } while (0)
    f32x16 pA0, pA1, pB0, pB1; float mnA, mnB, alA, alB; bf16x8 pa0, pa1, pa2, pa3;
    if constexpr (F32) { VMW(); SWRITE_VF(0); SBAR(); } else { SWRITE_HV(0); SBAR(); }
    if (NT > 1) { if constexpr (F32) SLOAD_F((const float*)Kh, KBASE(1)); else SLOAD_H(Kh, Vh, KBASE(1)); }
    SBAR(); qkt<0, SK>(pA0, pA1, K_lds, r32, hi, S.qr, ACT(0));
    if constexpr (F32) { if (NT > 1) { VMW(); SWRITE_KF(1); SBAR(); SLOAD_F((const float*)Vh, KBASE(1)); } }
    BIAS(pA0, pA1, 0); MASKT(pA0, pA1, 0); partialSM(pA0, pA1, m_reg, mnA, alA);
    if (NT > 1) { VMW(); if constexpr (F32) { SWRITE_VF(1); SBAR(); if (NT > 2) SLOAD_F((const float*)Kh, KBASE(2)); } else SWRITE_H(1); }
    __syncthreads();
#define HALF_STEP(PX0, PX1, mnX, alX, PY0, PY1, alY, t, KB, VB, SB) do {                                                      \
        SBAR(); qkt<KB, SK>(PX0, PX1, K_lds, r32, hi, S.qr, ACT(t));                                             \
        finishSM(PY0, PY1, alY, l_reg, pa0, pa1, pa2, pa3); SBAR();                                                           \
        if ((t) + 1 < NT) { if constexpr (F32) { VMW(); SWRITE_KF(SB); SBAR(); SLOAD_F((const float*)Vh, KBASE((t) + 1)); }  \
                            else { SLOAD_H(Kh, Vh, KBASE((t) + 1)); } SBAR(); }                                               \
        pv_tile<VB, SK>(o, vb0, pa0, pa1, pa2, pa3, ACT((t) - 1)); BIAS(PX0, PX1, (t)); MASKT(PX0, PX1, (t)); partialSM(PX0, PX1, m_reg, mnX, alX);                                        \
        __syncthreads();                                                                                                      \
        if ((t) + 1 < NT) { VMW(); if constexpr (F32) { SWRITE_VF(SB); SBAR(); if ((t) + 2 < NT) SLOAD_F((const float*)Kh, KBASE((t) + 2)); } \
                            else { SWRITE_H(SB); } }                                                                          \
        RESC(alX); __syncthreads(); } while (0)
    for (int t = 1; t + 1 < NT; t += 2) {
        HALF_STEP(pB0, pB1, mnB, alB, pA0, pA1, alA, t, 1, 0, 0);
        HALF_STEP(pA0, pA1, mnA, alA, pB0, pB1, alB, t + 1, 0, 1, 1);
    }
    const bool even = (NT & 1) == 0;
    if (even) { SBAR(); qkt<1, SK>(pB0, pB1, K_lds, r32, hi, S.qr, ACT(NT - 1)); SBAR(); }
#define QROW(e) (nxt.Q + (size_t)(wid * QBLK + r32) * LDK + ((e) >> 1) * 16 + hi * 8 + ((e) & 1) * 4)
    if constexpr (F32) { SLOAD_F((const float*)nxt.K, kbn); SBAR();
#pragma unroll
        for (int e = 0; e < 8; ++e) S.tq[e] = *(const f32x4*)QROW(e); }
    else { SLOAD_H(nxt.K, nxt.V, kbn); SBAR();
#pragma unroll
        for (int d0 = 0; d0 < 8; ++d0) S.qr[d0] = load8<TIn>(nxt.Q + (size_t)(wid * QBLK + r32) * LDK + d0 * 16 + hi * 8); }
    SBAR();
    finishSM(pA0, pA1, alA, l_reg, pa0, pa1, pa2, pa3); SBAR();
    if constexpr (F32) {
#pragma unroll
        for (int e = 8; e < 16; ++e) S.tq[e] = *(const f32x4*)QROW(e); SBAR(); }
#undef QROW
    pv_tile<0, SK>(o, vb0, pa0, pa1, pa2, pa3, ACT(even ? NT - 2 : NT - 1));
    if (even) { BIAS(pB0, pB1, NT - 1); MASKT(pB0, pB1, NT - 1); partialSM(pB0, pB1, m_reg, mnB, alB); __syncthreads(); RESC(alB);
        finishSM(pB0, pB1, alB, l_reg, pa0, pa1, pa2, pa3); SBAR(); pv_tile<1, SK>(o, vb0, pa0, pa1, pa2, pa3, ACT(NT - 1)); }
    SBAR(); SEAM_K0();
    if (hi == 0) li_l[r32] = l_reg; asm volatile("s_waitcnt lgkmcnt(0)" ::: "memory");
    float rli[16];
#pragma unroll
    for (int r = 0; r < 16; ++r) rli[r] = __builtin_amdgcn_rcpf(li_l[crow(r, hi)]);
    TOut* Ow = cur.O + (size_t)(wid * QBLK) * LDO;
    const float gw0 = cur.G[r32], gw1 = cur.G[32 + r32], gw2 = cur.G[64 + r32], gw3 = cur.G[96 + r32];
#pragma unroll
    for (int r = 0; r < 16; ++r) { const int orow = crow(r, hi);
        float v0 = o[0][r] * rli[r], v1 = o[1][r] * rli[r], v2 = o[2][r] * rli[r], v3 = o[3][r] * rli[r];
        float ss = (v0 * v0 + v1 * v1) + (v2 * v2 + v3 * v3);
        ss += __shfl_xor(ss, 1); ss += __shfl_xor(ss, 2); ss += __shfl_xor(ss, 4); ss += __shfl_xor(ss, 8); ss += __shfl_xor(ss, 16);
        const float rn = 1.0f / sqrtf(ss * (1.0f / 128.0f) + NEPS);
        v0 *= rn * gw0; v1 *= rn * gw1; v2 *= rn * gw2; v3 *= rn * gw3;
        const float n0 = __shfl_xor(v0, 1), n1 = __shfl_xor(v1, 1), n2 = __shfl_xor(v2, 1), n3 = __shfl_xor(v3, 1);
        if ((r32 & 1) == 0) { TOut* op = Ow + (size_t)orow * LDO + r32;
            *(unsigned*)(op) = cvtpk(v0, n0); *(unsigned*)(op + 32) = cvtpk(v1, n1); *(unsigned*)(op + 64) = cvtpk(v2, n2); *(unsigned*)(op + 96) = cvtpk(v3, n3); } }
    if constexpr (F32) {
#pragma unroll
        for (int d0 = 0; d0 < 8; ++d0) S.qr[d0] = pack8(S.tq[2 * d0], S.tq[2 * d0 + 1]); }
    __syncthreads();
#undef RESC
#undef KBASE
#undef ACT
#undef MASKT
#undef BIAS
#undef SEAM_K0
#undef HALF_STEP
}
#undef ROW
#undef VMW
#undef VMWN
#undef SLOAD_H
#undef SWRITE_HK
#undef SWRITE_HV
#undef SWRITE_H
#undef SLOAD_F
#undef SWRITE_KF
#undef SWRITE_VF

#undef KSWZ
#undef SBAR
}

typedef unsigned u32x2 __attribute__((ext_vector_type(2)));
struct Frame {
    LAS unsigned char* lds;
    volatile LAS unsigned* MISC;
    unsigned char* ws;
    float* X;
    int vcu, G;
};
static_assert(19 * 8 <= 320, "pointer table fits below MISC");
enum { I_x, I_c, I_norm_pre, I_norm_post, I_w_mod, I_b_mod, I_w_gate, I_w_up, I_w_down, I_w_in, I_conv_w, I_conv_b, I_dt_bias, I_a_log, I_d_skip, I_ssm_norm, I_f_bias, I_attn_norm, I_w_out, I_N };
__device__ __forceinline__ const float* inp(const Frame& F, int k) {
    const LAS unsigned* t = (const LAS unsigned*)(F.lds + LDSCTL_OFF) + 2 * k;
    const unsigned lo = __builtin_amdgcn_readfirstlane(t[0]), hi = __builtin_amdgcn_readfirstlane(t[1]);
    return (const float*)(const GAS float*)(((unsigned long long)hi << 32) | lo);
}
template <class T> __device__ __forceinline__ T* wsp(const Frame& F, size_t off) { GAS unsigned char* p = (GAS unsigned char*)F.ws; asm volatile("" : "+s"(p)); return (T*)(GAS T*)(p + off); }

__device__ __forceinline__ float bf2f(unsigned short u) { return __uint_as_float((unsigned)u << 16); }
__device__ __forceinline__ float bflo(unsigned w) { return __uint_as_float(w << 16); }
__device__ __forceinline__ float bfhi(unsigned w) { return __uint_as_float(w & 0xffff0000u); }
__device__ __forceinline__ float wave_sum(float v) {
#pragma unroll
    for (int o = 1; o < 64; o <<= 1) v += __shfl_xor(v, o);
    return v;
}
__device__ __forceinline__ float wave_max(float v) {
#pragma unroll
    for (int o = 1; o < 64; o <<= 1) v = fmaxf(v, __shfl_xor(v, o));
    return v;
}
__device__ __forceinline__ float softplus_f(float x) { return fmaxf(x, 0.f) + log1pf(__expf(-fabsf(x))); }
__device__ __forceinline__ float silu_f(float g) { return g * __builtin_amdgcn_rcpf(1.0f + __expf(-g)); }
__device__ __forceinline__ unsigned pkb(float lo, float hi) { return pg8::pk_bf16(lo, hi); }
__device__ __forceinline__ float rl(float v, int l) { return __int_as_float(__builtin_amdgcn_readlane(__float_as_int(v), l)); }
__device__ __forceinline__ int fresh_tid() { int t = threadIdx.x; asm volatile("" : "+v"(t)); return t; }
#define PHASE_IDS const int tid = fresh_tid(), lane = tid & 63, wave = __builtin_amdgcn_readfirstlane(tid >> 6); (void)tid; (void)lane; (void)wave
#define MFMA16(a, b, c) __builtin_amdgcn_mfma_f32_16x16x32_bf16((a), (b), (c), 0, 0, 0)

struct CvItem { const float* src; bf16* dst; int N, K; };
constexpr int CV_IFF = (DM / 64) * (DFF / 64);
constexpr int CV_IOUT = (DM / 64) * (DM / 64);
constexpr int CV_ITEMS = 7 * CV_IFF + CV_IOUT;
__device__ __forceinline__ CvItem cv_decode(Frame& F, int L, int j) {
    CvItem d;
    if (j < 4 * CV_IFF) {
        const int up = j >= 2 * CV_IFF ? 1 : 0, r0 = j - up * 2 * CV_IFF, lf = 2 * L + r0 / CV_IFF, r = r0 % CV_IFF, kb = r / 88, nb = r % 88;
        d.N = DFF; d.K = DM; d.src = (up ? inp(F, I_w_up) : inp(F, I_w_gate)) + (size_t)lf * DM * DFF + (size_t)(64 * kb) * DFF + 64 * nb;
        d.dst = wsp<bf16>(F, WS_WGU) + (size_t)lf * NGU * DM + (size_t)((nb >> 1) * 256 + (nb & 1) * 64 + up * 128) * DM + 64 * kb;
    } else if (j < 6 * CV_IFF) {
        const int r0 = j - 4 * CV_IFF, lf = 2 * L + r0 / CV_IFF, r = r0 % CV_IFF, kb = r / 32, nb = r % 32;
        d.N = DM; d.K = DFF; d.src = inp(F, I_w_down) + (size_t)lf * DFF * DM + (size_t)(64 * kb) * DM + 64 * nb;
        d.dst = wsp<bf16>(F, WS_WDN) + (size_t)lf * DM * DFF + (size_t)(64 * nb) * DFF + 64 * kb;
    } else if (j < 7 * CV_IFF) {
        const int r = j - 6 * CV_IFF, kb = r / 88, nb = r % 88;
        d.N = DIN; d.K = DM; d.src = inp(F, I_w_in) + (size_t)L * DM * DIN + (size_t)(64 * kb) * DIN + 64 * nb + (64 * nb >= 2560 ? 16 : 0);
        d.dst = wsp<bf16>(F, WS_WIN) + (size_t)L * DINP * DM + (size_t)(64 * nb) * DM + 64 * kb;
    } else {
        const int r = j - 7 * CV_IFF, kb = r / 32, nb = r % 32;
        d.N = DM; d.K = DM; d.src = inp(F, I_w_out) + (size_t)L * DM * DM + (size_t)(64 * kb) * DM + 64 * nb;
        d.dst = wsp<bf16>(F, WS_WOUT) + (size_t)L * DM * DM + (size_t)(64 * nb) * DM + 64 * kb;
    }
    return d;
}
__device__ __forceinline__ void cv_load(const CvItem& d, f32x4 (&a)[8], f32x4 (&b)[8], int lane) {
    const int r = lane >> 4, q = lane & 15;
#pragma unroll
    for (int i = 0; i < 8; ++i) { const int kp = 4 * i + r; const float* p = d.src + (size_t)(2 * kp) * d.N + 4 * q; a[i] = *(const f32x4*)p; b[i] = *(const f32x4*)(p + d.N); }
}
__device__ __forceinline__ void cv_store(const CvItem& d, const f32x4 (&a)[8], const f32x4 (&b)[8], LAS unsigned* T, int lane) {
    const int r = lane >> 4, q = lane & 15;
#pragma unroll
    for (int i = 0; i < 8; ++i) { const int kp = 4 * i + r; LAS unsigned* t = T + kp * 65 + 4 * q;
        t[0] = pkb(a[i][0], b[i][0]); t[1] = pkb(a[i][1], b[i][1]); t[2] = pkb(a[i][2], b[i][2]); t[3] = pkb(a[i][3], b[i][3]); }
    LDS_WAIT(); asm volatile("" ::: "memory");
    const int c = lane & 7;
#pragma unroll
    for (int i = 0; i < 8; ++i) { const int n = 8 * i + (lane >> 3); const LAS unsigned* t = T + (4 * c) * 65 + n;
        v4u o; o.x = t[0]; o.y = t[65]; o.z = t[130]; o.w = t[195];
        *(v4u*)(d.dst + (size_t)n * d.K + 8 * c) = o; }
    LDS_WAIT(); asm volatile("" ::: "memory");
}
__device__ __forceinline__ void convert_range(Frame& F, int L, int jbeg, int jend, int q, int nq, LAS unsigned* T, int lane) {
    if (jbeg + q < jend) {
        f32x4 a0[8], b0[8], a1[8], b1[8];
        int j = jbeg + q; CvItem d0 = cv_decode(F, L, j), d1 = d0; cv_load(d0, a0, b0, lane);
        for (;;) {
            const int j1 = j + nq; const bool h1 = j1 < jend;
            if (h1) { d1 = cv_decode(F, L, j1); cv_load(d1, a1, b1, lane); }
            cv_store(d0, a0, b0, T, lane);
            if (!h1) break;
            j = j1 + nq; const bool h0 = j < jend;
            if (h0) { d0 = cv_decode(F, L, j); cv_load(d0, a0, b0, lane); }
            cv_store(d1, a1, b1, T, lane);
            if (!h0) break;
        }
    }
}
__device__ __forceinline__ void convert_tail(Frame& F, int L, int tq, int ntq) {
    for (int i = tq; i < 256 * 256; i += ntq) {
        const int kc = i & 255, j = i >> 8;
        const int src = j < 16 ? 2560 + j : (j < 24 ? 5648 + (j - 16) : -1);
        v4u o = {0u, 0u, 0u, 0u};
        if (src >= 0) { const float* p = inp(F, I_w_in) + (size_t)L * DM * DIN + (size_t)(8 * kc) * DIN + src;
            o.x = pkb(p[0], p[DIN]); o.y = pkb(p[2 * DIN], p[3 * DIN]); o.z = pkb(p[4 * DIN], p[5 * DIN]); o.w = pkb(p[6 * DIN], p[7 * DIN]); }
        *(v4u*)(wsp<bf16>(F, WS_WIN) + (size_t)L * DINP * DM + (size_t)(DINB + j) * DM + 8 * kc) = o;
    }
}
constexpr int CV_G1 = 5800, CV_B0 = 2 * CV_G1, CV_BGRP = 286;
__device__ __forceinline__ void p0_prologue(Frame& F) {
    PHASE_IDS;
    const int gw = F.vcu * NWAVES + wave, NGW = F.G * NWAVES;
    {
        LAS unsigned* T = (LAS unsigned*)(F.lds) + wave * (32 * 65);
        const int nl = (F.G == 256) ? 1 : DEPTH;
        for (int L = 0; L < nl; ++L) { convert_range(F, L, 0, CV_ITEMS, gw, NGW, T, lane); convert_tail(F, L, blockIdx.x * NTHR + tid, F.G * NTHR); }
    }
    {
        LAS float* cact = (LAS float*)(F.lds + 81920);
        for (int i = tid; i < NB * DM; i += NTHR) cact[i] = silu_f(inp(F, I_c)[i]);
        __syncthreads();
        const int gtid = blockIdx.x * NTHR + tid, NT = F.G * NTHR;
        constexpr int J4 = MODW / 4, KS = 7, KC = 296;
        for (int i = gtid; i < DEPTH * KS * J4; i += NT) {
            const int j4 = i % J4, ks = (i / J4) % KS, l = i / (J4 * KS);
            const int KL = (ks == KS - 1) ? DM - (KS - 1) * KC : KC;
            const float* wp = inp(F, I_w_mod) + ((size_t)l * DM + ks * KC) * MODW + 4 * j4;
            const LAS float* cp = cact + ks * KC;
            f32x4 acc[NB];
#pragma unroll
            for (int b = 0; b < NB; ++b) acc[b] = (f32x4){0.f, 0.f, 0.f, 0.f};
            for (int k = 0; k < KL; k += 8) {
                f32x4 w[8];
#pragma unroll
                for (int u = 0; u < 8; ++u) w[u] = *(const f32x4*)(wp + (size_t)(k + u) * MODW);
#pragma unroll
                for (int u = 0; u < 8; ++u)
#pragma unroll
                    for (int b = 0; b < NB; ++b) acc[b] += cp[b * DM + k + u] * w[u];
            }
#pragma unroll
            for (int b = 0; b < NB; ++b) *(f32x4*)(wsp<float>(F, WS_PART) + ((size_t)(ks * DEPTH + l) * NB + b) * MODW + 4 * j4) = acc[b];
        }
        __syncthreads();
    }
}

__device__ __forceinline__ void mod_reduce_phase(Frame& F) {
    PHASE_IDS;
    const int gtid = blockIdx.x * NTHR + tid, NT = F.G * NTHR;
    for (int i = gtid; i < DEPTH * NB * 3 * (DM / 4); i += NT) {
        const int c4 = i % (DM / 4), sub = (i / (DM / 4)) % 3, lb = i / (3 * DM / 4), l = lb / NB, b = lb % NB, k = 3 * l + sub;
        f32x4 m[3];
#pragma unroll
        for (int q = 0; q < 3; ++q) { const int col = (3 * sub + q) * DM + 4 * c4; f32x4 a = *(const f32x4*)(inp(F, I_b_mod) + (size_t)l * MODW + col);
#pragma unroll
            for (int ks = 0; ks < 7; ++ks) a += *(const f32x4*)(wsp<float>(F, WS_PART) + ((size_t)ks * DEPTH * NB + lb) * MODW + col);
            m[q] = a; }
        const f32x4 npre = *(const f32x4*)(inp(F, I_norm_pre) + (size_t)k * DM + 4 * c4), npost = *(const f32x4*)(inp(F, I_norm_post) + (size_t)k * DM + 4 * c4);
        float* mc = wsp<float>(F, WS_MOD);
        *(f32x4*)(mc + ((size_t)(k * NB + b) * 3 + 1) * DM + 4 * c4) = npre * (m[1] + 1.0f);
        *(f32x4*)(mc + ((size_t)(k * NB + b) * 3 + 2) * DM + 4 * c4) = m[0];
        *(f32x4*)(mc + ((size_t)((k + 1) * NB + b) * 3 + 0) * DM + 4 * c4) = (m[2] * (sub == 1 ? 1.0f : 0.5f)) * npost;
    }
}

template <bool FIRST, bool LAST, int NR>
__device__ __forceinline__ void thin_phase(Frame& F, int k) {
    PHASE_IDS;
    const int gw = F.vcu * NWAVES + wave, NGW = F.G * NWAVES;
    for (int rq = gw; rq < M / NR; rq += NGW) {
        const int row0 = NR * rq, b = row0 / SEQ;
        u32x2 xb[NR][8], yv[FIRST ? 1 : NR][8]; float ssx[NR], r[NR];
        if constexpr (FIRST) {
            f32x4 xf[NR][8];
#pragma unroll
            for (int t = 0; t < NR; ++t) { const f32x4* xr = (const f32x4*)(inp(F, I_x) + (size_t)(row0 + t) * DM) + lane;
#pragma unroll
                for (int j = 0; j < 8; ++j) xf[t][j] = xr[64 * j]; }
#pragma unroll
            for (int t = 0; t < NR; ++t) { ssx[t] = 0.f; u32x2* xo = (u32x2*)(wsp<bf16>(F, WS_XB) + (size_t)(row0 + t) * DM) + lane;
#pragma unroll
                for (int j = 0; j < 8; ++j) { u32x2 w; w.x = pkb(xf[t][j][0], xf[t][j][1]); w.y = pkb(xf[t][j][2], xf[t][j][3]); xb[t][j] = w; xo[64 * j] = w;
                    const float a0 = bflo(w.x), a1 = bfhi(w.x), a2 = bflo(w.y), a3 = bfhi(w.y); ssx[t] += (a0 * a0 + a1 * a1) + (a2 * a2 + a3 * a3); } }
        } else {
#pragma unroll
            for (int t = 0; t < NR; ++t) { const u32x2* xr = (const u32x2*)(wsp<bf16>(F, WS_XB) + (size_t)(row0 + t) * DM) + lane; const u32x2* yr = (const u32x2*)(wsp<bf16>(F, WS_Y) + (size_t)(row0 + t) * DM) + lane;
#pragma unroll
                for (int j = 0; j < 8; ++j) { xb[t][j] = xr[64 * j]; yv[t][j] = yr[64 * j]; } }
            asm volatile("" ::: "memory");
#pragma unroll
            for (int t = 0; t < NR; ++t) { float ss = 0.f;
#pragma unroll
                for (int j = 0; j < 8; ++j) { const float a0 = bflo(yv[t][j].x), a1 = bfhi(yv[t][j].x), a2 = bflo(yv[t][j].y), a3 = bfhi(yv[t][j].y); ss += (a0 * a0 + a1 * a1) + (a2 * a2 + a3 * a3); }
                r[t] = 1.0f / sqrtf(wave_sum(ss) * (1.0f / DM) + EPS); ssx[t] = 0.f; }
            const f32x4* gp = (const f32x4*)(wsp<float>(F, WS_MOD) + ((size_t)(k * NB + b) * 3 + 0) * DM) + lane;
#pragma unroll
            for (int j = 0; j < 8; ++j) {
                const f32x4 gv = gp[64 * j];
#pragma unroll
                for (int t = 0; t < NR; ++t) {
                    const f32x4 xo4 = (f32x4){bflo(xb[t][j].x), bfhi(xb[t][j].x), bflo(xb[t][j].y), bfhi(xb[t][j].y)};
                    const f32x4 yf = (f32x4){bflo(yv[t][j].x), bfhi(yv[t][j].x), bflo(yv[t][j].y), bfhi(yv[t][j].y)};
                    const f32x4 xn = xo4 + gv * (yf * r[t]);
                    if constexpr (LAST) { ((f32x4*)(F.X + (size_t)(row0 + t) * DM) + lane)[64 * j] = xn; }
                    else { u32x2 w; w.x = pkb(xn[0], xn[1]); w.y = pkb(xn[2], xn[3]); xb[t][j] = w; ((u32x2*)(wsp<bf16>(F, WS_XB) + (size_t)(row0 + t) * DM) + lane)[64 * j] = w;
                        const float a0 = bflo(w.x), a1 = bfhi(w.x), a2 = bflo(w.y), a3 = bfhi(w.y); ssx[t] += (a0 * a0 + a1 * a1) + (a2 * a2 + a3 * a3); }
                }
                asm volatile("" ::: "memory");
            }
        }
        if constexpr (!LAST) {
#pragma unroll
            for (int t = 0; t < NR; ++t) r[t] = 1.0f / sqrtf(wave_sum(ssx[t]) * (1.0f / DM) + EPS);
            const f32x4* bp = (const f32x4*)(wsp<float>(F, WS_MOD) + ((size_t)(k * NB + b) * 3 + 1) * DM) + lane; const f32x4* cp = bp + DM / 4;
#pragma unroll
            for (int j = 0; j < 8; ++j) {
                const f32x4 bv = bp[64 * j], cv = cp[64 * j];
#pragma unroll
                for (int t = 0; t < NR; ++t) {
                    const f32x4 xn = (f32x4){bflo(xb[t][j].x), bfhi(xb[t][j].x), bflo(xb[t][j].y), bfhi(xb[t][j].y)};
                    const f32x4 hv = (xn * r[t]) * bv + cv;
                    u32x2 w; w.x = pkb(hv[0], hv[1]); w.y = pkb(hv[2], hv[3]); ((u32x2*)(wsp<bf16>(F, WS_HB) + (size_t)(row0 + t) * DM) + lane)[64 * j] = w;
                }
                asm volatile("" ::: "memory");
            }
        }
        asm volatile("" ::: "memory");
    }
}

__device__ __forceinline__ void ssd_states_phase(Frame& F, int l) {
    PHASE_IDS;
    LAS bf16* BT = (LAS bf16*)F.lds;
    LAS bf16* XsTb = (LAS bf16*)(F.lds + 128 * 72 * 2);
    LAS float* WL = (LAS float*)(F.lds + 128 * 72 * 2 + 8 * 64 * 72 * 2);
    const int fr = lane & 15, fq = lane >> 4;
    for (int unit = blockIdx.x; unit < NB * NCH * SG; unit += F.G) {
        const int g = unit & 1, c = (unit >> 1) & 31, b = unit >> 6, t0 = b * SEQ + c * CHUNK, h = g * HPG + wave;
        {
            const float a = -__expf(inp(F, I_a_log)[l * SH + h]), bias = inp(F, I_dt_bias)[l * SH + h];
            const float dt = softplus_f(wsp<float>(F, WS_DTF)[(size_t)(t0 + lane) * 32 + h] + bias);
            float inc = dt * a;
#pragma unroll
            for (int o = 1; o < 64; o <<= 1) { const float t = __shfl_up(inc, o); if (lane >= o) inc += t; }
            wsp<float>(F, WS_DT)[(t0 + lane) * 16 + h] = dt; wsp<float>(F, WS_ACS)[(t0 + lane) * 16 + h] = inc;
            WL[wave * 64 + lane] = dt * __expf(__shfl(inc, 63) - inc);
        }
        __syncthreads();
        {
            const int t = c * CHUNK + lane;
            const bf16* prow = wsp<bf16>(F, WS_ACT) + (size_t)(t0 + lane) * DINB + PC_X;
            const bf16* hrow = wsp<bf16>(F, WS_ACT) + (size_t)(t0 - 3 + (lane < 3 ? lane : 0)) * DINB + PC_X;
            bf16* drow = wsp<bf16>(F, WS_XBC) + (size_t)(t0 + lane) * CONVD;
            const bool halo_ok = (c > 0) && (lane < 3);
            (void)t;
#pragma unroll 2
            for (int kk = 0; kk < 12; ++kk) {
                const int cc = wave + 8 * kk;
                const int col = cc < 64 ? 512 * g + 8 * cc : (cc < 80 ? 1024 + 128 * g + 8 * (cc - 64) : 1280 + 128 * g + 8 * (cc - 80));
                const v4u cur = *(const v4u*)(prow + col);
                v4u hal = {0u, 0u, 0u, 0u}; if (halo_ok) hal = *(const v4u*)(hrow + col);
                float acc[8];
                { const float* bp = inp(F, I_conv_b) + l * CONVD + col; const f32x4 a0 = *(const f32x4*)bp, a1 = *(const f32x4*)(bp + 4);
                  acc[0] = a0[0]; acc[1] = a0[1]; acc[2] = a0[2]; acc[3] = a0[3]; acc[4] = a1[0]; acc[5] = a1[1]; acc[6] = a1[2]; acc[7] = a1[3]; }
#pragma unroll
                for (int k = 0; k < 4; ++k) {
                    const int dl = 3 - k; v4u u;
                    if (dl == 0) u = cur;
                    else { const int s1 = (lane - dl) & 63, s2 = (lane - dl + 3) & 63; const bool own = lane >= dl;
                        const unsigned ax = __shfl(cur.x, s1), ay = __shfl(cur.y, s1), az = __shfl(cur.z, s1), aw = __shfl(cur.w, s1);
                        const unsigned hx = __shfl(hal.x, s2), hy = __shfl(hal.y, s2), hz = __shfl(hal.z, s2), hw = __shfl(hal.w, s2);
                        u.x = own ? ax : hx; u.y = own ? ay : hy; u.z = own ? az : hz; u.w = own ? aw : hw; }
                    const float* wp = inp(F, I_conv_w) + (size_t)(l * 4 + k) * CONVD + col; const f32x4 w0 = *(const f32x4*)wp, w1 = *(const f32x4*)(wp + 4);
                    acc[0] += w0[0] * bflo(u.x); acc[1] += w0[1] * bfhi(u.x); acc[2] += w0[2] * bflo(u.y); acc[3] += w0[3] * bfhi(u.y);
                    acc[4] += w1[0] * bflo(u.z); acc[5] += w1[1] * bfhi(u.z); acc[6] += w1[2] * bflo(u.w); acc[7] += w1[3] * bfhi(u.w);
                }
#pragma unroll
                for (int e = 0; e < 8; ++e) acc[e] = silu_f(acc[e]);
                v4u o; o.x = pkb(acc[0], acc[1]); o.y = pkb(acc[2], acc[3]); o.z = pkb(acc[4], acc[5]); o.w = pkb(acc[6], acc[7]);
                *(v4u*)(drow + col) = o;
                if (cc < 64) {
                    const float sc_ = WL[(cc >> 3) * 64 + lane]; LAS bf16* d = XsTb + (cc >> 3) * (64 * 72) + (8 * (cc & 7)) * 72 + lane;
                    const unsigned w0 = pkb(acc[0] * sc_, acc[1] * sc_), w1 = pkb(acc[2] * sc_, acc[3] * sc_), w2 = pkb(acc[4] * sc_, acc[5] * sc_), w3 = pkb(acc[6] * sc_, acc[7] * sc_);
                    d[0] = (bf16)w0; d[72] = (bf16)(w0 >> 16); d[144] = (bf16)w1; d[216] = (bf16)(w1 >> 16); d[288] = (bf16)w2; d[360] = (bf16)(w2 >> 16); d[432] = (bf16)w3; d[504] = (bf16)(w3 >> 16);
                } else if (cc < 80) {
                    LAS bf16* d = BT + (8 * (cc - 64)) * 72 + lane;
                    d[0] = (bf16)o.x; d[72] = (bf16)(o.x >> 16); d[144] = (bf16)o.y; d[216] = (bf16)(o.y >> 16); d[288] = (bf16)o.z; d[360] = (bf16)(o.z >> 16); d[432] = (bf16)o.w; d[504] = (bf16)(o.w >> 16);
                }
            }
        }
        __syncthreads();
        const LAS bf16* XsT = XsTb + wave * (64 * 72);
        bf16* stp = wsp<bf16>(F, WS_ST) + (size_t)((b * NCH + c) * SH + h) * (SP * SN);
#pragma unroll
        for (int nh = 0; nh < 2; ++nh) {
            f32x4 acc[4][4];
#pragma unroll
            for (int i = 0; i < 4; ++i)
#pragma unroll
                for (int j = 0; j < 4; ++j) acc[i][j] = (f32x4){0.f, 0.f, 0.f, 0.f};
#pragma unroll
            for (int ks = 0; ks < 2; ++ks) {
                bf16x8 xa[4], yb[4];
#pragma unroll
                for (int nt = 0; nt < 4; ++nt) xa[nt] = *(const LAS bf16x8*)(BT + (64 * nh + 16 * nt + fr) * 72 + 32 * ks + 8 * fq);
#pragma unroll
                for (int pt = 0; pt < 4; ++pt) yb[pt] = *(const LAS bf16x8*)(XsT + (16 * pt + fr) * 72 + 32 * ks + 8 * fq);
#pragma unroll
                for (int nt = 0; nt < 4; ++nt)
#pragma unroll
                    for (int pt = 0; pt < 4; ++pt) acc[nt][pt] = MFMA16(xa[nt], yb[pt], acc[nt][pt]);
            }
#pragma unroll
            for (int nt = 0; nt < 4; ++nt)
#pragma unroll
                for (int pt = 0; pt < 4; ++pt) { u32x2 wv; wv.x = pkb(acc[nt][pt][0], acc[nt][pt][1]); wv.y = pkb(acc[nt][pt][2], acc[nt][pt][3]);
                    *(u32x2*)(stp + (16 * pt + fr) * SN + 64 * nh + 16 * nt + 4 * fq) = wv; }
        }
        __syncthreads();
    }
}

__device__ __forceinline__ void scan_block(Frame& F, int sb, int tid) {
    const int i = sb * NTHR + tid, e4 = i & 2047, h = (i >> 11) & 15, b = i >> 15;
    u32x2* p0 = (u32x2*)(wsp<bf16>(F, WS_ST) + (size_t)(b * NCH * SH + h) * (SP * SN)) + e4;
    const float* ap = wsp<float>(F, WS_ACS) + (size_t)(b * SEQ + 63) * 16 + h;
    u32x2 st[NCH]; float dec[NCH];
#pragma unroll
    for (int c = 0; c < NCH; ++c) { st[c] = p0[(size_t)c * (SH * SP * SN / 4)]; dec[c] = ap[c * CHUNK * 16]; }
    f32x4 hs = (f32x4){0.f, 0.f, 0.f, 0.f};
#pragma unroll
    for (int c = 0; c < NCH; ++c) {
        u32x2 w; w.x = pkb(hs[0], hs[1]); w.y = pkb(hs[2], hs[3]); p0[(size_t)c * (SH * SP * SN / 4)] = w;
        const float d = __expf(dec[c]);
        hs = hs * d + (f32x4){bflo(st[c].x), bfhi(st[c].x), bflo(st[c].y), bfhi(st[c].y)};
    }
}
static_assert(fa::LDK == DINB && fa::LDO == DM && fa::D == AHD && fa::LDS_BYTES + SEQ * 4 + 64 <= RING_BYTES, "attention body geometry");
__device__ __forceinline__ void attn_block(Frame& F, int l, char* lds, int bh, int qb, int tid) {
    const int lane = tid & 63, wave = __builtin_amdgcn_readfirstlane(tid >> 6), b = bh / AH, h = bh % AH;
    float* cks = (float*)(lds + fa::LDS_BYTES); float* wtot = cks + SEQ;
    constexpr int W = 1 << 24;
    const int n = qb * 256 + 256;
    {   const float fb = inp(F, I_f_bias)[l * AH + h]; const float* fr_ = wsp<float>(F, WS_DTF) + (size_t)(b * SEQ) * 32 + 16 + h;
        float v[4]; float run = 0.f;
#pragma unroll
        for (int e = 0; e < 4; ++e) { const int t = 4 * tid + e; const float xx = (t < n) ? fr_[(size_t)t * 32] + fb : 0.f; run += (t < n) ? -softplus_f(-xx) : 0.f; v[e] = run; }
        float inc = run;
#pragma unroll
        for (int o = 1; o < 64; o <<= 1) { const float t = __shfl_up(inc, o); if (lane >= o) inc += t; }
        if (lane == 63) wtot[wave] = inc;
        __syncthreads();
        float pre = inc - run;
#pragma unroll
        for (int w2 = 0; w2 < 8; ++w2) pre += (w2 < wave) ? wtot[w2] : 0.f;
        if (4 * tid < n) *(f32x4*)(cks + 4 * tid) = (f32x4){(pre + v[0]) * 11.313708498984761f, (pre + v[1]) * 11.313708498984761f, (pre + v[2]) * 11.313708498984761f, (pre + v[3]) * 11.313708498984761f};
    }
    fa::BlockRef<fa::bf16, fa::bf16> cur;
    const bf16* proj = wsp<bf16>(F, WS_ACT);
    cur.Q = (const fa::bf16*)(proj + (size_t)(b * SEQ + qb * 256) * DINB + PC_Q + h * AHD);
    cur.K = (const fa::bf16*)(proj + (size_t)(b * SEQ) * DINB + PC_K + h * AHD);
    cur.V = (const fa::bf16*)(proj + (size_t)(b * SEQ) * DINB + PC_V + h * AHD);
    cur.O = (fa::bf16*)(wsp<bf16>(F, WS_YCAT) + (size_t)(b * SEQ + qb * 256) * DM + DSSM + h * AHD);
    cur.G = inp(F, I_attn_norm) + l * DATT + h * AHD; cur.P0 = qb * 256;
    fa::Seam<fa::bf16> S;
    fa::causal_swa_prime<fa::bf16, fa::bf16>(cur, W, lds, S);
    fa::causal_swa_block<fa::bf16, fa::bf16>(cur, cur, SEQ, W, lds, S);
}
__device__ __forceinline__ void attn_scan_phase(Frame& F, int l, char* lds) {
    PHASE_IDS;
    if (F.G == 256) {
        const int c = blockIdx.x, xcd = c & 7, slot = c >> 3, qb = slot & 7, grp = xcd + 8 * (slot >> 3);
        const int nscan = qb < 2 ? 2 : (qb < 6 ? 1 : 0), first = qb < 2 ? 2 * qb : qb + 2;
        for (int k = 0; k < nscan; ++k) scan_block(F, grp * 8 + first + k, tid);
        attn_block(F, l, lds, grp, qb, tid);
        if (l + 1 < DEPTH) {
            const int off0 = qb == 0 ? 0 : qb == 1 ? 62 : qb == 2 ? 114 : qb == 3 ? 165 : qb == 4 ? 205 : qb == 5 ? 235 : qb == 6 ? 256 : 276;
            const int off1 = qb == 0 ? 62 : qb == 1 ? 114 : qb == 2 ? 165 : qb == 3 ? 205 : qb == 4 ? 235 : qb == 5 ? 256 : qb == 6 ? 276 : 286;
            const int jb = CV_B0 + grp * CV_BGRP + off0; int je = CV_B0 + grp * CV_BGRP + off1; if (je > CV_ITEMS) je = CV_ITEMS;
            convert_range(F, l + 1, jb, je, wave, NWAVES, (LAS unsigned*)(F.lds) + wave * (32 * 65), lane);
        }
    } else {
        for (int sb = blockIdx.x; sb < 256; sb += F.G) scan_block(F, sb, tid);
        for (int item = blockIdx.x; item < NB * AH * (SEQ / 256); item += F.G) attn_block(F, l, lds, item >> 3, item & 7, tid);
    }
}

__device__ __forceinline__ void ssd_out_phase(Frame& F, int l) {
    PHASE_IDS;
    LAS bf16* Cn = (LAS bf16*)F.lds;
    LAS bf16* Bn = Cn + 64 * 136;
    LAS bf16* CBs = Bn + 64 * 136;
    LAS bf16* XTb = CBs + 64 * 72;
    LAS float* ACSh = (LAS float*)(XTb + 8 * 64 * 72);
    LAS float* DTh = ACSh + 512;
    LAS float* SSP = DTh + 512;
    static_assert((64 * 136 * 2 + 64 * 72 + 8 * 64 * 72) * 2 + 3 * 2048 <= RING_BYTES, "phase C LDS");
    const int fr = lane & 15, fq = lane >> 4, w = wave;
    LAS bf16* XT = XTb + w * (64 * 72);
    const LAS float* acsv = ACSh + w * 64; const LAS float* dtv = DTh + w * 64;
    for (int unit = blockIdx.x; unit < NB * NCH * SG; unit += F.G) {
        const int g = unit & 1, c = (unit >> 1) & 31, b = unit >> 6, t0 = b * SEQ + c * CHUNK, h = g * HPG + w;
        const bf16* prev = wsp<bf16>(F, WS_ST) + (size_t)((b * NCH + c) * SH + h) * (SP * SN);
        bf16x8 pf[4][4];
#pragma unroll
        for (int pt = 0; pt < 4; ++pt)
#pragma unroll
            for (int ks = 0; ks < 4; ++ks) pf[pt][ks] = *(const bf16x8*)(prev + (16 * pt + fr) * SN + 32 * ks + 8 * fq);
#pragma unroll
        for (int i = 0; i < 2; ++i) { const int idx = tid + NTHR * i, row = idx >> 4, ch = idx & 15; const bf16* src = wsp<bf16>(F, WS_XBC) + (size_t)(t0 + row) * CONVD + 128 * g + 8 * ch;
            *(LAS v4u*)(Bn + row * 136 + 8 * ch) = *(const v4u*)(src + (PC_B - PC_X));
            *(LAS v4u*)(Cn + row * 136 + 8 * ch) = *(const v4u*)(src + (PC_C - PC_X)); }
        {   const bf16* src = wsp<bf16>(F, WS_XBC) + (size_t)(t0 + lane) * CONVD + 64 * h;
#pragma unroll
            for (int ch = 0; ch < 8; ++ch) { const v4u v = *(const v4u*)(src + 8 * ch);
                LAS bf16* d = XT + (8 * ch) * 72 + lane;
                d[0] = (bf16)v.x; d[72] = (bf16)(v.x >> 16); d[144] = (bf16)v.y; d[216] = (bf16)(v.y >> 16); d[288] = (bf16)v.z; d[360] = (bf16)(v.z >> 16); d[432] = (bf16)v.w; d[504] = (bf16)(v.w >> 16); }
            ACSh[w * 64 + lane] = wsp<float>(F, WS_ACS)[(t0 + lane) * 16 + h]; DTh[w * 64 + lane] = wsp<float>(F, WS_DT)[(t0 + lane) * 16 + h]; }
        __syncthreads();
        {   const int lt = w >> 1;
            bf16x8 yc[4];
#pragma unroll
            for (int ks = 0; ks < 4; ++ks) yc[ks] = *(const LAS bf16x8*)(Cn + (16 * lt + fr) * 136 + 32 * ks + 8 * fq);
#pragma unroll
            for (int s2 = 0; s2 < 2; ++s2) { const int st = 2 * (w & 1) + s2;
                f32x4 a = (f32x4){0.f, 0.f, 0.f, 0.f};
#pragma unroll
                for (int ks = 0; ks < 4; ++ks) { const bf16x8 xb = *(const LAS bf16x8*)(Bn + (16 * st + fr) * 136 + 32 * ks + 8 * fq); a = MFMA16(xb, yc[ks], a); }
                u32x2 pw; pw.x = pkb(a[0], a[1]); pw.y = pkb(a[2], a[3]);
                *(LAS u32x2*)(CBs + (16 * lt + fr) * 72 + 16 * st + 4 * fq) = pw; } }
        __syncthreads();
        f32x4 acc[4][4];
#pragma unroll
        for (int i = 0; i < 4; ++i)
#pragma unroll
            for (int j = 0; j < 4; ++j) acc[i][j] = (f32x4){0.f, 0.f, 0.f, 0.f};
        const float dsk = inp(F, I_d_skip)[l * SH + h];
#pragma unroll
        for (int lt = 0; lt < 4; ++lt) {
            const int lrow = 16 * lt + fr; const float al = acsv[lrow], eal = __expf(al);
#pragma unroll
            for (int ks = 0; ks < 2; ++ks) {
                if (ks == 1 && lt < 2) continue;
                const int s0 = 32 * ks + 8 * fq;
                const v4u cb = *(const LAS v4u*)(CBs + lrow * 72 + s0);
                const f32x4 as0 = *(const LAS f32x4*)(acsv + s0), as1 = *(const LAS f32x4*)(acsv + s0 + 4), ds0 = *(const LAS f32x4*)(dtv + s0), ds1 = *(const LAS f32x4*)(dtv + s0 + 4);
                float f[8];
#pragma unroll
                for (int j = 0; j < 4; ++j) { f[j] = (s0 + j <= lrow) ? __expf(al - as0[j]) * ds0[j] : 0.f; f[4 + j] = (s0 + 4 + j <= lrow) ? __expf(al - as1[j]) * ds1[j] : 0.f; }
                v4u sp; sp.x = pkb(bflo(cb.x) * f[0], bfhi(cb.x) * f[1]); sp.y = pkb(bflo(cb.y) * f[2], bfhi(cb.y) * f[3]); sp.z = pkb(bflo(cb.z) * f[4], bfhi(cb.z) * f[5]); sp.w = pkb(bflo(cb.w) * f[6], bfhi(cb.w) * f[7]);
                const bf16x8 ys = __builtin_bit_cast(bf16x8, sp);
#pragma unroll
                for (int pt = 0; pt < 4; ++pt) { const bf16x8 xx = *(const LAS bf16x8*)(XT + (16 * pt + fr) * 72 + s0); acc[lt][pt] = MFMA16(xx, ys, acc[lt][pt]); }
            }
#pragma unroll
            for (int ks = 0; ks < 4; ++ks) {
                const v4u cc = *(const LAS v4u*)(Cn + lrow * 136 + 32 * ks + 8 * fq);
                v4u sc_; sc_.x = pkb(bflo(cc.x) * eal, bfhi(cc.x) * eal); sc_.y = pkb(bflo(cc.y) * eal, bfhi(cc.y) * eal); sc_.z = pkb(bflo(cc.z) * eal, bfhi(cc.z) * eal); sc_.w = pkb(bflo(cc.w) * eal, bfhi(cc.w) * eal);
                const bf16x8 yc = __builtin_bit_cast(bf16x8, sc_);
#pragma unroll
                for (int pt = 0; pt < 4; ++pt) acc[lt][pt] = MFMA16(pf[pt][ks], yc, acc[lt][pt]);
            }
            float ssq = 0.f;
#pragma unroll
            for (int pt = 0; pt < 4; ++pt) {
                const int pc = 16 * pt + 4 * fq;
                const u32x2 zz = *(const u32x2*)(wsp<bf16>(F, WS_ACT) + (size_t)(t0 + lrow) * DINB + PC_Z + 64 * h + pc);
                f32x4 y = acc[lt][pt];
                y[0] = (y[0] + dsk * bf2f(XT[(pc + 0) * 72 + lrow])) * silu_f(bflo(zz.x));
                y[1] = (y[1] + dsk * bf2f(XT[(pc + 1) * 72 + lrow])) * silu_f(bfhi(zz.x));
                y[2] = (y[2] + dsk * bf2f(XT[(pc + 2) * 72 + lrow])) * silu_f(bflo(zz.y));
                y[3] = (y[3] + dsk * bf2f(XT[(pc + 3) * 72 + lrow])) * silu_f(bfhi(zz.y));
                acc[lt][pt] = y; ssq += (y[0] * y[0] + y[1] * y[1]) + (y[2] * y[2] + y[3] * y[3]);
            }
            ssq += __shfl_xor(ssq, 16); ssq += __shfl_xor(ssq, 32);
            if (fq == 0) SSP[lrow * 8 + w] = ssq;
        }
        __syncthreads();
#pragma unroll
        for (int lt = 0; lt < 4; ++lt) {
            const int lrow = 16 * lt + fr;
            const f32x4 s0 = *(const LAS f32x4*)(SSP + lrow * 8), s1 = *(const LAS f32x4*)(SSP + lrow * 8 + 4);
            const float r = 1.0f / sqrtf(((s0[0] + s0[1]) + (s0[2] + s0[3]) + (s1[0] + s1[1]) + (s1[2] + s1[3])) * (1.0f / 512.0f) + EPS);
#pragma unroll
            for (int pt = 0; pt < 4; ++pt) { const int pc = 16 * pt + 4 * fq; const f32x4 wn = *(const f32x4*)(inp(F, I_ssm_norm) + l * DSSM + 64 * h + pc); const f32x4 y = acc[lt][pt];
                u32x2 ow; ow.x = pkb(y[0] * r * wn[0], y[1] * r * wn[1]); ow.y = pkb(y[2] * r * wn[2], y[3] * r * wn[3]);
                *(u32x2*)(wsp<bf16>(F, WS_YCAT) + (size_t)(t0 + lrow) * DM + 64 * h + pc) = ow; }
        }
        __syncthreads();
    }
}

struct Args { const float* in[19]; float* out; unsigned char* ws; };
__global__ void __launch_bounds__(NWAVES * 64, 2) fwd_kernel(Args args) {
    extern __shared__ __attribute__((aligned(16))) unsigned char lds[];
    Frame F;
    F.lds = (LAS unsigned char*)lds;
    F.MISC = (volatile LAS unsigned*)(F.lds + MISC_OFF);
    F.G = gridDim.x; { const int bx = blockIdx.x; F.vcu = (F.G % 8 == 0) ? (bx % 8) * (F.G / 8) + bx / 8 : bx; }
    F.ws = args.ws; F.X = args.out;
    for (int u = threadIdx.x; u < (LDS_BYTES - LDSCTL_OFF) / 4; u += NWAVES * 64) ((LAS unsigned*)(F.lds + LDSCTL_OFF))[u] = 0u;
    __syncthreads();
    if (threadIdx.x == 0) { LAS unsigned* t = (LAS unsigned*)(F.lds + LDSCTL_OFF);
#pragma unroll
        for (int k = 0; k < I_N; ++k) { const unsigned long long p = (unsigned long long)args.in[k]; t[2 * k] = (unsigned)p; t[2 * k + 1] = (unsigned)(p >> 32); } }
    __syncthreads();
    XcdBarrier bar = xcd_barrier_post((unsigned*)(args.ws + WS_CTL) + CW_BAR, F.MISC + 8);
#define GRID_BAR() do { XcdBarrier b_ = bar; GAS unsigned* p_ = (GAS unsigned*)bar.bar; asm volatile("" : "+s"(p_), "+s"(b_.x)); b_.bar = (unsigned*)p_; xcd_barrier(b_); } while (0)

    p0_prologue(F);
    GRID_BAR();
    mod_reduce_phase(F);
    GRID_BAR();
    thin_phase<true, false, 2>(F, 0);
    for (int s = 0; s < 3 * DEPTH; ++s) {
        const int l = s / 3, sub = s % 3;
        if (s > 0) thin_phase<false, false, 4>(F, s);
        GRID_BAR();
        if (sub != 1) {
            const int lf = l * 2 + (sub == 2 ? 1 : 0);
            pg8::Gemm g{wsp<bf16>(F, WS_HB), wsp<bf16>(F, WS_WGU) + (size_t)lf * NGU * DM, M, NGU, DM}; pg8::StaticOrder S; S.init(M, NGU, F.G, (int)blockIdx.x);
            pg8::EpiSwiGLU E{wsp<bf16>(F, WS_ACT), DFF};
            pg8::gemm_phase<pg8::EpiSwiGLU, pg8::StaticOrder, true, true>(F.lds, g, S, E);
            if (F.G == 256 && blockIdx.x >= 128 && l + 1 < DEPTH) {
                const int tid_ = fresh_tid(), wv_ = __builtin_amdgcn_readfirstlane(tid_ >> 6), ph_ = (sub == 2 ? 1 : 0), slot_ = (int)blockIdx.x - 128;
                convert_range(F, l + 1, ph_ * CV_G1, (ph_ + 1) * CV_G1, slot_ * NWAVES + wv_, 128 * NWAVES, (LAS unsigned*)(F.lds) + wv_ * (32 * 65), tid_ & 63);
                if (ph_ == 0) convert_tail(F, l + 1, slot_ * NTHR + tid_, 128 * NTHR);
            }
            GRID_BAR();
        } else {
            {   pg8::Gemm g{wsp<bf16>(F, WS_HB), wsp<bf16>(F, WS_WIN) + (size_t)l * DINP * DM, M, DINP, DM}; pg8::StaticOrder S; S.init(M, DINP, F.G, (int)blockIdx.x);
                pg8::EpiProj E{wsp<bf16>(F, WS_ACT), DINB, wsp<float>(F, WS_DTF), DINB / 256};
                pg8::gemm_phase<pg8::EpiProj, pg8::StaticOrder, true, true>(F.lds, g, S, E); }
            GRID_BAR();
            ssd_states_phase(F, l);
            GRID_BAR();
            attn_scan_phase(F, l, (char*)lds);
            GRID_BAR();
            ssd_out_phase(F, l);
            GRID_BAR();
        }
        {   const bool mix = (sub == 1); const int lf = l * 2 + (sub == 2 ? 1 : 0);
            pg8::Gemm g{mix ? wsp<bf16>(F, WS_YCAT) : wsp<bf16>(F, WS_ACT), mix ? wsp<bf16>(F, WS_WOUT) + (size_t)l * DM * DM : wsp<bf16>(F, WS_WDN) + (size_t)lf * DM * DFF, M, DM, mix ? DM : DFF}; pg8::StaticOrder S; S.init(M, DM, F.G, (int)blockIdx.x);
            pg8::EpiProj E{wsp<bf16>(F, WS_Y), DM, nullptr, 1 << 30};
            pg8::gemm_phase<pg8::EpiProj, pg8::StaticOrder, true, true>(F.lds, g, S, E); }
        GRID_BAR();
    }
    thin_phase<false, true, 2>(F, 3 * DEPTH);
}

extern "C" void kernel_launch(void* const* d_in, const int* in_sizes, int n_in, void* d_out, int out_size, void* d_ws, size_t ws_size, hipStream_t stream) {
    static int grid = 0;
    if (grid == 0) {
        if (n_in != 19 || in_sizes[0] != M * DM || out_size != M * DM || ws_size < WS_END) { fprintf(stderr, "kernel_launch: unexpected shapes (n_in %d, in0 %d, out %d, ws %zu < %zu)\n", n_in, n_in > 0 ? in_sizes[0] : -1, out_size, ws_size, (size_t)WS_END); grid = -1; return; }
        int dev = 0, cus = 0, per_cu = 0;
        if (hipGetDevice(&dev) != hipSuccess || hipDeviceGetAttribute(&cus, hipDeviceAttributeMultiprocessorCount, dev) != hipSuccess) { grid = -1; return; }
        if (hipFuncSetAttribute((const void*)fwd_kernel, hipFuncAttributeMaxDynamicSharedMemorySize, LDS_BYTES) != hipSuccess) { fprintf(stderr, "kernel_launch: hipFuncSetAttribute failed\n"); grid = -1; return; }
        if (hipOccupancyMaxActiveBlocksPerMultiprocessor(&per_cu, (const void*)fwd_kernel, NWAVES * 64, LDS_BYTES) != hipSuccess || per_cu < 1) { fprintf(stderr, "kernel_launch: occupancy query says %d\n", per_cu); }
        (void)hipGetLastError();
        grid = cus;
    }
    if (grid < 0) return;
    if (hipMemsetAsync((char*)d_ws + WS_CTL, 0, CTL_ZERO_BYTES, stream) != hipSuccess) return;
    Args a{};
    for (int i = 0; i < 19; ++i) a.in[i] = (const float*)d_in[i];
    a.out = (float*)d_out; a.ws = (unsigned char*)d_ws;
    hipLaunchKernelGGL(fwd_kernel, dim3(grid), dim3(NWAVES * 64), LDS_BYTES, stream, a);
}
```
